# Optimizing an MI355X kernel written in HIP

```python
import jax
import jax.numpy as jnp
from jax import lax
import numpy as np

D_MODEL = 1024
BATCH = 8
SEQ = 4096
DEPTH = 4

GRID_W = 64
CTX_LEN = 256
HEAD_DIM = 64
EPS = 1e-6

ATT_Q_HEADS = 8
ATT_KV_HEADS = 2
GQA_GROUP = ATT_Q_HEADS // ATT_KV_HEADS
ATT_WIDTH = ATT_Q_HEADS * HEAD_DIM
ATT_KV_WIDTH = ATT_KV_HEADS * HEAD_DIM
ATT_SCALE = HEAD_DIM ** -0.5
Q_BLOCK = 128
ROPE_BASE = 10000.0
ROPE_PAIRS = HEAD_DIM // 4

RWKV_HEADS = 8
RWKV_HEAD_DIM = HEAD_DIM
RWKV_WIDTH = RWKV_HEADS * RWKV_HEAD_DIM
DECAY_LORA = 64
ICLR_LORA = 64
GATE_LORA = 128
SHIFT_CONV = 3
LNX_EPS = 64e-5

CMLP_GROUPS = 4
CMLP_WIDTH = 512
CMLP_GROUP_CH = CMLP_WIDTH // CMLP_GROUPS
CHUNK = 128

N_BRANCH = 3
FFN_DENSE = 2816
N_EXPERTS = 8
TOP_K = 2
FFN_EXPERT = 3584
MOE_BLOCK = 128

IN_SIZES = (ATT_KV_WIDTH, ATT_KV_WIDTH, 3 * RWKV_WIDTH, 2 * DECAY_LORA, 2 * ICLR_LORA,
            ATT_WIDTH, GATE_LORA, 2 * CMLP_WIDTH, N_BRANCH * D_MODEL)
IN_OFFSETS = tuple(int(s) for s in np.cumsum(IN_SIZES)[:-1])
IN_WIDTH = int(sum(IN_SIZES))
CTX_STATE_WIDTH = IN_OFFSETS[4]

kernel_name = 'hybrid_flow_block'


def _rms(x, g):
    xf = x.astype(jnp.float32)
    y = xf * lax.rsqrt(jnp.mean(xf * xf, axis=-1, keepdims=True) + EPS)
    return (y * g.astype(jnp.float32)).astype(x.dtype)


def _layernorm(x, g, b, eps):
    xf = x.astype(jnp.float32)
    mu = jnp.mean(xf, axis=-1, keepdims=True)
    var = jnp.mean(jnp.square(xf - mu), axis=-1, keepdims=True)
    y = (xf - mu) * lax.rsqrt(var + eps)
    return (y * g.astype(jnp.float32) + b.astype(jnp.float32)).astype(x.dtype)


def _modulation(cvec, w, b):
    m = jax.nn.silu(cvec) @ w + b
    return [t[..., None, :] for t in jnp.split(m, 6, axis=-1)]


def _axial_rope_tables(n_tokens, dtype):
    rows = n_tokens // GRID_W
    row = jnp.repeat(jnp.arange(rows, dtype=jnp.float32), GRID_W)
    col = jnp.tile(jnp.arange(GRID_W, dtype=jnp.float32), rows)
    freqs = ROPE_BASE ** (-jnp.arange(ROPE_PAIRS, dtype=jnp.float32) / ROPE_PAIRS)
    ang_r = row[:, None] * freqs
    ang_c = col[:, None] * freqs
    return (jnp.cos(ang_r).astype(dtype), jnp.sin(ang_r).astype(dtype),
            jnp.cos(ang_c).astype(dtype), jnp.sin(ang_c).astype(dtype))


def _rot_half(x, cos, sin):
    x1, x2 = jnp.split(x, 2, axis=-1)
    cos = cos[:, None, :]
    sin = sin[:, None, :]
    return jnp.concatenate([x1 * cos - x2 * sin, x2 * cos + x1 * sin], axis=-1)


def _apply_rope(x, rope):
    cos_r, sin_r, cos_c, sin_c = rope
    xr, xc = jnp.split(x, 2, axis=-1)
    return jnp.concatenate([_rot_half(xr, cos_r, sin_r), _rot_half(xc, cos_c, sin_c)], axis=-1)


def _gqa_softmax(q, k, v):
    s = jnp.einsum('bqhgd,bkhd->bhgqk', q, k).astype(jnp.float32) * ATT_SCALE
    p = jax.nn.softmax(s, axis=-1).astype(v.dtype)
    return jnp.einsum('bhgqk,bkhd->bqhgd', p, v)


def _attention_branch(qc, kc, vc, ql, kl, vl, qk_gain, rope):
    B, T, _ = ql.shape
    C = kc.shape[1]
    ql = _apply_rope(_rms(ql.reshape(B, T, ATT_Q_HEADS, HEAD_DIM), qk_gain[0]), rope)
    kl = _apply_rope(_rms(kl.reshape(B, T, ATT_KV_HEADS, HEAD_DIM), qk_gain[1]), rope)
    kc = _rms(kc.reshape(B, C, ATT_KV_HEADS, HEAD_DIM), qk_gain[1])
    vl = vl.reshape(B, T, ATT_KV_HEADS, HEAD_DIM)
    vc = vc.reshape(B, C, ATT_KV_HEADS, HEAD_DIM)
    k_all = jnp.concatenate([kc, kl], axis=1)
    v_all = jnp.concatenate([vc, vl], axis=1)
    nb = T // Q_BLOCK
    qb = ql.reshape(B, nb, Q_BLOCK, ATT_KV_HEADS, GQA_GROUP, HEAD_DIM).transpose(1, 0, 2, 3, 4, 5)
    ol = lax.map(lambda q: _gqa_softmax(q, k_all, v_all), qb)
    ol = ol.transpose(1, 0, 2, 3, 4, 5).reshape(B, T, ATT_WIDTH)
    oc = None
    if qc is not None:
        qc = _rms(qc.reshape(B, C, ATT_Q_HEADS, HEAD_DIM), qk_gain[0])
        qc = qc.reshape(B, C, ATT_KV_HEADS, GQA_GROUP, HEAD_DIM)
        oc = _gqa_softmax(qc, kc, vc).reshape(B, C, ATT_WIDTH)
    return oc, ol


def _heads(t):
    return t.reshape(t.shape[:-1] + (RWKV_HEADS, RWKV_HEAD_DIM))


def _short_conv(x, w):
    L = x.shape[1]
    pad = SHIFT_CONV // 2
    xp = jnp.pad(x, ((0, 0), (pad, pad), (0, 0)))
    return sum(xp[:, j:j + L] * w[j] for j in range(SHIFT_CONV))


def _rwkv_prepare(rkv, w_low, a_low, conv_w, w0, w2, a0, a2, key_k):
    r, k, v = jnp.split(_short_conv(rkv, conv_w), 3, axis=-1)
    kk = _heads(k * key_k[0]).astype(jnp.float32)
    kk = kk * lax.rsqrt(jnp.sum(kk * kk, axis=-1, keepdims=True) + 1e-12)
    decays, keys, iclrs = [], [], []
    for d in range(2):
        wd = (w0[d] + jnp.tanh(w_low[..., d * DECAY_LORA:(d + 1) * DECAY_LORA]) @ w2[d]).astype(jnp.float32)
        decays.append(_heads(jnp.exp(-jnp.exp(-jax.nn.softplus(-wd) - 0.5))))
        ad = jax.nn.sigmoid(a0[d] + a_low[..., d * ICLR_LORA:(d + 1) * ICLR_LORA] @ a2[d])
        iclrs.append(_heads(ad))
        keys.append(_heads(k * (1 + (ad - 1) * key_k[1])))
    return _heads(r), _heads(k), _heads(v), kk, decays, keys, iclrs


def _rwkv_scan(S0, r, w, k, v, kk, a, reverse, emit):
    xs = tuple(jnp.moveaxis(t.astype(jnp.float32), 1, 0) for t in (r, w, k, v, kk, a))

    def step(S, inp):
        r_t, w_t, k_t, v_t, kk_t, a_t = inp
        sa = jnp.einsum('bhvk,bhk->bhv', S, -kk_t)
        S = (S * w_t[:, :, None, :] + sa[..., None] * (kk_t * a_t)[:, :, None, :]
             + v_t[..., None] * k_t[:, :, None, :])
        y = jnp.einsum('bhvk,bhk->bhv', S, r_t) if emit else None
        return S, y

    S, ys = lax.scan(step, S0, xs, reverse=reverse)
    return S, (jnp.moveaxis(ys, 0, 1) if emit else None)


def _rwkv_readout(y, r, k, v, g_low, r_k, g2, lnx_g, lnx_b):
    B, L = y.shape[:2]
    yn = _layernorm(y, lnx_g.reshape(RWKV_HEADS, RWKV_HEAD_DIM),
                    lnx_b.reshape(RWKV_HEADS, RWKV_HEAD_DIM), LNX_EPS).astype(v.dtype)
    bonus = jnp.sum(r * k * r_k, axis=-1, keepdims=True) * v
    g = jax.nn.sigmoid(g_low) @ g2
    return (yn + bonus).reshape(B, L, RWKV_WIDTH) * g


def _rwkv_branch(prep_c, prep_l, glow_c, glow_l, r_k, g2, lnx_g, lnx_b, need_ctx):
    rc, kc, vc, kkc, wc, kdc, ac = prep_c
    rl, kl, vl, kkl, wl, kdl, al = prep_l
    B = rl.shape[0]
    S0 = jnp.zeros((B, RWKV_HEADS, RWKV_HEAD_DIM, RWKV_HEAD_DIM), jnp.float32)
    yl = 0.0
    yc = 0.0
    for d in range(2):
        rev = d == 1
        Sc, ycd = _rwkv_scan(S0, rc, wc[d], kdc[d], vc, kkc, ac[d], rev, need_ctx)
        _, yld = _rwkv_scan(Sc, rl, wl[d], kdl[d], vl, kkl, al[d], rev, True)
        yl = yl + yld
        if need_ctx:
            yc = yc + ycd
    ol = _rwkv_readout(yl, rl, kl, vl, glow_l, r_k, g2, lnx_g, lnx_b)
    oc = _rwkv_readout(yc, rc, kc, vc, glow_c, r_k, g2, lnx_g, lnx_b) if need_ctx else None
    return oc, ol


def _chunk_mlp(uv, ln_g, ln_b, ws, bs):
    B, L, _ = uv.shape
    u, v = jnp.split(jax.nn.gelu(uv), 2, axis=-1)
    v = _layernorm(v, ln_g, ln_b, EPS)
    vb = v.reshape(B, L // CHUNK, CHUNK, CMLP_GROUPS, CMLP_GROUP_CH)
    s = jnp.einsum('gpq,bnqgc->bnpgc', ws, vb) + bs.T[:, :, None]
    return u * s.reshape(B, L, CMLP_WIDTH)


def _merge(oa, ob, oc, gates, w_branch, w_out):
    B, L, _ = gates.shape
    g = jax.nn.sigmoid(gates.reshape(B, L, N_BRANCH, D_MODEL))
    y = (g[:, :, 0] * (oa @ w_branch[0]) + g[:, :, 1] * (ob @ w_branch[1])
         + g[:, :, 2] * (oc @ w_branch[2]))
    return y @ w_out


def _token_mixer(hc, hl, rope, w_in, qk_gain, conv_w, w0, w2, a0, a2, key_k, r_k, g2,
                 lnx_g, lnx_b, ln_g, ln_b, ws, bs, w_branch, w_out, need_ctx):
    kl, vl, rkvl, wlow_l, alow_l, ql, glow_l, uvl, gates_l = jnp.split(hl @ w_in, IN_OFFSETS, axis=-1)
    if need_ctx:
        kc, vc, rkvc, wlow_c, alow_c, qc, glow_c, uvc, gates_c = jnp.split(hc @ w_in, IN_OFFSETS, axis=-1)
    else:
        kc, vc, rkvc, wlow_c, alow_c = jnp.split(hc @ w_in[:, :CTX_STATE_WIDTH], IN_OFFSETS[:4], axis=-1)
        qc, glow_c = None, None
    oa_c, oa_l = _attention_branch(qc, kc, vc, ql, kl, vl, qk_gain, rope)
    prep_l = _rwkv_prepare(rkvl, wlow_l, alow_l, conv_w, w0, w2, a0, a2, key_k)
    prep_c = _rwkv_prepare(rkvc, wlow_c, alow_c, conv_w, w0, w2, a0, a2, key_k)
    ob_c, ob_l = _rwkv_branch(prep_c, prep_l, glow_c, glow_l, r_k, g2, lnx_g, lnx_b, need_ctx)
    ol = _merge(oa_l, ob_l, _chunk_mlp(uvl, ln_g, ln_b, ws, bs), gates_l, w_branch, w_out)
    oc = None
    if need_ctx:
        oc = _merge(oa_c, ob_c, _chunk_mlp(uvc, ln_g, ln_b, ws, bs), gates_c, w_branch, w_out)
    return oc, ol


def _swiglu(h, w_gu, w_down):
    g, u = jnp.split(h @ w_gu, 2, axis=-1)
    return (jax.nn.silu(g) * u) @ w_down


def _moe_swiglu(h, w_router, w_gu, w_down):
    shp = h.shape
    tb = h.reshape(-1, MOE_BLOCK, shp[-1])

    def block(t):
        logits = (t @ w_router).astype(jnp.float32)
        top_v, top_i = lax.top_k(logits, TOP_K)
        wts = jax.nn.softmax(top_v, axis=-1)
        comb = jnp.sum(jax.nn.one_hot(top_i, N_EXPERTS, dtype=jnp.float32) * wts[..., None], axis=1)
        g, u = jnp.split(jnp.einsum('nd,edf->enf', t, w_gu), 2, axis=-1)
        y = jnp.einsum('enf,efd->end', jax.nn.silu(g) * u, w_down)
        return jnp.einsum('ne,end->nd', comb.astype(y.dtype), y)

    return lax.map(block, tb).reshape(shp)


def setup_inputs(seed: int = 0) -> dict:
    key = jax.random.key(seed)
    ks = iter(jax.random.split(key, 40))

    def nrm(shape, scale):
        return scale * jax.random.normal(next(ks), shape, jnp.float32)

    L = DEPTH
    nd = (DEPTH + 1) // 2
    nm = DEPTH // 2
    D = D_MODEL
    return {
        'x': nrm((BATCH, SEQ, D), 1.0),
        'c': nrm((BATCH, D), 1.0),
        'ctx': nrm((BATCH, CTX_LEN, D), 1.0),
        'c_ctx': nrm((D,), 1.0),
        'w_mod': nrm((L, D, 6 * D), 0.5 * D ** -0.5),
        'b_mod': nrm((L, 6 * D), 0.01),
        'norm_gain': 1.0 + nrm((L, 4, D), 0.05),
        'w_in': nrm((L, D, IN_WIDTH), D ** -0.5),
        'qk_gain': 1.0 + nrm((L, 2, HEAD_DIM), 0.05),
        'rwkv_conv': nrm((L, SHIFT_CONV, 3 * RWKV_WIDTH), SHIFT_CONV ** -0.5),
        'decay_w0': jax.random.uniform(next(ks), (L, 2, RWKV_WIDTH), jnp.float32, minval=-6.0, maxval=1.0),
        'decay_w2': nrm((L, 2, DECAY_LORA, RWKV_WIDTH), 0.5 * DECAY_LORA ** -0.5),
        'iclr_a0': nrm((L, 2, RWKV_WIDTH), 0.1),
        'iclr_a2': nrm((L, 2, ICLR_LORA, RWKV_WIDTH), 0.5 * ICLR_LORA ** -0.5),
        'key_k': jnp.array([0.85, 1.0], jnp.float32)[None, :, None] + nrm((L, 2, RWKV_WIDTH), 0.05),
        'bonus_rk': nrm((L, RWKV_HEADS, RWKV_HEAD_DIM), 0.1),
        'gate_g2': nrm((L, GATE_LORA, RWKV_WIDTH), GATE_LORA ** -0.5),
        'lnx_gain': 1.0 + nrm((L, RWKV_WIDTH), 0.05),
        'lnx_bias': nrm((L, RWKV_WIDTH), 0.01),
        'cmlp_ln_gain': 1.0 + nrm((L, CMLP_WIDTH), 0.05),
        'cmlp_ln_bias': nrm((L, CMLP_WIDTH), 0.01),
        'cmlp_ws': nrm((L, CMLP_GROUPS, CHUNK, CHUNK), CHUNK ** -0.5),
        'cmlp_bs': 1.0 + nrm((L, CMLP_GROUPS, CHUNK), 0.05),
        'w_branch': nrm((L, N_BRANCH, RWKV_WIDTH, D), RWKV_WIDTH ** -0.5),
        'w_out': nrm((L, D, D), D ** -0.5),
        'ffn_w_gu': nrm((nd, D, 2 * FFN_DENSE), D ** -0.5),
        'ffn_w_down': nrm((nd, FFN_DENSE, D), FFN_DENSE ** -0.5),
        'moe_router': nrm((nm, D, N_EXPERTS), D ** -0.5),
        'moe_w_gu': nrm((nm, N_EXPERTS, D, 2 * FFN_EXPERT), D ** -0.5),
        'moe_w_down': nrm((nm, N_EXPERTS, FFN_EXPERT, D), FFN_EXPERT ** -0.5),
    }


def reference(x, c, ctx, c_ctx, w_mod, b_mod, norm_gain, w_in, qk_gain, rwkv_conv, decay_w0,
              decay_w2, iclr_a0, iclr_a2, key_k, bonus_rk, gate_g2, lnx_gain, lnx_bias,
              cmlp_ln_gain, cmlp_ln_bias, cmlp_ws, cmlp_bs, w_branch, w_out, ffn_w_gu,
              ffn_w_down, moe_router, moe_w_gu, moe_w_down):
    xl, xc = x, ctx
    rope = _axial_rope_tables(xl.shape[1], xl.dtype)
    for l in range(DEPTH):
        last = l == DEPTH - 1
        sh1, sc1, ga1, sh2, sc2, ga2 = _modulation(c, w_mod[l], b_mod[l])
        csh1, csc1, cga1, csh2, csc2, cga2 = _modulation(c_ctx, w_mod[l], b_mod[l])
        ng = norm_gain[l]
        hl = _rms(xl, ng[0]) * (1 + sc1) + sh1
        hc = _rms(xc, ng[0]) * (1 + csc1) + csh1
        oc, ol = _token_mixer(hc, hl, rope, w_in[l], qk_gain[l], rwkv_conv[l], decay_w0[l],
                              decay_w2[l], iclr_a0[l], iclr_a2[l], key_k[l], bonus_rk[l],
                              gate_g2[l], lnx_gain[l], lnx_bias[l], cmlp_ln_gain[l],
                              cmlp_ln_bias[l], cmlp_ws[l], cmlp_bs[l], w_branch[l], w_out[l],
                              not last)
        xl = xl + ga1 * _rms(ol, ng[1])
        if not last:
            xc = xc + cga1 * _rms(oc, ng[1])
        if l % 2 == 0:
            def ffn(h, i=l // 2):
                return _swiglu(h, ffn_w_gu[i], ffn_w_down[i])
        else:
            def ffn(h, i=l // 2):
                return _moe_swiglu(h, moe_router[i], moe_w_gu[i], moe_w_down[i])
        hl = _rms(xl, ng[2]) * (1 + sc2) + sh2
        xl = xl + ga2 * _rms(ffn(hl), ng[3])
        if not last:
            hc = _rms(xc, ng[2]) * (1 + csc2) + csh2
            xc = xc + cga2 * _rms(ffn(hc), ng[3])
    return xl
```

```cpp
#include <hip/hip_runtime.h>
#include <cstdio>
#include <cstdint>


#define USE_SG32S 1
#define GEMM_REPEAT 0
#define CMLP_SCAN_SHARE 0
#define ATT_REPEAT 1

#define USE_SG 1
#define LDSZERO 1
#ifndef STOP_AFTER
#define STOP_AFTER 8
#endif

#define LAS __attribute__((address_space(3)))
#define GAS __attribute__((address_space(1)))
typedef unsigned short bf16_t;
typedef short bf16x8 __attribute__((ext_vector_type(8)));
typedef float f32x4 __attribute__((ext_vector_type(4)));
typedef float f32x16 __attribute__((ext_vector_type(16)));
typedef unsigned u32x4 __attribute__((ext_vector_type(4)));
typedef unsigned u32x2 __attribute__((ext_vector_type(2)));

constexpr int D = 1024, NB = 8, SEQ = 4096, CTXL = 256;
constexpr int NLAT = NB * SEQ, NCTX = NB * CTXL, MT = NLAT + NCTX, NKEY = CTXL + SEQ;
constexpr int PLD = 6912;
constexpr int PK = 0, PV = 128, PRKV = 256, PWLOW = 1792, PALOW = 1920, PGLOW = 2048, PQ = 2304, PUV = 2816, PGATE = 3840;
constexpr int FD = 2816, FE = 3584, NE = 8;
constexpr int INW = 6784;
constexpr int MOE_CAP_ROWS = 71680;
constexpr float EPS = 1e-6f;

constexpr size_t MiB = 1u << 20;
constexpr size_t WS_CTL = 0, CTL_BYTES = 1 * MiB;
constexpr size_t WS_MODV = 1 * MiB, WS_ROPE = 2 * MiB, WS_ROUTE = 3 * MiB, WS_PROW = 5 * MiB, WS_WCM = 6 * MiB, WS_WLORA = 8 * MiB;
constexpr size_t WS_WIN = 16 * MiB, WS_WBR = 70 * MiB, WS_WOUT = 82 * MiB, WS_WGU = 90 * MiB, WS_WDN = 112 * MiB, WS_MGU = 124 * MiB, WS_MDN = 348 * MiB;
constexpr size_t WS_XC = 460 * MiB, WS_H = 468 * MiB, WS_PROJ = 536 * MiB, WS_QN = 995 * MiB, WS_KN = 1029 * MiB, WS_VT = 1038 * MiB;
constexpr size_t WS_WDEC = 1047 * MiB, WS_AICLR = 1183 * MiB, WS_GG = 1251 * MiB, WS_YFB = 1285 * MiB, WS_OA = 1421 * MiB;
constexpr size_t WS_TMP = WS_WDEC, WS_YM = WS_AICLR, WS_OL = WS_YFB;
constexpr size_t WS_HID = 536 * MiB, WS_HPERM = 1026 * MiB, WS_YP = 1166 * MiB;
constexpr size_t WS_XB = 1523 * MiB;
constexpr size_t WS_END = 1591 * MiB;
constexpr size_t OABC_STRIDE = 34 * MiB / 2;
constexpr int CW_BAR = 4096, CW_MOE = 16384;

constexpr int LDS_BYTES = 147456, LDS_MISC = 131072;

struct Params { const float* in[30]; float* out; unsigned char* ws; int stop_after; int pad; };

__device__ __forceinline__ const float* inp(const Params& p, int k) { unsigned long long q = (unsigned long long)p.in[k]; asm volatile("" : "+s"(q)); return (const float*)(GAS const float*)q; }
__device__ __forceinline__ float* outp(const Params& p) { unsigned long long q = (unsigned long long)p.out; asm volatile("" : "+s"(q)); return (float*)(GAS float*)q; }
__device__ __forceinline__ int lane_id() { int l; asm volatile("v_mbcnt_lo_u32_b32 %0, -1, 0\n\tv_mbcnt_hi_u32_b32 %0, -1, %0" : "=v"(l)); return l; }
typedef __bf16 bf16x2_t __attribute__((ext_vector_type(2)));
typedef float f32x2_t __attribute__((ext_vector_type(2)));
__device__ __forceinline__ unsigned pk2(float lo, float hi) { f32x2_t v = {lo, hi}; bf16x2_t b = __builtin_convertvector(v, bf16x2_t); return __builtin_bit_cast(unsigned, b); }
__device__ __forceinline__ float bflo(unsigned u) { return __uint_as_float(u << 16); }
__device__ __forceinline__ float bfhi(unsigned u) { return __uint_as_float(u & 0xffff0000u); }
__device__ __forceinline__ float bf1(bf16_t b) { return __uint_as_float(((unsigned)b) << 16); }
__device__ __forceinline__ f32x4 unp4(u32x2 v) { return (f32x4){bflo(v.x), bfhi(v.x), bflo(v.y), bfhi(v.y)}; }
__device__ __forceinline__ float fexp2(float x) { return __builtin_amdgcn_exp2f(x); }
__device__ __forceinline__ float frcp(float x) { return __builtin_amdgcn_rcpf(x); }
__device__ __forceinline__ float frsq(float x) { return __builtin_amdgcn_rsqf(x); }
__device__ __forceinline__ float fsig(float x) { return frcp(1.f + fexp2(-1.44269504089f * x)); }
__device__ __forceinline__ float ftanh(float x) { return 2.f * fsig(2.f * x) - 1.f; }
__device__ __forceinline__ float fgelu(float x) { return x * fsig(1.5957691216f * (x + 0.044715f * x * x * x)); }
template <int CTRL> __device__ __forceinline__ float dppf(float v) { return __int_as_float(__builtin_amdgcn_update_dpp(0, __float_as_int(v), CTRL, 0xF, 0xF, true)); }
__device__ __forceinline__ float dpp_sum16(float v) {
    v += dppf<0xB1>(v); v += dppf<0x4E>(v); v += dppf<0x141>(v); v += dppf<0x140>(v); return v;
}
__device__ __forceinline__ float sum4(float v) { v += dppf<0xB1>(v); v += dppf<0x4E>(v); return v; }
__device__ __forceinline__ float sum8(float v) { v += dppf<0xB1>(v); v += dppf<0x4E>(v); v += dppf<0x141>(v); return v; }
__device__ __forceinline__ float rlf(float v, int l) { return __int_as_float(__builtin_amdgcn_readlane(__float_as_int(v), l)); }
__device__ __forceinline__ float wave_sum(float v) { v = dpp_sum16(v); return (rlf(v, 0) + rlf(v, 16)) + (rlf(v, 32) + rlf(v, 48)); }

#define XB_TMO      128
#define XB_XCNT(j)  (256  + 64 * (j))
#define XB_XSUB(j)  (1280 + 64 * (j))
#define XB_XGEN(j)  (2304 + 64 * (j))
#define XB_TOP      3328
#define XB_TOPGEN   3392
#define XCD_BAR_WORDS 3456
#define XB_SPIN_CAP (1u << 20)

__device__ __forceinline__ unsigned xb_ld(unsigned* p)              { return __hip_atomic_load(p, __ATOMIC_RELAXED, __HIP_MEMORY_SCOPE_AGENT); }
__device__ __forceinline__ unsigned xb_add(unsigned* p, unsigned v) { return __hip_atomic_fetch_add(p, v, __ATOMIC_RELAXED, __HIP_MEMORY_SCOPE_AGENT); }
__device__ __forceinline__ unsigned xb_xcc_id() { return (unsigned)__builtin_amdgcn_s_getreg((3 << 11) | 20) & 0xFu; }
#define XB_SPIN(cond, bar) do { unsigned _sp = 0; while (cond) { __builtin_amdgcn_s_sleep(1); \
    if ((++_sp & 255u) == 0u) { if (xb_ld(&(bar)[XB_TMO])) break; if (_sp > XB_SPIN_CAP) { atomicAdd(&(bar)[XB_TMO], 1u); break; } } } } while (0)

struct XcdBarrier { unsigned* bar; unsigned x; volatile LAS unsigned* st; };

__device__ __forceinline__ XcdBarrier xcd_barrier_post(unsigned* bar, volatile LAS unsigned* st) {
    XcdBarrier b; b.bar = bar; b.x = xb_xcc_id(); b.st = st;
    if (threadIdx.x == 0) (void)xb_add(&bar[XB_XCNT(b.x)], 1u);
    return b;
}
__device__ __forceinline__ void xcd_barrier_complete(unsigned* bar, unsigned x, unsigned& nloc, unsigned& nx) {
    const unsigned G = gridDim.x * gridDim.y * gridDim.z;
    unsigned sum, cnt, mine, sp = 0u;
    for (;;) {
        sum = 0u; cnt = 0u; mine = 0u;
#pragma unroll
        for (unsigned j = 0; j < 16; ++j) { const unsigned c = xb_ld(&bar[XB_XCNT(j)]); sum += c; cnt += (c > 0u) ? 1u : 0u; mine = (j == x) ? c : mine; }
        if (sum == G) break;
        __builtin_amdgcn_s_sleep(1);
        if ((++sp & 255u) == 0u) { if (xb_ld(&bar[XB_TMO])) break; if (sp > XB_SPIN_CAP) { atomicAdd(&bar[XB_TMO], 1u); break; } }
    }
    nloc = mine > 0u ? mine : 1u; nx = cnt > 0u ? cnt : 1u;
}
__device__ __forceinline__ void xcd_barrier(const XcdBarrier& b, const bool is_t0) {
    asm volatile("s_waitcnt vmcnt(0)" ::: "memory");
    __syncthreads();
    if (is_t0) {
        unsigned* bar = b.bar;
        __builtin_amdgcn_s_waitcnt(0);
        unsigned nloc = b.st[0], nx = b.st[1];
        if (nloc == 0u) { xcd_barrier_complete(bar, b.x, nloc, nx); b.st[0] = nloc; b.st[1] = nx; }
        const unsigned old = xb_add(&bar[XB_XSUB(b.x)], 1u);
        const unsigned gen = old / nloc;
        if (old + 1u == (gen + 1u) * nloc) {
            __builtin_amdgcn_fence(__ATOMIC_RELEASE, "agent");
            asm volatile("s_waitcnt vmcnt(0)" ::: "memory");
            const unsigned og = xb_add(&bar[XB_TOP], 1u);
            const unsigned tg = og / nx;
            if (og + 1u == (tg + 1u) * nx) xb_add(&bar[XB_TOPGEN], 1u);
            else XB_SPIN(xb_ld(&bar[XB_TOPGEN]) == tg, bar);
            __builtin_amdgcn_fence(__ATOMIC_ACQUIRE, "agent");
            xb_add(&bar[XB_XGEN(b.x)], 1u);
            asm volatile("s_waitcnt vmcnt(0)" ::: "memory");
        } else {
            XB_SPIN(xb_ld(&bar[XB_XGEN(b.x)]) == gen, bar);
            __builtin_amdgcn_fence(__ATOMIC_ACQUIRE, "agent");
            asm volatile("s_waitcnt vmcnt(0)" ::: "memory");
        }
    }
    __syncthreads();
}

namespace pg8 {
constexpr int BM = 256, BK = 64, HALF = 128, HTB = HALF * BK * 2, STAGE_BYTES = 8 * HTB, NXCD = 8, WGM = 8;
__host__ __device__ __forceinline__ int lds_byte(int r, int c) { const int st = (r >> 4) * 2 + (c >> 5), rr = r & 15, cc = c & 31, ob = rr * 64 + cc * 2; return st * 1024 + (ob ^ (((ob >> 9) & 1) << 5)); }
__host__ __device__ __forceinline__ void stage_rc(int b, int& R, int& C) { const int st = b / 1024, sb = b % 1024, swz = sb ^ (((sb >> 9) & 1) << 5); R = (st >> 1) * 16 + swz / 64; C = (st & 1) * 32 + (swz % 64) / 2; }
__host__ __device__ __forceinline__ int perm32(int rho) { const int n = rho >> 4, i = rho & 15; return 8 * (i >> 2) + 4 * n + (i & 3); }

struct Unit { int pm, pn, ga, gb; };
struct Gemm { const bf16_t* A; const bf16_t* Bt; int K, lda, ldb; size_t agstride, bgstride; };

struct StaticOrder {
    int nM, nN, nwg, G, c;
    __device__ void init(int nM_, int nN_, int G_, int c_) { nM = nM_; nN = nN_; nwg = nM * nN; G = G_; c = c_; }
    __device__ bool map(long L, Unit& u) const {
        if (L >= nwg) return false;
        int wgid = (int)L; { const int q = nwg / NXCD, r = nwg % NXCD, xcd = wgid % NXCD, off = wgid / NXCD; wgid = (xcd < r ? xcd * (q + 1) : r * (q + 1) + (xcd - r) * q) + off; }
        const int nig = WGM * nN, gid = wgid / nig, fm = gid * WGM, gsz = (nM - fm) < WGM ? (nM - fm) : WGM;
        u.pm = fm + ((wgid % nig) % gsz); u.pn = (wgid % nig) / gsz; u.ga = 0; u.gb = 0; return true;
    }
    __device__ bool next(int i, Unit& u) const { return map((long)i * G + c, u); }
    __device__ int kbeg(const Unit&) const { return 0; }
    __device__ int ksteps(const Unit&, int full) const { return full; }
};
struct InProjOrder {
    StaticOrder lat; int nlat, nctxN, ntot;
    __device__ void init2(int nMlat, int nMctx, int nN_, int nctxN_, int G_, int c_) { lat.init(nMlat, nN_, G_, c_); nlat = lat.nwg; nctxN = nctxN_; ntot = nlat + nMctx * nctxN_; }
    __device__ bool next(int i, Unit& u) const {
        const long Lx = (long)i * lat.G + lat.c;
        if (Lx >= ntot) return false;
        if (Lx < nlat) return lat.map(Lx, u);
        const int j = (int)(Lx - nlat); u.pm = lat.nM + j / nctxN; u.pn = j % nctxN; u.ga = 0; u.gb = 0; return true;
    }
    __device__ int kbeg(const Unit&) const { return 0; }
    __device__ int ksteps(const Unit&, int full) const { return full; }
};
struct LoraOrder : StaticOrder {
    __device__ int kbeg(const Unit& u) const { return u.pn < 8 ? 2 * (u.pn >> 1) : 8; }
    __device__ int ksteps(const Unit& u, int) const { return u.pn < 8 ? 2 : 4; }
};
struct MergeOrder : StaticOrder {
    __device__ bool next(int i, Unit& u) const { const int t = i / 3, br = i - 3 * t; if (!map((long)t * G + c, u)) return false; u.ga = br; u.gb = br; return true; }
};
struct GroupOrder : StaticOrder {
    const int* tsp;
    __device__ bool next(int i, Unit& u) const {
        if (!map((long)i * G + c, u)) return false;
        int e = 0;
#pragma unroll
        for (int j = 1; j < 8; ++j) e += (u.pm >= tsp[j]) ? 1 : 0;
        u.gb = __builtin_amdgcn_readfirstlane(e); return true;
    }
};

template <class Epi, class Sched>
__device__ __forceinline__ void gemm_phase(LAS unsigned char* lds, const int tid, const Gemm g, const Sched& S, const Epi& E) {
    const int wid = __builtin_amdgcn_readfirstlane(tid >> 6), lane = tid & 63, wr = wid >> 2, wc = wid & 3, fr = lane & 15, fq = lane >> 4;
    const int K = g.K, nt = K / BK;
    unsigned voffA[2], voffB[2];
#pragma unroll
    for (int i = 0; i < 2; ++i) { int R, C; stage_rc(tid * 16 + i * 8192, R, C); const int Rb = Epi::PERM ? ((R & ~31) + perm32(R & 31)) : R;
        voffA[i] = (unsigned)(R * g.lda + C) * 2u; voffB[i] = (unsigned)(Rb * g.ldb + C) * 2u; }
    const size_t kstep = (size_t)(BK * 2);
    const size_t hsA = (size_t)HALF * g.lda * 2, hsB = (size_t)HALF * g.ldb * 2;
    const size_t tsA = 2 * hsA, tsB = 2 * hsB;
    const unsigned ldsw = (unsigned)wid * 1024u;
    const int aoff = lds_byte(wr * 64 + fr, fq * 8), boff = lds_byte(wc * 32 + fr, fq * 8);
#define PG8_SA(b, h) (((b) * 2 + (h)) * HTB)
#define PG8_SB(b, h) ((4 + (b) * 2 + (h)) * HTB)
#define PG8_STAGE(bufoff, gbase, voff) do { _Pragma("unroll") for (int _i = 0; _i < 2; ++_i) \
        __builtin_amdgcn_global_load_lds((const unsigned*)((const char*)(gbase) + (voff)[_i]), (LAS unsigned*)(lds + (bufoff) + ldsw + _i * 8192), 16, 0, 0); } while (0)
#define PG8_LDA(dst, b, h) do { _Pragma("unroll") for (int m = 0; m < 4; ++m) _Pragma("unroll") for (int k = 0; k < 2; ++k) dst[m][k] = *(const LAS bf16x8*)(lds + PG8_SA(b, h) + aoff + m * 2048 + k * 1024); } while (0)
#define PG8_LDB(dst, b, h) do { _Pragma("unroll") for (int n = 0; n < 2; ++n) _Pragma("unroll") for (int k = 0; k < 2; ++k) dst[n][k] = *(const LAS bf16x8*)(lds + PG8_SB(b, h) + boff + n * 2048 + k * 1024); } while (0)
#define PG8_MMA(ai, bj, At, Bt) do { __builtin_amdgcn_s_setprio(1); _Pragma("unroll") for (int m = 0; m < 4; ++m) _Pragma("unroll") for (int n = 0; n < 2; ++n) _Pragma("unroll") for (int k = 0; k < 2; ++k) \
        acc[ai][bj][m][n] = __builtin_amdgcn_mfma_f32_16x16x32_bf16(Bt[n][k], At[m][k], acc[ai][bj][m][n], 0, 0, 0); __builtin_amdgcn_s_setprio(0); } while (0)
#define PG8_WAIT_V(n) asm volatile("s_waitcnt vmcnt(" #n ")" ::: "memory")
#define PG8_WAIT_L(n) asm volatile("s_waitcnt lgkmcnt(" #n ")" ::: "memory")
#define PG8_BAR __builtin_amdgcn_s_barrier()
#define PG8_SCHED __builtin_amdgcn_sched_barrier(0)
    Unit cur, nxt; int ui = 0;
    if (!S.next(0, cur)) return;
    f32x4 acc[2][2][4][2];
#pragma unroll
    for (int a = 0; a < 2; ++a)
#pragma unroll
        for (int b = 0; b < 2; ++b)
#pragma unroll
            for (int m = 0; m < 4; ++m)
#pragma unroll
                for (int n = 0; n < 2; ++n) acc[a][b][m][n] = (f32x4){0.f, 0.f, 0.f, 0.f};
    bf16x8 At[4][2], B0[2][2], B1[2][2];
    const char* cA = (const char*)g.A + ((size_t)cur.ga * g.agstride) * 2 + (size_t)cur.pm * tsA;
    const char* cB = (const char*)g.Bt + ((size_t)cur.gb * g.bgstride) * 2 + (size_t)cur.pn * tsB;
    PG8_STAGE(PG8_SB(0, 0), cB, voffB); PG8_STAGE(PG8_SA(0, 0), cA, voffA); PG8_STAGE(PG8_SB(0, 1), cB + hsB, voffB); PG8_STAGE(PG8_SA(0, 1), cA + hsA, voffA);
    if (wr == 1) PG8_BAR;
    PG8_WAIT_V(4); PG8_BAR;
    PG8_STAGE(PG8_SB(1, 0), cB + kstep, voffB); PG8_STAGE(PG8_SA(1, 0), cA + kstep, voffA); PG8_STAGE(PG8_SB(1, 1), cB + hsB + kstep, voffB);
    PG8_WAIT_V(6); PG8_BAR;
    for (;;) {
        const bool has_next = S.next(ui + 1, nxt);
        const char* nA = has_next ? (const char*)g.A + ((size_t)nxt.ga * g.agstride) * 2 + (size_t)nxt.pm * tsA : cA;
        const char* nB = has_next ? (const char*)g.Bt + ((size_t)nxt.gb * g.bgstride) * 2 + (size_t)nxt.pn * tsB : cB;
        for (int t = 0; t < nt; t += 2) {
            const bool last = (t == nt - 2);
            const char* a1 = cA + (size_t)(t + 1) * kstep;
            const char* a2 = last ? nA : cA + (size_t)(t + 2) * kstep; const char* b2 = last ? nB : cB + (size_t)(t + 2) * kstep;
            const char* a3 = a2 + kstep; const char* b3 = b2 + kstep;
            PG8_LDB(B0, 0, 0); PG8_SCHED; PG8_LDA(At, 0, 0); PG8_STAGE(PG8_SA(1, 1), a1 + hsA, voffA);
            PG8_WAIT_L(8); PG8_BAR; PG8_WAIT_L(0); PG8_MMA(0, 0, At, B0); PG8_BAR; PG8_SCHED;
            PG8_LDB(B1, 0, 1); PG8_STAGE(PG8_SB(0, 0), b2, voffB);
            PG8_BAR; PG8_WAIT_L(0); PG8_MMA(0, 1, At, B1); PG8_BAR;
            PG8_LDA(At, 0, 1); PG8_STAGE(PG8_SA(0, 0), a2, voffA);
            PG8_BAR; PG8_WAIT_L(0); PG8_MMA(1, 0, At, B0); PG8_BAR; PG8_SCHED;
            PG8_STAGE(PG8_SB(0, 1), b2 + hsB, voffB);
            PG8_WAIT_V(6); PG8_BAR; PG8_MMA(1, 1, At, B1); PG8_BAR;
            PG8_LDB(B0, 1, 0); PG8_SCHED; PG8_LDA(At, 1, 0); PG8_STAGE(PG8_SA(0, 1), a2 + hsA, voffA);
            PG8_WAIT_L(8); PG8_BAR; PG8_WAIT_L(0); PG8_MMA(0, 0, At, B0); PG8_BAR; PG8_SCHED;
            PG8_LDB(B1, 1, 1); PG8_STAGE(PG8_SB(1, 0), b3, voffB);
            PG8_BAR; PG8_WAIT_L(0); PG8_MMA(0, 1, At, B1); PG8_BAR;
            PG8_LDA(At, 1, 1); PG8_STAGE(PG8_SA(1, 0), a3, voffA);
            PG8_BAR; PG8_WAIT_L(0); PG8_MMA(1, 0, At, B0); PG8_BAR; PG8_SCHED;
            PG8_STAGE(PG8_SB(1, 1), b3 + hsB, voffB);
            PG8_WAIT_V(6); PG8_BAR; PG8_MMA(1, 1, At, B1); PG8_BAR;
        }
        { const int l2 = lane_id(); E(acc, cur, wr, wc, l2 & 15, l2 >> 4); }
        if (!has_next) break;
#pragma unroll
        for (int a = 0; a < 2; ++a)
#pragma unroll
            for (int b = 0; b < 2; ++b)
#pragma unroll
                for (int m = 0; m < 4; ++m)
#pragma unroll
                    for (int n = 0; n < 2; ++n) acc[a][b][m][n] = (f32x4){0.f, 0.f, 0.f, 0.f};
        cur = nxt; cA = nA; cB = nB; ++ui;
    }
    PG8_WAIT_V(0);
    if (wr == 0) PG8_BAR;
    PG8_BAR;
#undef PG8_SA
#undef PG8_SB
#undef PG8_STAGE
#undef PG8_LDA
#undef PG8_LDB
#undef PG8_MMA
#undef PG8_WAIT_V
#undef PG8_WAIT_L
#undef PG8_BAR
#undef PG8_SCHED
}


template <class Epi, class Sched>
__device__ __forceinline__ void gemm_simple(LAS unsigned char* lds, const int tid, const Gemm g, const Sched& S, const Epi& E) {
    const int wid = __builtin_amdgcn_readfirstlane(tid >> 6), lane = tid & 63, wr = wid >> 2, wc = wid & 3, fr = lane & 15, fq = lane >> 4;
    const int nt = g.K / 64, lrow = tid >> 3, lch = tid & 7;
    LAS unsigned char* As = lds; LAS unsigned char* Bs = lds + 36864;
    unsigned offA[4], offB[4];
#pragma unroll
    for (int i = 0; i < 4; ++i) { const int slot = lrow + 64 * i; const int br = Epi::PERM ? ((slot & ~31) + perm32(slot & 31)) : slot;
        offA[i] = (unsigned)(slot * g.lda + lch * 8) * 2u; offB[i] = (unsigned)(br * g.ldb + lch * 8) * 2u; }
    const unsigned wofs = (unsigned)(lrow * 144 + lch * 16);
    const unsigned aofs = (unsigned)((64 * wr + fr) * 144 + fq * 16), bofs = (unsigned)((32 * wc + fr) * 144 + fq * 16);
    Unit u;
    for (int ui = 0; S.next(ui, u); ++ui) {
        const char* Ab = (const char*)g.A + ((size_t)u.ga * g.agstride + (size_t)u.pm * 256 * g.lda) * 2;
        const char* Bb = (const char*)g.Bt + ((size_t)u.gb * g.bgstride + (size_t)u.pn * 256 * g.ldb) * 2;
        f32x4 acc[2][2][4][2];
#pragma unroll
        for (int a = 0; a < 2; ++a)
#pragma unroll
            for (int b = 0; b < 2; ++b)
#pragma unroll
                for (int m = 0; m < 4; ++m)
#pragma unroll
                    for (int n = 0; n < 2; ++n) acc[a][b][m][n] = (f32x4){0.f, 0.f, 0.f, 0.f};
        u32x4 ra[4], rb[4];
#pragma unroll
        for (int i = 0; i < 4; ++i) { ra[i] = *(const u32x4*)(Ab + offA[i]); rb[i] = *(const u32x4*)(Bb + offB[i]); }
        for (int t = 0; t < nt; ++t) {
            if (t > 0) __syncthreads();
#pragma unroll
            for (int i = 0; i < 4; ++i) { *(LAS u32x4*)(As + wofs + i * 9216) = ra[i]; *(LAS u32x4*)(Bs + wofs + i * 9216) = rb[i]; }
            __syncthreads();
            if (t + 1 < nt) { const char* An = Ab + (size_t)(t + 1) * 128; const char* Bn = Bb + (size_t)(t + 1) * 128;
#pragma unroll
                for (int i = 0; i < 4; ++i) { ra[i] = *(const u32x4*)(An + offA[i]); rb[i] = *(const u32x4*)(Bn + offB[i]); } }
#pragma unroll 1
            for (int kk = 0; kk < 2; ++kk) {
                bf16x8 Bf[2][2];
#pragma unroll
                for (int bj = 0; bj < 2; ++bj)
#pragma unroll
                    for (int n = 0; n < 2; ++n) Bf[bj][n] = *(const LAS bf16x8*)(Bs + bofs + (128 * bj + 16 * n) * 144 + kk * 64);
#pragma unroll
                for (int ai = 0; ai < 2; ++ai) {
                    bf16x8 Af[4];
#pragma unroll
                    for (int m = 0; m < 4; ++m) Af[m] = *(const LAS bf16x8*)(As + aofs + (128 * ai + 16 * m) * 144 + kk * 64);
#pragma unroll
                    for (int m = 0; m < 4; ++m)
#pragma unroll
                        for (int bj = 0; bj < 2; ++bj)
#pragma unroll
                            for (int n = 0; n < 2; ++n) acc[ai][bj][m][n] = __builtin_amdgcn_mfma_f32_16x16x32_bf16(Bf[bj][n], Af[m], acc[ai][bj][m][n], 0, 0, 0);
                }
            }
        }
        { const int l2 = lane_id(); E(acc, u, wr, wc, l2 & 15, l2 >> 4); }
        __syncthreads();
    }
}

template <class Epi, class Sched>
__device__ __forceinline__ void gemm_sg32(LAS unsigned char* lds, const int tid, const Gemm g, const Sched& S, const Epi& E) {
    const int wid = __builtin_amdgcn_readfirstlane(tid >> 6), lane = tid & 63, wr = wid >> 2, wc = wid & 3, fr = lane & 15, fq = lane >> 4;
    const int nt = g.K / 32, lrow = tid >> 2, lch = tid & 3;
    LAS unsigned char* As = lds; LAS unsigned char* Bs = lds + 20480;
    unsigned offA[2], offB[2];
#pragma unroll
    for (int i = 0; i < 2; ++i) { const int slot = lrow + 128 * i; const int br = Epi::PERM ? ((slot & ~31) + perm32(slot & 31)) : slot;
        offA[i] = (unsigned)(slot * g.lda + lch * 8) * 2u; offB[i] = (unsigned)(br * g.ldb + lch * 8) * 2u; }
    const unsigned wofs = (unsigned)(lrow * 80 + lch * 16);
    const unsigned aofs = (unsigned)((64 * wr + fr) * 80 + fq * 16), bofs = (unsigned)((32 * wc + fr) * 80 + fq * 16);
    Unit u;
    for (int ui = 0; S.next(ui, u); ++ui) {
        const char* Ab = (const char*)g.A + ((size_t)u.ga * g.agstride + (size_t)u.pm * 256 * g.lda) * 2;
        const char* Bb = (const char*)g.Bt + ((size_t)u.gb * g.bgstride + (size_t)u.pn * 256 * g.ldb) * 2;
        f32x4 acc[2][2][4][2];
#pragma unroll
        for (int a = 0; a < 2; ++a)
#pragma unroll
            for (int b = 0; b < 2; ++b)
#pragma unroll
                for (int m = 0; m < 4; ++m)
#pragma unroll
                    for (int n = 0; n < 2; ++n) acc[a][b][m][n] = (f32x4){0.f, 0.f, 0.f, 0.f};
        u32x4 ra[2], rb[2];
#pragma unroll
        for (int i = 0; i < 2; ++i) { ra[i] = *(const u32x4*)(Ab + offA[i]); rb[i] = *(const u32x4*)(Bb + offB[i]); }
#pragma unroll 1
        for (int t = 0; t < nt; ++t) {
            if (t > 0) __syncthreads();
#pragma unroll
            for (int i = 0; i < 2; ++i) { *(LAS u32x4*)(As + wofs + i * 10240) = ra[i]; *(LAS u32x4*)(Bs + wofs + i * 10240) = rb[i]; }
            __syncthreads();
            if (t + 1 < nt) { const char* An = Ab + (size_t)(t + 1) * 64; const char* Bn = Bb + (size_t)(t + 1) * 64;
#pragma unroll
                for (int i = 0; i < 2; ++i) { ra[i] = *(const u32x4*)(An + offA[i]); rb[i] = *(const u32x4*)(Bn + offB[i]); } }
            bf16x8 Bf[2][2];
#pragma unroll
            for (int bj = 0; bj < 2; ++bj)
#pragma unroll
                for (int n = 0; n < 2; ++n) Bf[bj][n] = *(const LAS bf16x8*)(Bs + bofs + (128 * bj + 16 * n) * 80);
#pragma unroll
            for (int ai = 0; ai < 2; ++ai) {
                bf16x8 Af[4];
#pragma unroll
                for (int m = 0; m < 4; ++m) Af[m] = *(const LAS bf16x8*)(As + aofs + (128 * ai + 16 * m) * 80);
#pragma unroll
                for (int m = 0; m < 4; ++m)
#pragma unroll
                    for (int bj = 0; bj < 2; ++bj)
#pragma unroll
                        for (int n = 0; n < 2; ++n) acc[ai][bj][m][n] = __builtin_amdgcn_mfma_f32_16x16x32_bf16(Bf[bj][n], Af[m], acc[ai][bj][m][n], 0, 0, 0);
            }
        }
        { const int l2 = lane_id(); E(acc, u, wr, wc, l2 & 15, l2 >> 4); }
        __syncthreads();
    }
}

template <class Epi, class Sched>
__device__ __forceinline__ void gemm_sg32d(LAS unsigned char* lds, const int tid, const Gemm g, const Sched& S, const Epi& E) {
    const int wid = __builtin_amdgcn_readfirstlane(tid >> 6), lane = tid & 63, wr = wid >> 2, wc = wid & 3, fr = lane & 15, fq = lane >> 4;
    const int nt = g.K / 32, lrow = tid >> 2, lch = tid & 3;
    unsigned offA[2], offB[2];
#pragma unroll
    for (int i = 0; i < 2; ++i) { const int slot = lrow + 128 * i; const int br = Epi::PERM ? ((slot & ~31) + perm32(slot & 31)) : slot;
        offA[i] = (unsigned)(slot * g.lda + lch * 8) * 2u; offB[i] = (unsigned)(br * g.ldb + lch * 8) * 2u; }
    const unsigned wofs = (unsigned)(lrow * 64 + ((lch ^ ((lrow >> 2) & 3)) * 16));
    const unsigned sw = (unsigned)((fq ^ ((fr >> 2) & 3)) * 16);
    const unsigned aofs = (unsigned)((64 * wr + fr) * 64) + sw, bofs = 16384u + (unsigned)((32 * wc + fr) * 64) + sw;
    Unit u;
    for (int ui = 0; S.next(ui, u); ++ui) {
        const char* Ab = (const char*)g.A + ((size_t)u.ga * g.agstride + (size_t)u.pm * 256 * g.lda) * 2;
        const char* Bb = (const char*)g.Bt + ((size_t)u.gb * g.bgstride + (size_t)u.pn * 256 * g.ldb) * 2;
        f32x4 acc[2][2][4][2];
#pragma unroll
        for (int a = 0; a < 2; ++a)
#pragma unroll
            for (int b = 0; b < 2; ++b)
#pragma unroll
                for (int m = 0; m < 4; ++m)
#pragma unroll
                    for (int n = 0; n < 2; ++n) acc[a][b][m][n] = (f32x4){0.f, 0.f, 0.f, 0.f};
        u32x4 ra[2], rb[2];
#pragma unroll
        for (int i = 0; i < 2; ++i) { ra[i] = *(const u32x4*)(Ab + offA[i]); rb[i] = *(const u32x4*)(Bb + offB[i]); }
#pragma unroll
        for (int i = 0; i < 2; ++i) { *(LAS u32x4*)(lds + wofs + i * 8192) = ra[i]; *(LAS u32x4*)(lds + 16384 + wofs + i * 8192) = rb[i]; }
        if (nt > 1) {
#pragma unroll
            for (int i = 0; i < 2; ++i) { ra[i] = *(const u32x4*)(Ab + 64 + offA[i]); rb[i] = *(const u32x4*)(Bb + 64 + offB[i]); } }
        __syncthreads();
#pragma unroll 1
        for (int t = 0; t < nt; ++t) {
            LAS unsigned char* cur = lds + (t & 1) * 32768;
            bf16x8 Bf[2][2], Af[2][4];
#pragma unroll
            for (int bj = 0; bj < 2; ++bj)
#pragma unroll
                for (int n = 0; n < 2; ++n) Bf[bj][n] = *(const LAS bf16x8*)(cur + bofs + (128 * bj + 16 * n) * 64);
#pragma unroll
            for (int ai = 0; ai < 2; ++ai)
#pragma unroll
                for (int m = 0; m < 4; ++m) Af[ai][m] = *(const LAS bf16x8*)(cur + aofs + (128 * ai + 16 * m) * 64);
            __builtin_amdgcn_sched_barrier(0);
            if (t + 1 < nt) {
                LAS unsigned char* nxt = lds + ((t + 1) & 1) * 32768;
#pragma unroll
                for (int i = 0; i < 2; ++i) { *(LAS u32x4*)(nxt + wofs + i * 8192) = ra[i]; *(LAS u32x4*)(nxt + 16384 + wofs + i * 8192) = rb[i]; }
                if (t + 2 < nt) { const char* An = Ab + (size_t)(t + 2) * 64; const char* Bn = Bb + (size_t)(t + 2) * 64;
#pragma unroll
                    for (int i = 0; i < 2; ++i) { ra[i] = *(const u32x4*)(An + offA[i]); rb[i] = *(const u32x4*)(Bn + offB[i]); } }
            }
            __builtin_amdgcn_sched_barrier(0);
#pragma unroll
            for (int ai = 0; ai < 2; ++ai)
#pragma unroll
                for (int m = 0; m < 4; ++m)
#pragma unroll
                    for (int bj = 0; bj < 2; ++bj)
#pragma unroll
                        for (int n = 0; n < 2; ++n) acc[ai][bj][m][n] = __builtin_amdgcn_mfma_f32_16x16x32_bf16(Bf[bj][n], Af[ai][m], acc[ai][bj][m][n], 0, 0, 0);
            __syncthreads();
        }
        { const int l2 = lane_id(); E(acc, u, wr, wc, l2 & 15, l2 >> 4); }
    }
}

template <class Epi, class Sched>
__device__ __forceinline__ void gemm_sg32s(LAS unsigned char* lds, const int tid, const Gemm g, const Sched& S, const Epi& E) {
    const int wid = __builtin_amdgcn_readfirstlane(tid >> 6), lane = tid & 63, wr = wid >> 2, wc = wid & 3, fr = lane & 15, fq = lane >> 4;
    const int ntfull = g.K / 32, lrow = tid >> 2, lch = tid & 3;
    const int br0 = Epi::PERM ? ((lrow & ~31) + perm32(lrow & 31)) : lrow;
    const int offA = (lrow * g.lda + lch * 8) * 2, offB = (br0 * g.ldb + lch * 8) * 2;
    const int dA = 128 * g.lda * 2, dB = 128 * g.ldb * 2;
    const unsigned wofs = (unsigned)(lrow * 64 + ((lch ^ ((0x78 >> (2 * ((lrow >> 2) & 3))) & 3)) * 16));
    const unsigned sw = (unsigned)((fq ^ ((0x78 >> (2 * ((fr >> 2) & 3))) & 3)) * 16);
    const unsigned frsw = (unsigned)(fr * 64) + sw; const int aofs = wr * 4096, bofs = 16384 + wc * 2048;
#define SGS_BAR() do { asm volatile("s_waitcnt lgkmcnt(0)" ::: "memory"); __builtin_amdgcn_s_barrier(); asm volatile("" ::: "memory"); } while (0)
#define SGS_LOAD(RA, RB, TT) do { const int _so = (TT) * 64; \
        RA[0] = __builtin_amdgcn_raw_buffer_load_b128(rsA, offA, _so, 0); RB[0] = __builtin_amdgcn_raw_buffer_load_b128(rsB, offB, _so, 0); \
        RA[1] = __builtin_amdgcn_raw_buffer_load_b128(rsA, offA, _so + dA, 0); RB[1] = __builtin_amdgcn_raw_buffer_load_b128(rsB, offB, _so + dB, 0); } while (0)
#define SGS_WRITE(RA, RB, BUFP) do { _Pragma("unroll") for (int i = 0; i < 2; ++i) { *(LAS u32x4*)((BUFP) + wofs + i * 8192) = RA[i]; *(LAS u32x4*)((BUFP) + 16384 + wofs + i * 8192) = RB[i]; } } while (0)
#define SGS_LDSPHASE(TT, RA, RB) do { \
            LAS unsigned char* cur = lds + ((TT) & 1) * 32768; \
            _Pragma("unroll") for (int bj = 0; bj < 2; ++bj) _Pragma("unroll") for (int n = 0; n < 2; ++n) Bf[bj][n] = *(const LAS bf16x8*)((cur + bofs) + frsw + (128 * bj + 16 * n) * 64); \
            _Pragma("unroll") for (int ai = 0; ai < 2; ++ai) _Pragma("unroll") for (int m = 0; m < 4; ++m) Af[ai][m] = *(const LAS bf16x8*)((cur + aofs) + frsw + (128 * ai + 16 * m) * 64); \
            if ((TT) + 1 < nt) { SGS_WRITE(RA, RB, lds + (((TT) + 1) & 1) * 32768); if ((TT) + 3 < nt) SGS_LOAD(RA, RB, (TT) + 3); } } while (0)
#define SGS_MMA() do { __builtin_amdgcn_sched_barrier(0); \
            _Pragma("unroll") for (int ai = 0; ai < 2; ++ai) _Pragma("unroll") for (int m = 0; m < 4; ++m) _Pragma("unroll") for (int bj = 0; bj < 2; ++bj) _Pragma("unroll") for (int n = 0; n < 2; ++n) \
                acc[ai][bj][m][n] = __builtin_amdgcn_mfma_f32_16x16x32_bf16(Bf[bj][n], Af[ai][m], acc[ai][bj][m][n], 0, 0, 0); \
            __builtin_amdgcn_sched_barrier(0); } while (0)
    Unit u;
    for (int ui = 0; S.next(ui, u); ++ui) {
        const int nt = S.ksteps(u, ntfull), kb = S.kbeg(u);
        const char* Ab = (const char*)g.A + ((size_t)u.ga * g.agstride + (size_t)u.pm * 256 * g.lda + (size_t)kb * 32) * 2;
        const char* Bb = (const char*)g.Bt + ((size_t)u.gb * g.bgstride + (size_t)u.pn * 256 * g.ldb + (size_t)kb * 32) * 2;
        f32x4 acc[2][2][4][2];
#pragma unroll
        for (int a = 0; a < 2; ++a)
#pragma unroll
            for (int b = 0; b < 2; ++b)
#pragma unroll
                for (int m = 0; m < 4; ++m)
#pragma unroll
                    for (int n = 0; n < 2; ++n) acc[a][b][m][n] = (f32x4){0.f, 0.f, 0.f, 0.f};
        u32x4 ra0[2], rb0[2], ra1[2], rb1[2];
        bf16x8 Bf[2][2], Af[2][4];
        int rs_nr = 0x7fffffff, rs_fl = 0x00020000; asm volatile("" : "+s"(rs_nr), "+s"(rs_fl));
        const __amdgpu_buffer_rsrc_t rsA = __builtin_amdgcn_make_buffer_rsrc((void*)Ab, 0, rs_nr, rs_fl);
        const __amdgpu_buffer_rsrc_t rsB = __builtin_amdgcn_make_buffer_rsrc((void*)Bb, 0, rs_nr, rs_fl);
        SGS_LOAD(ra0, rb0, 0);
        SGS_LOAD(ra1, rb1, 1);
        SGS_WRITE(ra0, rb0, lds);
        if (nt > 2) SGS_LOAD(ra0, rb0, 2);
        SGS_BAR();
        if (wr == 0) {
#pragma unroll 1
            for (int t = 0; t < nt; t += 2) {
                SGS_LDSPHASE(t, ra1, rb1); SGS_BAR(); SGS_MMA(); SGS_BAR();
                SGS_LDSPHASE(t + 1, ra0, rb0); SGS_BAR(); SGS_MMA(); SGS_BAR();
            }
        } else {
#pragma unroll 1
            for (int t = 0; t < nt; t += 2) {
                if (t > 0) SGS_MMA();
                SGS_BAR(); SGS_LDSPHASE(t, ra1, rb1); SGS_BAR();
                SGS_MMA();
                SGS_BAR(); SGS_LDSPHASE(t + 1, ra0, rb0); SGS_BAR();
            }
            SGS_MMA();
        }
        { const int l2 = lane_id(); E(acc, u, wr, wc, l2 & 15, l2 >> 4); }
    }
#undef SGS_BAR
#undef SGS_LOAD
#undef SGS_WRITE
#undef SGS_LDSPHASE
#undef SGS_MMA
}

template <class Epi, class Sched>
__device__ __forceinline__ void gemm_nolds(LAS unsigned char* lds, const int tid, const Gemm g, const Sched& S, const Epi& E) {
    const int wid = __builtin_amdgcn_readfirstlane(tid >> 6), lane = tid & 63, wr = wid >> 2, wc = wid & 3, fr = lane & 15, fq = lane >> 4;
    const int nt = g.K / 32;
    Unit u;
    for (int ui = 0; S.next(ui, u); ++ui) {
        const bf16_t* Ab = g.A + (size_t)u.ga * g.agstride + (size_t)u.pm * 256 * g.lda + fq * 8;
        const bf16_t* Bb = g.Bt + (size_t)u.gb * g.bgstride + (size_t)u.pn * 256 * g.ldb + fq * 8;
        f32x4 acc[2][2][4][2];
#pragma unroll
        for (int a = 0; a < 2; ++a)
#pragma unroll
            for (int b = 0; b < 2; ++b)
#pragma unroll
                for (int m = 0; m < 4; ++m)
#pragma unroll
                    for (int n = 0; n < 2; ++n) acc[a][b][m][n] = (f32x4){0.f, 0.f, 0.f, 0.f};
#pragma unroll 1
        for (int t = 0; t < nt; ++t) {
            bf16x8 Bf[2][2];
#pragma unroll
            for (int bj = 0; bj < 2; ++bj)
#pragma unroll
                for (int n = 0; n < 2; ++n) { const int slot = 128 * bj + 32 * wc + 16 * n + fr; const int br = Epi::PERM ? ((slot & ~31) + perm32(slot & 31)) : slot;
                    Bf[bj][n] = *(const bf16x8*)(Bb + (size_t)br * g.ldb + t * 32); }
#pragma unroll
            for (int ai = 0; ai < 2; ++ai) {
                bf16x8 Af[4];
#pragma unroll
                for (int m = 0; m < 4; ++m) Af[m] = *(const bf16x8*)(Ab + (size_t)(128 * ai + 64 * wr + 16 * m + fr) * g.lda + t * 32);
#pragma unroll
                for (int m = 0; m < 4; ++m)
#pragma unroll
                    for (int bj = 0; bj < 2; ++bj)
#pragma unroll
                        for (int n = 0; n < 2; ++n) acc[ai][bj][m][n] = __builtin_amdgcn_mfma_f32_16x16x32_bf16(Bf[bj][n], Af[m], acc[ai][bj][m][n], 0, 0, 0);
            }
        }
        { const int l2 = lane_id(); E(acc, u, wr, wc, l2 & 15, l2 >> 4); }
    }
}

typedef const f32x4 (&AccRef)[2][2][4][2];

enum { ACT_NONE = 0, ACT_TANH = 1, ACT_SIG = 2, ACT_GELU = 3 };
template <int ACT> __device__ __forceinline__ float actf(float x) {
    if (ACT == ACT_TANH) return ftanh(x);
    if (ACT == ACT_SIG) return fsig(x);
    if (ACT == ACT_GELU) return fgelu(x);
    return x;
}
template <int ACT> __device__ __forceinline__ u32x4 act_pack(f32x4 v0, f32x4 v1) {
    u32x4 w;
    w.x = pk2(actf<ACT>(v0[0]), actf<ACT>(v0[1])); w.y = pk2(actf<ACT>(v0[2]), actf<ACT>(v0[3]));
    w.z = pk2(actf<ACT>(v1[0]), actf<ACT>(v1[1])); w.w = pk2(actf<ACT>(v1[2]), actf<ACT>(v1[3]));
    return w;
}
constexpr int EPS_OFF = 65536;
struct EpiTr {
    LAS unsigned char* w; int rd, wr_;
    __device__ __forceinline__ EpiTr(int wave, int fr, int fq) {
        LAS unsigned char* base = (LAS unsigned char*)(size_t)0; asm volatile("" : "+v"(base));
        w = base + EPS_OFF + wave * 1024; const int L = fq * 16 + fr, r = L >> 2, c = L & 3;
        wr_ = fr * 64 + (((fq + (fr >> 2)) & 3) * 16); rd = r * 64 + (((c + (r >> 2)) & 3) * 16);
    }
    __device__ __forceinline__ u32x4 operator()(u32x4 v) const { *(LAS u32x4*)(w + wr_) = v; return *(const LAS u32x4*)(w + rd); }
};
struct EpiProj {
    static constexpr bool PERM = true;
    bf16_t* P;
    template <int A0, int A1> __device__ __forceinline__ void store(AccRef acc, const Unit& u, int wr, int wc, int fr, int fq) const {
        const EpiTr T(wr * 4 + wc, fr, fq); const int L = fq * 16 + fr;
        const int row0 = u.pm * BM + wr * 64 + (L >> 2), col0 = u.pn * BM + wc * 32 + 8 * (L & 3);
#pragma unroll
        for (int ai = 0; ai < 2; ++ai)
#pragma unroll
            for (int m = 0; m < 4; ++m) { bf16_t* rowp = P + (size_t)(row0 + ai * HALF + m * 16) * PLD + col0;
                __builtin_nontemporal_store(T(act_pack<A0>(acc[ai][0][m][0], acc[ai][0][m][1])), (u32x4*)(rowp));
                __builtin_nontemporal_store(T(act_pack<A1>(acc[ai][1][m][0], acc[ai][1][m][1])), (u32x4*)(rowp + HALF)); }
    }
    __device__ __forceinline__ void operator()(AccRef acc, const Unit& u, int wr, int wc, int fr, int fq) const {
        const int pn = u.pn;
        if (pn == 7) store<ACT_TANH, ACT_NONE>(acc, u, wr, wc, fr, fq);
        else if (pn == 8) store<ACT_SIG, ACT_NONE>(acc, u, wr, wc, fr, fq);
        else if (pn >= 11 && pn < 15) store<ACT_GELU, ACT_GELU>(acc, u, wr, wc, fr, fq);
        else if (pn >= 15) store<ACT_SIG, ACT_SIG>(acc, u, wr, wc, fr, fq);
        else store<ACT_NONE, ACT_NONE>(acc, u, wr, wc, fr, fq);
    }
};
struct EpiLora {
    static constexpr bool PERM = true;
    bf16_t* WDEC; bf16_t* AICLR; bf16_t* GG; const float* w0; const float* a0;
    __device__ __forceinline__ void operator()(AccRef acc, const Unit& u, int wr, int wc, int fr, int fq) const {
        const EpiTr T(wr * 4 + wc, fr, fq); const int L = fq * 16 + fr;
        const int rowT = u.pm * BM + wr * 64 + (L >> 2), pn = u.pn;
#pragma unroll
        for (int bj = 0; bj < 2; ++bj) {
            const int n0 = pn * BM + bj * HALF + wc * 32 + 8 * fq;
            const int nT = pn * BM + bj * HALF + wc * 32 + 8 * (L & 3);
            if (pn < 4) {
                const f32x4 b0 = *(const f32x4*)(w0 + n0), b1 = *(const f32x4*)(w0 + n0 + 4);
#pragma unroll
                for (int ai = 0; ai < 2; ++ai)
#pragma unroll
                    for (int m = 0; m < 4; ++m) { bf16_t* rp = WDEC + (size_t)(rowT + ai * HALF + m * 16) * 1024 + nT;
                        f32x4 x0 = acc[ai][bj][m][0] + b0, x1 = acc[ai][bj][m][1] + b1, o0, o1;
#pragma unroll
                        for (int j = 0; j < 4; ++j) { o0[j] = -0.8750375f * fsig(x0[j]); o1[j] = -0.8750375f * fsig(x1[j]); }
                        *(u32x4*)rp = T(act_pack<ACT_NONE>(o0, o1)); }
            } else if (pn < 8) {
                const int n1 = n0 - 1024;
                const f32x4 b0 = *(const f32x4*)(a0 + n1), b1 = *(const f32x4*)(a0 + n1 + 4);
#pragma unroll
                for (int ai = 0; ai < 2; ++ai)
#pragma unroll
                    for (int m = 0; m < 4; ++m) { bf16_t* rp = AICLR + (size_t)(rowT + ai * HALF + m * 16) * 1024 + (nT - 1024);
                        *(u32x4*)rp = T(act_pack<ACT_SIG>(acc[ai][bj][m][0] + b0, acc[ai][bj][m][1] + b1)); }
            } else {
#pragma unroll
                for (int ai = 0; ai < 2; ++ai)
#pragma unroll
                    for (int m = 0; m < 4; ++m) { bf16_t* rp = GG + (size_t)(rowT + ai * HALF + m * 16) * 512 + (nT - 2048);
                        *(u32x4*)rp = T(act_pack<ACT_NONE>(acc[ai][bj][m][0], acc[ai][bj][m][1])); }
            }
        }
    }
};
struct EpiMerge {
    static constexpr bool PERM = true;
    const bf16_t* P; bf16_t* TMP; bf16_t* YM;
    __device__ __forceinline__ void operator()(AccRef acc, const Unit& u, int wr, int wc, int fr, int fq) const {
        const EpiTr T(wr * 4 + wc, fr, fq); const int L = fq * 16 + fr;
        const int row0 = u.pm * BM + wr * 64 + fr, rowT = u.pm * BM + wr * 64 + (L >> 2), br = u.gb;
#pragma unroll
        for (int ai = 0; ai < 2; ++ai)
#pragma unroll
            for (int m = 0; m < 4; ++m) {
                const int row = row0 + ai * HALF + m * 16, rT = rowT + ai * HALF + m * 16;
#pragma unroll
                for (int bj = 0; bj < 2; ++bj) {
                    const int c0 = u.pn * BM + bj * HALF + wc * 32 + 8 * fq, cT = u.pn * BM + bj * HALF + wc * 32 + 8 * (L & 3);
                    const u32x4 gw = *(const u32x4*)(P + (size_t)row * PLD + PGATE + br * 1024 + c0);
                    f32x4 v0 = acc[ai][bj][m][0], v1 = acc[ai][bj][m][1];
                    v0[0] *= bflo(gw.x); v0[1] *= bfhi(gw.x); v0[2] *= bflo(gw.y); v0[3] *= bfhi(gw.y);
                    v1[0] *= bflo(gw.z); v1[1] *= bfhi(gw.z); v1[2] *= bflo(gw.w); v1[3] *= bfhi(gw.w);
                    u32x4 pk = T(act_pack<ACT_NONE>(v0, v1));
                    bf16_t* tp = TMP + (size_t)rT * 1024 + cT;
                    if (br != 0) {
                        const u32x4 t = *(const u32x4*)tp;
                        pk.x = pk2(bflo(pk.x) + bflo(t.x), bfhi(pk.x) + bfhi(t.x)); pk.y = pk2(bflo(pk.y) + bflo(t.y), bfhi(pk.y) + bfhi(t.y));
                        pk.z = pk2(bflo(pk.z) + bflo(t.z), bfhi(pk.z) + bfhi(t.z)); pk.w = pk2(bflo(pk.w) + bflo(t.w), bfhi(pk.w) + bfhi(t.w));
                    }
                    if (br == 2) *(u32x4*)(YM + (size_t)rT * 1024 + cT) = pk; else *(u32x4*)tp = pk;
                }
            }
    }
};
struct EpiF32 {
    static constexpr bool PERM = false;
    float* C; int ldc;
    __device__ __forceinline__ void operator()(AccRef acc, const Unit& u, int wr, int wc, int fr, int fq) const {
        const int row0 = u.pm * BM + wr * 64 + fr, col0 = u.pn * BM + wc * 32 + 4 * fq;
#pragma unroll
        for (int ai = 0; ai < 2; ++ai)
#pragma unroll
            for (int m = 0; m < 4; ++m) { float* rowp = C + (size_t)(row0 + ai * HALF + m * 16) * ldc + col0;
#pragma unroll
                for (int bj = 0; bj < 2; ++bj)
#pragma unroll
                    for (int n = 0; n < 2; ++n) *(f32x4*)(rowp + bj * HALF + n * 16) = acc[ai][bj][m][n]; }
    }
};
struct EpiBf16Out {
    static constexpr bool PERM = true;
    bf16_t* C; int ldc;
    __device__ __forceinline__ void operator()(AccRef acc, const Unit& u, int wr, int wc, int fr, int fq) const {
        const EpiTr T(wr * 4 + wc, fr, fq); const int L = fq * 16 + fr;
        const int row0 = u.pm * BM + wr * 64 + (L >> 2), col0 = u.pn * BM + wc * 32 + 8 * (L & 3);
#pragma unroll
        for (int ai = 0; ai < 2; ++ai)
#pragma unroll
            for (int m = 0; m < 4; ++m) { bf16_t* rowp = C + (size_t)(row0 + ai * HALF + m * 16) * ldc + col0;
                *(u32x4*)(rowp) = T(act_pack<ACT_NONE>(acc[ai][0][m][0], acc[ai][0][m][1]));
                *(u32x4*)(rowp + HALF) = T(act_pack<ACT_NONE>(acc[ai][1][m][0], acc[ai][1][m][1])); }
    }
};
struct EpiSwiglu {
    static constexpr bool PERM = true;
    bf16_t* Hd; int ldh;
    __device__ __forceinline__ void operator()(AccRef acc, const Unit& u, int wr, int wc, int fr, int fq) const {
        const EpiTr T(wr * 4 + wc, fr, fq); const int L = fq * 16 + fr;
        const int row0 = u.pm * BM + wr * 64 + (L >> 2), hc = u.pn * HALF + wc * 32 + 8 * (L & 3);
#pragma unroll
        for (int ai = 0; ai < 2; ++ai)
#pragma unroll
            for (int m = 0; m < 4; ++m) {
                f32x4 o0, o1;
#pragma unroll
                for (int j = 0; j < 4; ++j) { const float g0 = acc[ai][0][m][0][j], g1 = acc[ai][0][m][1][j];
                    o0[j] = g0 * fsig(g0) * acc[ai][1][m][0][j]; o1[j] = g1 * fsig(g1) * acc[ai][1][m][1][j]; }
                __builtin_nontemporal_store(T(act_pack<ACT_NONE>(o0, o1)), (u32x4*)(Hd + (size_t)(row0 + ai * HALF + m * 16) * ldh + hc));
            }
    }
};
}

#if defined(USE_SG32S)
#define GEMM_CALL pg8::gemm_sg32s
#elif defined(USE_SG32D)
#define GEMM_CALL pg8::gemm_sg32d
#elif defined(USE_SG32)
#define GEMM_CALL pg8::gemm_sg32
#elif defined(USE_NOLDS)
#define GEMM_CALL pg8::gemm_nolds
#elif defined(USE_SG)
#define GEMM_CALL pg8::gemm_simple
#else
#define GEMM_CALL pg8::gemm_phase
#endif
struct Frame {
    LAS unsigned char* lds;
    int tid, lane, wave, G, bx;
    GAS unsigned char* ws;
};
#define WSP(T, off) ((T*)(GAS T*)(F.ws + (off)))

__device__ __forceinline__ void transpose_item(const float* W, int K, int N, bf16_t* WT, size_t dest_row0, int k0, int n0, LAS float* scr, int lane) {
#pragma unroll 8
    for (int i = 0; i < 32; ++i) { const int kk = 2 * i + (lane >> 5); scr[kk * 33 + (lane & 31)] = W[(size_t)(k0 + kk) * N + n0 + (lane & 31)]; }
    asm volatile("s_waitcnt lgkmcnt(0)" ::: "memory");
    const int c = lane & 7;
#pragma unroll
    for (int j = 0; j < 4; ++j) { const int n = (lane >> 3) + 8 * j; const LAS float* s = scr + (8 * c) * 33 + n;
        u32x4 o; o.x = pk2(s[0 * 33], s[1 * 33]); o.y = pk2(s[2 * 33], s[3 * 33]); o.z = pk2(s[4 * 33], s[5 * 33]); o.w = pk2(s[6 * 33], s[7 * 33]);
        *(u32x4*)(WT + (dest_row0 + n) * (size_t)K + k0 + 8 * c) = o; }
    asm volatile("s_waitcnt lgkmcnt(0)" ::: "memory");
}
__device__ __forceinline__ int map_win(int n0) {
    if (n0 < 2048) return n0;
    if (n0 < 2560) return n0 - 2048 + PQ;
    if (n0 < 2688) return n0 - 2560 + PGLOW;
    if (n0 < 3712) return n0 - 2688 + PUV;
    return n0 - 3712 + PGATE;
}
__device__ __forceinline__ int map_gu(int n0, int Fh) {
    if (n0 < Fh) return 256 * (n0 >> 7) + (n0 & 127);
    const int c = n0 - Fh; return 256 * (c >> 7) + 128 + (c & 127);
}

namespace p0i {
constexpr int I0 = 16 * 212, I1 = 8 * 32, I2 = 16 * 32, I3 = 16 * 176, I4 = 44 * 32, I5 = 16 * 224, I6 = 56 * 32;
constexpr int C0 = 4 * I0, C1 = C0 + 12 * I1, C2 = C1 + 4 * I2, C3 = C2 + 2 * I3, C4 = C3 + 2 * I4, C5 = C4 + 16 * I5, C6 = C5 + 16 * I6;
constexpr int NSEG = 11;
__device__ __forceinline__ int def_item(int x) {
    const int beg[NSEG] = {C5, C4, 2 * I0, C0 + 6 * I1, C1 + 2 * I2, C2 + I3, C3 + I4, 3 * I0, C0 + 9 * I1, C1 + 3 * I2, C4 + 8 * I5};
    const int len[NSEG] = {8 * I6, 8 * I5, I0, 3 * I1, I2, I3, I4, I0, 3 * I1, I2, 8 * I5};
#pragma unroll
    for (int i = 0; i < NSEG; ++i) { if (x < len[i]) return beg[i] + x; x -= len[i]; }
    return C5 + 8 * I6 + x;
}
constexpr int DEF_TOTAL = 8 * I6 + 8 * I5 + (I0 + 3 * I1 + I2) + (I3 + I4) + (I0 + 3 * I1 + I2) + 8 * I5 + 8 * I6, SLOTN = DEF_TOTAL / 4;
static_assert(DEF_TOTAL % 4 == 0 && 2 * SLOTN >= 8 * I6 + 8 * I5 + I0 + 3 * I1 + I2 && 3 * SLOTN >= DEF_TOTAL - 8 * I5 - 8 * I6, "slot deadlines");
__device__ __forceinline__ bool deferred(int it) {
    if (it >= C4) return true;
    if (it < C0) return it >= 2 * I0;
    if (it < C1) return it >= C0 + 6 * I1;
    if (it < C2) return it >= C1 + 2 * I2;
    if (it < C3) return it >= C2 + I3;
    return it >= C3 + I4;
}
}
__device__ __forceinline__ void p0_item(Frame& F, const Params& p, int it, LAS float* scr) {
    using namespace p0i;
        if (it < C0) { const int mat = it / I0, r = it % I0, kb = r / 212, nb = r % 212;
            transpose_item(inp(p, 7) + (size_t)mat * 1024 * INW, 1024, INW, WSP(bf16_t, WS_WIN) + (size_t)mat * PLD * 1024, (size_t)map_win(nb * 32), kb * 64, nb * 32, scr, F.lane); }
        else if (it < C1) { const int q = it - C0, mat = q / I1, r = q % I1, kb = r / 32, nb = r % 32;
            transpose_item(inp(p, 23) + (size_t)mat * 512 * 1024, 512, 1024, WSP(bf16_t, WS_WBR) + (size_t)mat * 1024 * 512, (size_t)(nb * 32), kb * 64, nb * 32, scr, F.lane); }
        else if (it < C2) { const int q = it - C1, mat = q / I2, r = q % I2, kb = r / 32, nb = r % 32;
            transpose_item(inp(p, 24) + (size_t)mat * 1024 * 1024, 1024, 1024, WSP(bf16_t, WS_WOUT) + (size_t)mat * 1024 * 1024, (size_t)(nb * 32), kb * 64, nb * 32, scr, F.lane); }
        else if (it < C3) { const int q = it - C2, mat = q / I3, r = q % I3, kb = r / 176, nb = r % 176;
            transpose_item(inp(p, 25) + (size_t)mat * 1024 * 2 * FD, 1024, 2 * FD, WSP(bf16_t, WS_WGU) + (size_t)mat * 2 * FD * 1024, (size_t)map_gu(nb * 32, FD), kb * 64, nb * 32, scr, F.lane); }
        else if (it < C4) { const int q = it - C3, mat = q / I4, r = q % I4, kb = r / 32, nb = r % 32;
            transpose_item(inp(p, 26) + (size_t)mat * FD * 1024, FD, 1024, WSP(bf16_t, WS_WDN) + (size_t)mat * 1024 * FD, (size_t)(nb * 32), kb * 64, nb * 32, scr, F.lane); }
        else if (it < C5) { const int q = it - C4, mat = q / I5, r = q % I5, kb = r / 224, nb = r % 224;
            transpose_item(inp(p, 28) + (size_t)mat * 1024 * 2 * FE, 1024, 2 * FE, WSP(bf16_t, WS_MGU) + (size_t)mat * 2 * FE * 1024, (size_t)map_gu(nb * 32, FE), kb * 64, nb * 32, scr, F.lane); }
        else { const int q = it - C5, mat = q / I6, r = q % I6, kb = r / 32, nb = r % 32;
            transpose_item(inp(p, 29) + (size_t)mat * FE * 1024, FE, 1024, WSP(bf16_t, WS_MDN) + (size_t)mat * 1024 * FE, (size_t)(nb * 32), kb * 64, nb * 32, scr, F.lane); }
}
__device__ __forceinline__ void p0_slot(Frame& F, const Params& p, int l, int worker, int nw) {
    using namespace p0i;
    LAS float* scr = (LAS float*)(F.lds + F.wave * 16384);
    for (int x = worker; x < SLOTN; x += nw) p0_item(F, p, def_item(l * SLOTN + x), scr);
}
__device__ __forceinline__ void p0_prologue(Frame& F, const Params& p, bool split) {
    using namespace p0i;
    LAS float* scr = (LAS float*)(F.lds + F.wave * 16384);
    const int gw = F.bx * 8 + F.wave, NGW = F.G * 8;
    for (int it = gw; it < C6; it += NGW) {
        if (split && deferred(it)) continue;
        p0_item(F, p, it, scr);
    }
    const size_t gt = (size_t)F.bx * 512 + F.tid, NT = (size_t)F.G * 512;
    for (size_t i = gt; i < (size_t)4 * 2560 * 384; i += NT) {
        const int l = (int)(i / (2560 * 384)), r = (int)(i % (2560 * 384)), n = r / 384, k = r % 384, seg = n >> 9, c = n & 511;
        float v = 0.f;
        if (seg < 2) { const int kk = k - 64 * seg; if (kk >= 0 && kk < 64) v = inp(p, 11)[(((size_t)l * 2 + seg) * 64 + kk) * 512 + c]; }
        else if (seg < 4) { const int d = seg - 2, kk = k - 128 - 64 * d; if (kk >= 0 && kk < 64) v = inp(p, 13)[(((size_t)l * 2 + d) * 64 + kk) * 512 + c]; }
        else { const int kk = k - 256; if (kk >= 0) v = inp(p, 16)[((size_t)l * 128 + kk) * 512 + c]; }
        WSP(bf16_t, WS_WLORA)[i] = (bf16_t)pk2(v, 0.f);
    }
    for (size_t i = gt; i < (size_t)4 * 4 * 128 * 128; i += NT) WSP(bf16_t, WS_WCM)[i] = (bf16_t)pk2(inp(p, 21)[i], 0.f);
    for (size_t i = gt; i < (size_t)4 * 128 * 1024; i += NT) { const int l = (int)(i / (128 * 1024)), r = (int)(i % (128 * 1024));
        WSP(bf16_t, WS_WIN)[(size_t)l * PLD * 1024 + (size_t)(2176 + r / 1024) * 1024 + (r % 1024)] = 0; }
    if (gt < 1024) { const int pos = (int)gt >> 4, i = (int)gt & 15; const float fr = fexp2(-0.83048202372f * (float)i), rev = (float)pos * fr * 0.15915494309f;
        const float fx = rev - floorf(rev);
        WSP(float, WS_ROPE)[2 * gt] = __builtin_amdgcn_cosf(fx); WSP(float, WS_ROPE)[2 * gt + 1] = __builtin_amdgcn_sinf(fx); }
#ifdef NANFILL
    { u32x4* q = WSP(u32x4, WS_XC); const size_t n16 = (WS_END - WS_XC) / 16;
      for (size_t i = gt; i < n16; i += NT) q[i] = (u32x4){0x7fc07fc0u, 0x7fc07fc0u, 0x7fc07fc0u, 0x7fc07fc0u}; }
#endif
    __syncthreads();
    LAS float* sil = (LAS float*)F.lds;
    LAS float* red = (LAS float*)(F.lds + 36864);
    if (F.bx < 192) {
        for (int i = F.tid; i < 9 * 1024; i += 512) { const int v = i >> 10, k = i & 1023; const float cv = v < 8 ? inp(p, 1)[v * 1024 + k] : inp(p, 3)[k]; sil[i] = cv / (1.f + __expf(-cv)); }
        __syncthreads();
        for (int it = F.bx; it < 192; it += F.G) {
            const int l = it / 48, cc = it % 48, s = F.tid >> 7, col = F.tid & 127;
            const float* W = inp(p, 4) + (size_t)l * 1024 * 6144 + (size_t)cc * 128 + col;
            float a[9];
#pragma unroll
            for (int v = 0; v < 9; ++v) a[v] = 0.f;
#pragma unroll 4
            for (int k = s * 256; k < s * 256 + 256; ++k) { const float w = W[(size_t)k * 6144];
#pragma unroll
                for (int v = 0; v < 9; ++v) a[v] += sil[v * 1024 + k] * w; }
#pragma unroll
            for (int v = 0; v < 9; ++v) red[(s * 9 + v) * 128 + col] = a[v];
            __syncthreads();
            for (int i = F.tid; i < 9 * 128; i += 512) { const int v = i >> 7, c2 = i & 127;
                const float sum = red[(0 * 9 + v) * 128 + c2] + red[(1 * 9 + v) * 128 + c2] + red[(2 * 9 + v) * 128 + c2] + red[(3 * 9 + v) * 128 + c2];
                WSP(float, WS_MODV)[((size_t)l * 9 + v) * 6144 + cc * 128 + c2] = sum + inp(p, 5)[(size_t)l * 6144 + cc * 128 + c2]; }
            __syncthreads();
        }
    }
}

__device__ __forceinline__ bf16_t* xres_row(Frame& F, int r) { return WSP(bf16_t, WS_XB) + (size_t)r * D; }
__device__ __forceinline__ int row_mv(int r) { return r < NLAT ? (r >> 12) : 8; }
__device__ __forceinline__ void emit_h(Frame& F, const Params& p, const f32x4 (&xv)[4], int r, int l, int ngi, int sci, int shi, f32x4 (&hv)[4]) {
    float ss = 0.f;
#pragma unroll
    for (int j = 0; j < 4; ++j) ss += xv[j].x * xv[j].x + xv[j].y * xv[j].y + xv[j].z * xv[j].z + xv[j].w * xv[j].w;
    const float rstd = frsq(wave_sum(ss) * (1.f / D) + EPS);
    const float* ng = inp(p, 6) + ((size_t)l * 4 + ngi) * D;
    const float* mv = WSP(float, WS_MODV) + ((size_t)l * 9 + row_mv(r)) * 6144;
    bf16_t* hrow = WSP(bf16_t, WS_H) + (size_t)r * D;
#pragma unroll
    for (int j = 0; j < 4; ++j) { const int c = 4 * F.lane + 256 * j;
        const f32x4 g = *(const f32x4*)(ng + c), sc = *(const f32x4*)(mv + sci * 1024 + c), sh = *(const f32x4*)(mv + shi * 1024 + c);
        hv[j] = xv[j] * rstd * g * (sc + 1.f) + sh;
        u32x2 o; o.x = pk2(hv[j].x, hv[j].y); o.y = pk2(hv[j].z, hv[j].w);
        *(u32x2*)(hrow + c) = o; }
}
__device__ __forceinline__ void residual_update(Frame& F, const Params& p, const f32x4 (&fv)[4], const u32x2 (&xraw)[4], int r, int l, int ngi, int gai, f32x4 (&xv)[4], bool fin = false) {
    float ss = 0.f;
#pragma unroll
    for (int j = 0; j < 4; ++j) ss += fv[j].x * fv[j].x + fv[j].y * fv[j].y + fv[j].z * fv[j].z + fv[j].w * fv[j].w;
    const float rstd = frsq(wave_sum(ss) * (1.f / D) + EPS);
    const float* ng = inp(p, 6) + ((size_t)l * 4 + ngi) * D;
    const float* mv = WSP(float, WS_MODV) + ((size_t)l * 9 + row_mv(r)) * 6144;
    bf16_t* xr = xres_row(F, r);
#pragma unroll
    for (int j = 0; j < 4; ++j) { const int c = 4 * F.lane + 256 * j;
        const f32x4 g = *(const f32x4*)(ng + c), ga = *(const f32x4*)(mv + gai * 1024 + c), x0 = unp4(xraw[j]);
        xv[j] = x0 + ga * (fv[j] * rstd * g);
        if (fin) *(f32x4*)(outp(p) + (size_t)r * D + c) = xv[j];
        else { u32x2 o; o.x = pk2(xv[j].x, xv[j].y); o.y = pk2(xv[j].z, xv[j].w); *(u32x2*)(xr + c) = o; } }
}

__device__ __forceinline__ void load_gg(Frame& F, const Params& p, int l, int ngi, int gai, int mvidx, f32x4 (&gg)[4]) {
    const float* ng = inp(p, 6) + ((size_t)l * 4 + ngi) * D;
    const float* mv = WSP(float, WS_MODV) + ((size_t)l * 9 + mvidx) * 6144;
#pragma unroll
    for (int j = 0; j < 4; ++j) { const int c = 4 * F.lane + 256 * j; gg[j] = *(const f32x4*)(ng + c) * *(const f32x4*)(mv + gai * 1024 + c); }
}
__device__ __forceinline__ void load_gs(Frame& F, const Params& p, int l, int ngi, int sci, int shi, int mvidx, f32x4 (&gs)[4], f32x4 (&sh)[4]) {
    const float* ng = inp(p, 6) + ((size_t)l * 4 + ngi) * D;
    const float* mv = WSP(float, WS_MODV) + ((size_t)l * 9 + mvidx) * 6144;
#pragma unroll
    for (int j = 0; j < 4; ++j) { const int c = 4 * F.lane + 256 * j; gs[j] = *(const f32x4*)(ng + c) * (*(const f32x4*)(mv + sci * 1024 + c) + 1.f); sh[j] = *(const f32x4*)(mv + shi * 1024 + c); }
}
__device__ __forceinline__ void emit_h_v(Frame& F, const f32x4 (&xv)[4], int r, const f32x4 (&gs)[4], const f32x4 (&sh)[4], f32x4 (&hv)[4]) {
    float ss = 0.f;
#pragma unroll
    for (int j = 0; j < 4; ++j) ss += xv[j].x * xv[j].x + xv[j].y * xv[j].y + xv[j].z * xv[j].z + xv[j].w * xv[j].w;
    const float rstd = frsq(wave_sum(ss) * (1.f / D) + EPS);
    bf16_t* hrow = WSP(bf16_t, WS_H) + (size_t)r * D;
#pragma unroll
    for (int j = 0; j < 4; ++j) { const int c = 4 * F.lane + 256 * j;
        hv[j] = (xv[j] * rstd) * gs[j] + sh[j];
        u32x2 o; o.x = pk2(hv[j].x, hv[j].y); o.y = pk2(hv[j].z, hv[j].w);
        *(u32x2*)(hrow + c) = o; }
}
__device__ __forceinline__ void residual_update_v(Frame& F, const Params& p, const f32x4 (&fv)[4], const u32x2 (&xraw)[4], int r, const f32x4 (&gg)[4], f32x4 (&xv)[4], bool fin) {
    float ss = 0.f;
#pragma unroll
    for (int j = 0; j < 4; ++j) ss += fv[j].x * fv[j].x + fv[j].y * fv[j].y + fv[j].z * fv[j].z + fv[j].w * fv[j].w;
    const float rstd = frsq(wave_sum(ss) * (1.f / D) + EPS);
    bf16_t* xr = xres_row(F, r);
#pragma unroll
    for (int j = 0; j < 4; ++j) { const int c = 4 * F.lane + 256 * j;
        xv[j] = unp4(xraw[j]) + gg[j] * (fv[j] * rstd);
        if (fin) *(f32x4*)(outp(p) + (size_t)r * D + c) = xv[j];
        else { u32x2 o; o.x = pk2(xv[j].x, xv[j].y); o.y = pk2(xv[j].z, xv[j].w); *(u32x2*)(xr + c) = o; } }
}

__device__ __forceinline__ void p1_input(Frame& F, const Params& p) {
    const int gw = F.bx * 8 + F.wave, NGW = F.G * 8;
#pragma unroll 1
    for (int seg = 0; seg < 2; ++seg) {
        const int rbeg = seg == 0 ? (gw & 7) * 4096 + (gw >> 3) : NLAT + gw, rstep = seg == 0 ? (NGW >> 3) : NGW, rend = seg == 0 ? (gw & 7) * 4096 + 4096 : MT;
        if (rbeg >= rend) continue;
        f32x4 gs[4], sh[4];
        load_gs(F, p, 0, 0, 1, 0, seg == 0 ? (gw & 7) : 8, gs, sh);
#pragma unroll 2
        for (int r = rbeg; r < rend; r += rstep) {
            const float* src = r < NLAT ? inp(p, 0) + (size_t)r * D : inp(p, 2) + (size_t)(r - NLAT) * D;
            bf16_t* xr = xres_row(F, r);
            f32x4 xv[4], hv[4];
#pragma unroll
            for (int j = 0; j < 4; ++j) { xv[j] = *(const f32x4*)(src + 4 * F.lane + 256 * j); u32x2 o; o.x = pk2(xv[j].x, xv[j].y); o.y = pk2(xv[j].z, xv[j].w); *(u32x2*)(xr + 4 * F.lane + 256 * j) = o; }
            emit_h_v(F, xv, r, gs, sh, hv);
        }
    }
}

__device__ __forceinline__ void p3_qk(Frame& F, const Params& p, int l) {
    const int gw = F.bx * 8 + F.wave, NGW = F.G * 8, lane = F.lane, sub = lane & 7;
    const bf16_t* PROJ = WSP(bf16_t, WS_PROJ);
    const float* rope = WSP(float, WS_ROPE);
    const float* qg = inp(p, 8) + (size_t)l * 128;
    float qg_[2][8];
#pragma unroll
    for (int w = 0; w < 2; ++w)
#pragma unroll
        for (int j = 0; j < 8; ++j) qg_[w][j] = qg[w * 64 + 8 * sub + j];
#pragma unroll 2
    for (int r = gw; r < MT; r += NGW) {
        const bool islat = r < NLAT;
        const int b = islat ? (r >> 12) : ((r - NLAT) >> 8), t = islat ? (r & 4095) : ((r - NLAT) & 255), pos = islat ? 256 + t : t;
        const int ppos = (sub < 4) ? (t >> 6) : (t & 63);
        const float sgn = (sub & 2) ? 1.f : -1.f;
        f32x4 rp[4];
#pragma unroll
        for (int i = 0; i < 4; ++i) rp[i] = *(const f32x4*)(rope + (size_t)(ppos * 16 + 8 * (sub & 1)) * 2 + 4 * i);
#pragma unroll
        for (int which = 0; which < 2; ++which) {
            const int l2 = which ? (lane & 15) : lane;
            const u32x4 raw = *(const u32x4*)(PROJ + (size_t)r * PLD + (which ? PK : PQ) + l2 * 8);
            float x[8] = {bflo(raw.x), bfhi(raw.x), bflo(raw.y), bfhi(raw.y), bflo(raw.z), bfhi(raw.z), bflo(raw.w), bfhi(raw.w)};
            float ss = 0.f;
#pragma unroll
            for (int j = 0; j < 8; ++j) ss += x[j] * x[j];
            ss = sum8(ss);
            const float rstd = frsq(ss * (1.f / 64.f) + EPS);
            float y[8];
#pragma unroll
            for (int j = 0; j < 8; ++j) y[j] = x[j] * rstd * qg_[which][j];
#pragma unroll
            for (int j = 0; j < 8; ++j) { const float pr = dppf<0x4E>(y[j]);
                if (islat) { const float cs = rp[j >> 1][(j & 1) * 2], sn = rp[j >> 1][(j & 1) * 2 + 1]; x[j] = y[j] * cs + sgn * pr * sn; }
                else x[j] = y[j]; }
            const float sc = which ? 1.f : 0.18033688011f;
            u32x4 o; o.x = pk2(x[0] * sc, x[1] * sc); o.y = pk2(x[2] * sc, x[3] * sc); o.z = pk2(x[4] * sc, x[5] * sc); o.w = pk2(x[6] * sc, x[7] * sc);
            if (which == 0) *(u32x4*)(WSP(bf16_t, WS_QN) + ((size_t)(b * 8 + (lane >> 3)) * NKEY + pos) * 64 + 8 * sub) = o;
            else if (lane < 16) *(u32x4*)(WSP(bf16_t, WS_KN) + ((size_t)(b * 2 + (lane >> 3)) * NKEY + pos) * 64 + 8 * sub) = o;
        }
    }
}
__device__ __forceinline__ void p3_vt(Frame& F) {
    const bf16_t* PROJ = WSP(bf16_t, WS_PROJ);
    bf16_t* VT = WSP(bf16_t, WS_VT);
    LAS unsigned char* tile = F.lds;
    for (int it = F.bx; it < NB * 68; it += F.G) {
        const int b = it / 68, tb = it % 68, pos0 = tb * 64;
        const int row0 = tb < 4 ? NLAT + b * 256 + pos0 : b * 4096 + pos0 - 256;
        { const int tok = F.tid >> 3, ch = F.tid & 7; const bf16_t* src = PROJ + (size_t)(row0 + tok) * PLD + PV + 16 * ch;
          const u32x4 a = *(const u32x4*)src, c = *(const u32x4*)(src + 8);
          *(LAS u32x4*)(tile + tok * 272 + ch * 32) = a; *(LAS u32x4*)(tile + tok * 272 + ch * 32 + 16) = c; }
        __syncthreads();
        { const int dc = F.tid >> 2, tq = F.tid & 3; unsigned w[8];
#pragma unroll
          for (int i = 0; i < 8; ++i) { const unsigned lo = *(const LAS unsigned short*)(tile + (16 * tq + 2 * i) * 272 + dc * 2), hi = *(const LAS unsigned short*)(tile + (16 * tq + 2 * i + 1) * 272 + dc * 2); w[i] = lo | (hi << 16); }
          bf16_t* dst = VT + ((size_t)(b * 2 + (dc >> 6)) * 64 + (dc & 63)) * NKEY + pos0 + 16 * tq;
          *(u32x4*)dst = (u32x4){w[0], w[1], w[2], w[3]}; *(u32x4*)(dst + 8) = (u32x4){w[4], w[5], w[6], w[7]}; }
        __syncthreads();
    }
}

__device__ __forceinline__ void attn_unit(Frame& F, int b, int h, int qpos0, int nkeys, int orow0) {
    const int tid = F.tid, wave = F.wave, lane = F.lane, c = lane & 31, h2 = lane >> 5, kvh = h >> 2;
    const bf16_t* Kb = WSP(bf16_t, WS_KN) + (size_t)(b * 2 + kvh) * NKEY * 64;
    const bf16_t* Vb = WSP(bf16_t, WS_VT) + (size_t)(b * 2 + kvh) * 64 * NKEY;
    const bf16_t* Qb = WSP(bf16_t, WS_QN) + ((size_t)(b * 8 + h) * NKEY + qpos0 + wave * 32 + c) * 64;
    bf16x8 qf[4];
#pragma unroll
    for (int s = 0; s < 4; ++s) qf[s] = *(const bf16x8*)(Qb + 16 * s + 8 * h2);
    f32x16 O0, O1;
#pragma unroll
    for (int i = 0; i < 16; ++i) { O0[i] = 0.f; O1[i] = 0.f; }
    float mrun = 0.f, lsum = 0.f;
    f32x16 NM;
#pragma unroll
    for (int i = 0; i < 16; ++i) NM[i] = 0.f;
    const int skey = tid >> 3, sch = tid & 7, ntile = nkeys >> 6;
    LAS unsigned char* lds = F.lds;
    u32x4 kr = *(const u32x4*)(Kb + (size_t)skey * 64 + sch * 8);
    u32x4 vr = *(const u32x4*)(Vb + (size_t)skey * NKEY + sch * 8);
    u32x4 kr2 = kr, vr2 = vr;
    if (ntile > 1) { kr2 = *(const u32x4*)(Kb + (size_t)(64 + skey) * 64 + sch * 8); vr2 = *(const u32x4*)(Vb + (size_t)skey * NKEY + 64 + sch * 8); }
    *(LAS u32x4*)(lds + skey * 144 + sch * 16) = kr;
    const int vwo = skey * 144 + (sch >> 1) * 32 + (sch & 1) * 8;
    *(LAS u32x2*)(lds + 18432 + vwo) = (u32x2){vr.x, vr.y}; *(LAS u32x2*)(lds + 18432 + vwo + 16) = (u32x2){vr.z, vr.w};
    kr = kr2; vr = vr2;
    __syncthreads();
    auto tile_step = [&](const int t, u32x4& KX, u32x4& VX, u32x4& KY, u32x4& VY) {
        const int cur = t & 1;
        LAS unsigned char* kb = lds + cur * 9216;
        LAS unsigned char* vb = lds + 18432 + cur * 9216;
        if (t + 2 < ntile) { KY = *(const u32x4*)(Kb + (size_t)((t + 2) * 64 + skey) * 64 + sch * 8); VY = *(const u32x4*)(Vb + (size_t)skey * NKEY + (t + 2) * 64 + sch * 8); }
        f32x16 S0, S1;
#pragma unroll
        for (int s = 0; s < 4; ++s) {
            const bf16x8 a0 = *(const LAS bf16x8*)(kb + c * 144 + s * 32 + h2 * 16);
            const bf16x8 a1 = *(const LAS bf16x8*)(kb + (32 + c) * 144 + s * 32 + h2 * 16);
            S0 = __builtin_amdgcn_mfma_f32_32x32x16_bf16(a0, qf[s], s == 0 ? NM : S0, 0, 0, 0);
            S1 = __builtin_amdgcn_mfma_f32_32x32x16_bf16(a1, qf[s], s == 0 ? NM : S1, 0, 0, 0);
        }
        float mx = __builtin_fmaxf(__builtin_fmaxf(S0[0], S0[1]), S1[0]);
#pragma unroll
        for (int i = 1; i < 15; i += 2) mx = __builtin_fmaxf(__builtin_fmaxf(mx, S0[i + 1]), S0[i + 2 < 16 ? i + 2 : 15]);
#pragma unroll
        for (int i = 1; i < 16; i += 2) mx = __builtin_fmaxf(__builtin_fmaxf(mx, S1[i]), S1[i + 1 < 16 ? i + 1 : 15]);
        if (__builtin_amdgcn_ballot_w64(mx > 8.f) != 0ull) {
            const float mo = __int_as_float(__builtin_amdgcn_ds_bpermute((lane ^ 32) << 2, __float_as_int(mx)));
            const float m2 = fmaxf(mx, mo), d = m2 > 8.f ? m2 : 0.f, alpha = fexp2(-d);
            mrun += d; lsum *= alpha;
#pragma unroll
            for (int i = 0; i < 16; ++i) { S0[i] -= d; S1[i] -= d; O0[i] *= alpha; O1[i] *= alpha; NM[i] = -mrun; }
        }
        f32x2_t rs2 = (f32x2_t){0.f, 0.f};
#pragma unroll
        for (int i = 0; i < 16; i += 2) { S0[i] = fexp2(S0[i]); S0[i + 1] = fexp2(S0[i + 1]); S1[i] = fexp2(S1[i]); S1[i + 1] = fexp2(S1[i + 1]);
            rs2 += (f32x2_t){S0[i], S0[i + 1]}; rs2 += (f32x2_t){S1[i], S1[i + 1]}; }
        lsum += rs2.x + rs2.y;
        bf16x8 pf[4];
        { u32x4 w;
          w.x = pk2(S0[0], S0[1]); w.y = pk2(S0[2], S0[3]); w.z = pk2(S0[4], S0[5]); w.w = pk2(S0[6], S0[7]); pf[0] = __builtin_bit_cast(bf16x8, w);
          w.x = pk2(S0[8], S0[9]); w.y = pk2(S0[10], S0[11]); w.z = pk2(S0[12], S0[13]); w.w = pk2(S0[14], S0[15]); pf[1] = __builtin_bit_cast(bf16x8, w);
          w.x = pk2(S1[0], S1[1]); w.y = pk2(S1[2], S1[3]); w.z = pk2(S1[4], S1[5]); w.w = pk2(S1[6], S1[7]); pf[2] = __builtin_bit_cast(bf16x8, w);
          w.x = pk2(S1[8], S1[9]); w.y = pk2(S1[10], S1[11]); w.z = pk2(S1[12], S1[13]); w.w = pk2(S1[14], S1[15]); pf[3] = __builtin_bit_cast(bf16x8, w); }
#pragma unroll
        for (int ks = 0; ks < 4; ++ks) {
            const bf16x8 va0 = *(const LAS bf16x8*)(vb + c * 144 + 32 * ks + 16 * h2), va1 = *(const LAS bf16x8*)(vb + (32 + c) * 144 + 32 * ks + 16 * h2);
            O0 = __builtin_amdgcn_mfma_f32_32x32x16_bf16(va0, pf[ks], O0, 0, 0, 0);
            O1 = __builtin_amdgcn_mfma_f32_32x32x16_bf16(va1, pf[ks], O1, 0, 0, 0);
        }
        if (t + 1 < ntile) {
            LAS unsigned char* kn = lds + (cur ^ 1) * 9216; LAS unsigned char* vn = lds + 18432 + (cur ^ 1) * 9216;
            *(LAS u32x4*)(kn + skey * 144 + sch * 16) = KX;
            *(LAS u32x2*)(vn + vwo) = (u32x2){VX.x, VX.y}; *(LAS u32x2*)(vn + vwo + 16) = (u32x2){VX.z, VX.w};
        }
        __syncthreads();
    };
    for (int t = 0; t < ntile; t += 2) { tile_step(t, kr, vr, kr2, vr2); tile_step(t + 1, kr2, vr2, kr, vr); }
    lsum += __int_as_float(__builtin_amdgcn_ds_bpermute((lane ^ 32) << 2, __float_as_int(lsum)));
    const float inv = 1.f / lsum;
    bf16_t* orow = WSP(bf16_t, WS_OA) + (size_t)(orow0 + wave * 32 + c) * 512 + h * 64;
#pragma unroll
    for (int g4 = 0; g4 < 4; ++g4) {
        u32x2 o0, o1;
        o0.x = pk2(O0[4 * g4] * inv, O0[4 * g4 + 1] * inv); o0.y = pk2(O0[4 * g4 + 2] * inv, O0[4 * g4 + 3] * inv);
        o1.x = pk2(O1[4 * g4] * inv, O1[4 * g4 + 1] * inv); o1.y = pk2(O1[4 * g4 + 2] * inv, O1[4 * g4 + 3] * inv);
        *(u32x2*)(orow + 8 * g4 + 4 * h2) = o0; *(u32x2*)(orow + 32 + 8 * g4 + 4 * h2) = o1;
    }
}

struct ScanRaw { u32x2 x[3][3]; u32x2 a; u32x2 w; float mp, mn; };
__device__ __forceinline__ void scan_unit(Frame& F, const Params& p, int l, int cid) {
    const int tid = F.tid, sidx = tid >> 4, j = tid & 15;
    const int b = cid >> 5, h = (cid >> 2) & 7, dir = (cid >> 1) & 1, half = cid & 1;
    const int ch = h * 64 + 4 * j;
    const bf16_t* PROJ = WSP(bf16_t, WS_PROJ);
    const bf16_t* AIC = WSP(bf16_t, WS_AICLR);
    const bf16_t* WDEC = WSP(bf16_t, WS_WDEC);
    float* Y = WSP(float, WS_YFB) + (size_t)dir * MT * 512;
    const float* cw = inp(p, 9) + (size_t)l * 3 * 1536;
    f32x4 cwr[3], cwk[3], cwv[3];
#pragma unroll
    for (int tp = 0; tp < 3; ++tp) { cwr[tp] = *(const f32x4*)(cw + tp * 1536 + ch); cwk[tp] = *(const f32x4*)(cw + tp * 1536 + 512 + ch); cwv[tp] = *(const f32x4*)(cw + tp * 1536 + 1024 + ch); }
    const f32x4 kk0 = *(const f32x4*)(inp(p, 14) + (size_t)l * 1024 + ch), kk1 = *(const f32x4*)(inp(p, 14) + (size_t)l * 1024 + 512 + ch);
    f32x2_t SL = (f32x2_t){0.f, 0.f}, SH = (f32x2_t){0.f, 0.f};
    LAS unsigned char* lds = F.lds;
    constexpr int REC = 1408, BUF = 32 * REC;

    auto load_raw = [&](int c, ScanRaw& R) {
        const bool isctx = c < 8; const int cc = isctx ? c : c - 8, L = isctx ? 256 : 4096, base = isctx ? NLAT + b * 256 : b * 4096;
        const int t = dir ? (L - 1 - 32 * cc - sidx) : (32 * cc + sidx), row = base + t;
        R.mp = t > 0 ? 1.f : 0.f; R.mn = t < L - 1 ? 1.f : 0.f;
        const int rp = t > 0 ? row - 1 : row, rn = t < L - 1 ? row + 1 : row;
        const bf16_t* q0 = PROJ + (size_t)rp * PLD + PRKV + ch; const bf16_t* q1 = PROJ + (size_t)row * PLD + PRKV + ch; const bf16_t* q2 = PROJ + (size_t)rn * PLD + PRKV + ch;
#pragma unroll
        for (int k = 0; k < 3; ++k) { R.x[0][k] = *(const u32x2*)(q0 + 512 * k); R.x[1][k] = *(const u32x2*)(q1 + 512 * k); R.x[2][k] = *(const u32x2*)(q2 + 512 * k); }
        R.a = *(const u32x2*)(AIC + (size_t)row * 1024 + dir * 512 + ch);
        R.w = *(const u32x2*)(WDEC + (size_t)row * 1024 + dir * 512 + ch);
    };
    auto finish = [&](const ScanRaw& R, LAS unsigned char* buf) {
        const f32x4 r = cwr[0] * unp4(R.x[0][0]) * R.mp + cwr[1] * unp4(R.x[1][0]) + cwr[2] * unp4(R.x[2][0]) * R.mn;
        const f32x4 k = cwk[0] * unp4(R.x[0][1]) * R.mp + cwk[1] * unp4(R.x[1][1]) + cwk[2] * unp4(R.x[2][1]) * R.mn;
        const f32x4 v = cwv[0] * unp4(R.x[0][2]) * R.mp + cwv[1] * unp4(R.x[1][2]) + cwv[2] * unp4(R.x[2][2]) * R.mn;
        f32x4 kkv = k * kk0;
        float ss = kkv.x * kkv.x + kkv.y * kkv.y + kkv.z * kkv.z + kkv.w * kkv.w;
        ss = dpp_sum16(ss);
        kkv = kkv * frsq(ss + 1e-12f);
        const f32x4 a = unp4(R.a);
        const f32x4 kt = k * ((a - 1.f) * kk1 + 1.f);
        const f32x4 bb = kkv * a;
        LAS unsigned char* rec = buf + sidx * REC;
        { const f32x4 lw = unp4(R.w); *(LAS f32x4*)(rec + j * 16) = (f32x4){fexp2(lw.x), fexp2(lw.y), fexp2(lw.z), fexp2(lw.w)}; } *(LAS f32x4*)(rec + 256 + j * 16) = r; *(LAS f32x4*)(rec + 512 + j * 16) = kt;
        *(LAS f32x4*)(rec + 768 + j * 16) = kkv; *(LAS f32x4*)(rec + 1024 + j * 16) = bb;
        if ((j >> 3) == half) *(LAS f32x4*)(rec + 1280 + (j & 7) * 16) = v;
    };
    ScanRaw R;
    load_raw(0, R); finish(R, lds); __syncthreads();
    for (int c = 0; c < 136; ++c) {
        if (c + 1 < 136) load_raw(c + 1, R);
        {
            const bool isctx = c < 8; const int cc = isctx ? c : c - 8, L = isctx ? 256 : 4096, base = isctx ? NLAT + b * 256 : b * 4096;
            const int t0 = dir ? (L - 1 - 32 * cc) : (32 * cc);
            const int ysgn = dir ? -1 : 1;
            float* yb = Y + (size_t)(base + t0 + ysgn * j) * 512 + h * 64 + 32 * half + sidx;
            const ptrdiff_t ystep16 = (ptrdiff_t)ysgn * 16 * 512;
            const LAS unsigned char* buf = lds;
            float ykeep = 0.f, qp = 0.f;
            f32x4 w = *(const LAS f32x4*)(buf + j * 16), rr = *(const LAS f32x4*)(buf + 256 + j * 16), kt = *(const LAS f32x4*)(buf + 512 + j * 16);
            f32x4 kkv = *(const LAS f32x4*)(buf + 768 + j * 16), bb = *(const LAS f32x4*)(buf + 1024 + j * 16);
            float vv = *(const LAS float*)(buf + 1280 + sidx * 4);
#pragma unroll
            for (int s = 0; s < 32; ++s) {
                const LAS unsigned char* nrec = buf + (s < 31 ? s + 1 : 31) * REC;
                const f32x4 nw = *(const LAS f32x4*)(nrec + j * 16), nrr = *(const LAS f32x4*)(nrec + 256 + j * 16), nkt = *(const LAS f32x4*)(nrec + 512 + j * 16);
                const f32x4 nkk = *(const LAS f32x4*)(nrec + 768 + j * 16), nbb = *(const LAS f32x4*)(nrec + 1024 + j * 16);
                const float nvv = *(const LAS float*)(nrec + 1280 + sidx * 4);
                __builtin_amdgcn_sched_barrier(0);
                const f32x2_t pdv = SL * (f32x2_t){kkv.x, kkv.y} + SH * (f32x2_t){kkv.z, kkv.w};
                float pd = pdv.x + pdv.y;
                pd += dppf<0xB1>(pd); qp += dppf<0xB1>(qp);
                pd += dppf<0x4E>(pd); qp += dppf<0x4E>(qp);
                pd += dppf<0x141>(pd); qp += dppf<0x141>(qp);
                pd += dppf<0x140>(pd); qp += dppf<0x140>(qp);
                if (s > 0) { ykeep = (((s - 1) & 15) == j) ? qp : ykeep; if (((s - 1) & 15) == 15) { *yb = ykeep; yb += ystep16; } }
                const f32x2_t sa2 = (f32x2_t){-pd, -pd}, vv2 = (f32x2_t){vv, vv};
                SL = SL * (f32x2_t){w.x, w.y} + ((f32x2_t){bb.x, bb.y} * sa2 + (f32x2_t){kt.x, kt.y} * vv2);
                SH = SH * (f32x2_t){w.z, w.w} + ((f32x2_t){bb.z, bb.w} * sa2 + (f32x2_t){kt.z, kt.w} * vv2);
                const f32x2_t qv = SL * (f32x2_t){rr.x, rr.y} + SH * (f32x2_t){rr.z, rr.w};
                qp = qv.x + qv.y;
                w = nw; rr = nrr; kt = nkt; kkv = nkk; bb = nbb; vv = nvv;
            }
            qp = dpp_sum16(qp);
            ykeep = (j == 15) ? qp : ykeep;
            *yb = ykeep;
        }
        __syncthreads();
        if (c + 1 < 136) finish(R, lds);
        __syncthreads();
    }
}

__device__ __forceinline__ void scan_unit2(Frame& F, const Params& p, int l, int cid) {
    const int tid = F.tid, sidx = tid >> 4, j = tid & 15;
    const int b = cid >> 4, h = (cid >> 1) & 7, dir = cid & 1;
    const int ch = h * 64 + 4 * j;
    const bf16_t* PROJ = WSP(bf16_t, WS_PROJ);
    const bf16_t* AIC = WSP(bf16_t, WS_AICLR);
    const bf16_t* WDEC = WSP(bf16_t, WS_WDEC);
    float* Y = WSP(float, WS_YFB) + (size_t)dir * MT * 512;
    const float* cw = inp(p, 9) + (size_t)l * 3 * 1536;
    f32x4 cwr[3], cwk[3], cwv[3];
#pragma unroll
    for (int tp = 0; tp < 3; ++tp) { cwr[tp] = *(const f32x4*)(cw + tp * 1536 + ch); cwk[tp] = *(const f32x4*)(cw + tp * 1536 + 512 + ch); cwv[tp] = *(const f32x4*)(cw + tp * 1536 + 1024 + ch); }
    const f32x4 kk0 = *(const f32x4*)(inp(p, 14) + (size_t)l * 1024 + ch), kk1 = *(const f32x4*)(inp(p, 14) + (size_t)l * 1024 + 512 + ch);
    f32x2_t SLa = (f32x2_t){0.f, 0.f}, SHa = (f32x2_t){0.f, 0.f}, SLb = (f32x2_t){0.f, 0.f}, SHb = (f32x2_t){0.f, 0.f};
    LAS unsigned char* lds = F.lds;
    constexpr int REC = 1536, BUF = 32 * REC;

    auto load_raw = [&](int c, ScanRaw& R) {
        const bool isctx = c < 8; const int cc = isctx ? c : c - 8, L = isctx ? 256 : 4096, base = isctx ? NLAT + b * 256 : b * 4096;
        const int t = dir ? (L - 1 - 32 * cc - sidx) : (32 * cc + sidx), row = base + t;
        R.mp = t > 0 ? 1.f : 0.f; R.mn = t < L - 1 ? 1.f : 0.f;
        const int rp = t > 0 ? row - 1 : row, rn = t < L - 1 ? row + 1 : row;
        const bf16_t* q0 = PROJ + (size_t)rp * PLD + PRKV + ch; const bf16_t* q1 = PROJ + (size_t)row * PLD + PRKV + ch; const bf16_t* q2 = PROJ + (size_t)rn * PLD + PRKV + ch;
#pragma unroll
        for (int k = 0; k < 3; ++k) { R.x[0][k] = *(const u32x2*)(q0 + 512 * k); R.x[1][k] = *(const u32x2*)(q1 + 512 * k); R.x[2][k] = *(const u32x2*)(q2 + 512 * k); }
        R.a = *(const u32x2*)(AIC + (size_t)row * 1024 + dir * 512 + ch);
        R.w = *(const u32x2*)(WDEC + (size_t)row * 1024 + dir * 512 + ch);
    };
    auto finish = [&](const ScanRaw& R, LAS unsigned char* buf) {
        const f32x4 r = cwr[0] * unp4(R.x[0][0]) * R.mp + cwr[1] * unp4(R.x[1][0]) + cwr[2] * unp4(R.x[2][0]) * R.mn;
        const f32x4 k = cwk[0] * unp4(R.x[0][1]) * R.mp + cwk[1] * unp4(R.x[1][1]) + cwk[2] * unp4(R.x[2][1]) * R.mn;
        const f32x4 v = cwv[0] * unp4(R.x[0][2]) * R.mp + cwv[1] * unp4(R.x[1][2]) + cwv[2] * unp4(R.x[2][2]) * R.mn;
        f32x4 kkv = k * kk0;
        float ss = kkv.x * kkv.x + kkv.y * kkv.y + kkv.z * kkv.z + kkv.w * kkv.w;
        ss = dpp_sum16(ss);
        kkv = kkv * frsq(ss + 1e-12f);
        const f32x4 a = unp4(R.a);
        const f32x4 kt = k * ((a - 1.f) * kk1 + 1.f);
        const f32x4 bb = kkv * a;
        LAS unsigned char* rec = buf + sidx * REC;
        { const f32x4 lw = unp4(R.w); *(LAS f32x4*)(rec + j * 16) = (f32x4){fexp2(lw.x), fexp2(lw.y), fexp2(lw.z), fexp2(lw.w)}; } *(LAS f32x4*)(rec + 256 + j * 16) = r; *(LAS f32x4*)(rec + 512 + j * 16) = kt;
        *(LAS f32x4*)(rec + 768 + j * 16) = kkv; *(LAS f32x4*)(rec + 1024 + j * 16) = bb;
        { LAS float* vp = (LAS float*)(rec + 1280 + (j & 7) * 32 + (j >> 3) * 4); vp[0] = v.x; vp[2] = v.y; vp[4] = v.z; vp[6] = v.w; }
    };
    ScanRaw R;
    load_raw(0, R); finish(R, lds); __syncthreads();
    for (int c = 0; c < 136; ++c) {
        if (c + 1 < 136) load_raw(c + 1, R);
        {
            const bool isctx = c < 8; const int cc = isctx ? c : c - 8, L = isctx ? 256 : 4096, base = isctx ? NLAT + b * 256 : b * 4096;
            const int t0 = dir ? (L - 1 - 32 * cc) : (32 * cc);
            const int ysgn = dir ? -1 : 1;
            float* yb = Y + (size_t)(base + t0 + ysgn * (j >> 1)) * 512 + h * 64 + (j & 1) * 32 + sidx;
            const ptrdiff_t ystep16 = (ptrdiff_t)ysgn * 16 * 512;
            const LAS unsigned char* buf = lds;
            float keep0 = 0.f, keep1 = 0.f, qpa = 0.f, qpb = 0.f;
            const bool oddl = (j & 1) != 0; const ptrdiff_t y8 = (ptrdiff_t)ysgn * 8 * 512;
            f32x4 w = *(const LAS f32x4*)(buf + j * 16), rr = *(const LAS f32x4*)(buf + 256 + j * 16), kt = *(const LAS f32x4*)(buf + 512 + j * 16);
            f32x4 kkv = *(const LAS f32x4*)(buf + 768 + j * 16), bb = *(const LAS f32x4*)(buf + 1024 + j * 16);
            f32x2_t vv0 = *(const LAS f32x2_t*)(buf + 1280 + sidx * 8); float vva = vv0.x, vvb = vv0.y;
#pragma unroll
            for (int s = 0; s < 32; ++s) {
                const LAS unsigned char* nrec = buf + (s < 31 ? s + 1 : 31) * REC;
                const f32x4 nw = *(const LAS f32x4*)(nrec + j * 16), nrr = *(const LAS f32x4*)(nrec + 256 + j * 16), nkt = *(const LAS f32x4*)(nrec + 512 + j * 16);
                const f32x4 nkk = *(const LAS f32x4*)(nrec + 768 + j * 16), nbb = *(const LAS f32x4*)(nrec + 1024 + j * 16);
                const f32x2_t nvv = *(const LAS f32x2_t*)(nrec + 1280 + sidx * 8); const float nvva = nvv.x, nvvb = nvv.y;
                __builtin_amdgcn_sched_barrier(0);
                const f32x2_t kl = (f32x2_t){kkv.x, kkv.y}, kh = (f32x2_t){kkv.z, kkv.w};
                const f32x2_t pva = SLa * kl + SHa * kh, pvb = SLb * kl + SHb * kh;
                float pda = pva.x + pva.y, pdb = pvb.x + pvb.y;
                float z = (oddl ? qpb : qpa) + dppf<0xB1>(oddl ? qpa : qpb);
                pda += dppf<0xB1>(pda); pdb += dppf<0xB1>(pdb);
                pda += dppf<0x4E>(pda); pdb += dppf<0x4E>(pdb); z += dppf<0x4E>(z);
                pda += dppf<0x141>(pda); pdb += dppf<0x141>(pdb); z += dppf<0x124>(z);
                pda += dppf<0x140>(pda); pdb += dppf<0x140>(pdb); z += dppf<0x128>(z);
                if (s > 0) { const int q = (s - 1) & 15; const bool mine = (j >> 1) == (q & 7);
                    if (q < 8) keep0 = mine ? z : keep0; else keep1 = mine ? z : keep1;
                    if (q == 15) { yb[0] = keep0; yb[y8] = keep1; yb += ystep16; } }
                const f32x2_t wl = (f32x2_t){w.x, w.y}, wh = (f32x2_t){w.z, w.w}, bl = (f32x2_t){bb.x, bb.y}, bh = (f32x2_t){bb.z, bb.w}, tl = (f32x2_t){kt.x, kt.y}, th = (f32x2_t){kt.z, kt.w};
                const f32x2_t saa = (f32x2_t){-pda, -pda}, sab = (f32x2_t){-pdb, -pdb}, va2 = (f32x2_t){vva, vva}, vb2 = (f32x2_t){vvb, vvb};
                SLa = SLa * wl + (bl * saa + tl * va2); SHa = SHa * wh + (bh * saa + th * va2);
                SLb = SLb * wl + (bl * sab + tl * vb2); SHb = SHb * wh + (bh * sab + th * vb2);
                const f32x2_t rl = (f32x2_t){rr.x, rr.y}, rh = (f32x2_t){rr.z, rr.w};
                const f32x2_t qva = SLa * rl + SHa * rh, qvb = SLb * rl + SHb * rh;
                qpa = qva.x + qva.y; qpb = qvb.x + qvb.y;
                w = nw; rr = nrr; kt = nkt; kkv = nkk; bb = nbb; vva = nvva; vvb = nvvb;
            }
            { float z = (oddl ? qpb : qpa) + dppf<0xB1>(oddl ? qpa : qpb); z += dppf<0x4E>(z); z += dppf<0x124>(z); z += dppf<0x128>(z);
              keep1 = ((j >> 1) == 7) ? z : keep1; }
            yb[0] = keep0; yb[y8] = keep1;
        }
        __syncthreads();
        if (c + 1 < 136) finish(R, lds);
        __syncthreads();
    }
}

__device__ __forceinline__ void cmlp_unit(Frame& F, const Params& p, int l, int chk, int g) {
    const int tid = F.tid, wave = F.wave, lane = F.lane, c = lane & 31, h2 = lane >> 5;
    const bf16_t* PROJ = WSP(bf16_t, WS_PROJ);
    const bf16_t* WCM = WSP(bf16_t, WS_WCM) + (size_t)l * 4 * 128 * 128;
    const float* lg = inp(p, 19) + (size_t)l * 512; const float* lb = inp(p, 20) + (size_t)l * 512; const float* bs = inp(p, 22) + (size_t)l * 512;
    bf16_t* OC = WSP(bf16_t, WS_OA) + 2 * OABC_STRIDE;
    LAS unsigned char* vt = F.lds;
    LAS float* stats = (LAS float*)(F.lds + 40960);
    const int R0 = chk * 128;
    { const int tok = tid >> 2, q4 = tid & 3; const bf16_t* src = PROJ + (size_t)(R0 + tok) * PLD + PUV + 512 + q4 * 128;
      float s = 0.f, ss = 0.f;
#pragma unroll
      for (int i = 0; i < 16; ++i) { const u32x4 x = *(const u32x4*)(src + 8 * i);
          const float f[8] = {bflo(x.x), bfhi(x.x), bflo(x.y), bfhi(x.y), bflo(x.z), bfhi(x.z), bflo(x.w), bfhi(x.w)};
#pragma unroll
          for (int e = 0; e < 8; ++e) { s += f[e]; ss += f[e] * f[e]; } }
      s = sum4(s); ss = sum4(ss);
      const float mean = s * (1.f / 512.f), var = fmaxf(ss * (1.f / 512.f) - mean * mean, 0.f);
      if (q4 == 0) { stats[tok * 2] = mean; stats[tok * 2 + 1] = frsq(var + EPS); } }
    __syncthreads();
    {
        { const int q = tid >> 2, cg = tid & 3; const bf16_t* src = PROJ + (size_t)(R0 + q) * PLD + PUV + 512 + 128 * g + 32 * cg;
          const float mean = stats[q * 2], rstd = stats[q * 2 + 1];
#pragma unroll
          for (int i = 0; i < 4; ++i) { const u32x4 x = *(const u32x4*)(src + 8 * i);
              const float f[8] = {bflo(x.x), bfhi(x.x), bflo(x.y), bfhi(x.y), bflo(x.z), bfhi(x.z), bflo(x.w), bfhi(x.w)};
#pragma unroll
              for (int e = 0; e < 8; ++e) { const int cl = 32 * cg + 8 * i + e, chn = 128 * g + cl;
                  const float val = (f[e] - mean) * rstd * lg[chn] + lb[chn];
                  *(LAS unsigned short*)(vt + cl * 272 + q * 2) = (unsigned short)pk2(val, 0.f); } } }
        __syncthreads();
        const int pb = wave >> 1, cbase = 64 * (wave & 1);
        f32x16 a0, a1;
#pragma unroll
        for (int i = 0; i < 16; ++i) { a0[i] = 0.f; a1[i] = 0.f; }
#pragma unroll
        for (int ks = 0; ks < 8; ++ks) {
            const bf16x8 A = *(const bf16x8*)(WCM + ((size_t)(g * 128 + 32 * pb + c)) * 128 + 16 * ks + 8 * h2);
            const bf16x8 B0 = *(const LAS bf16x8*)(vt + (cbase + c) * 272 + 32 * ks + 16 * h2);
            const bf16x8 B1 = *(const LAS bf16x8*)(vt + (cbase + 32 + c) * 272 + 32 * ks + 16 * h2);
            a0 = __builtin_amdgcn_mfma_f32_32x32x16_bf16(B0, A, a0, 0, 0, 0);
            a1 = __builtin_amdgcn_mfma_f32_32x32x16_bf16(B1, A, a1, 0, 0, 0);
        }
        LAS unsigned char* ot = F.lds + 49152;
        { const int pr = 32 * pb + c; const float bsv = bs[g * 128 + pr];
#pragma unroll
          for (int g4 = 0; g4 < 4; ++g4) {
              const int ch = cbase + 8 * g4 + 4 * h2;
              *(LAS f32x4*)(ot + pr * 528 + ch * 4) = (f32x4){a0[4 * g4] + bsv, a0[4 * g4 + 1] + bsv, a0[4 * g4 + 2] + bsv, a0[4 * g4 + 3] + bsv};
              *(LAS f32x4*)(ot + pr * 528 + (ch + 32) * 4) = (f32x4){a1[4 * g4] + bsv, a1[4 * g4 + 1] + bsv, a1[4 * g4 + 2] + bsv, a1[4 * g4 + 3] + bsv}; } }
        __syncthreads();
#pragma unroll
        for (int i = 0; i < 4; ++i) { const int q = tid + 512 * i, tok = q >> 4, seg = q & 15; const size_t ro = (size_t)(R0 + tok);
            const f32x4 x0 = *(const LAS f32x4*)(ot + tok * 528 + seg * 32), x1 = *(const LAS f32x4*)(ot + tok * 528 + seg * 32 + 16);
            const u32x4 uu = *(const u32x4*)(PROJ + ro * PLD + PUV + 128 * g + seg * 8);
            u32x4 w;
            w.x = pk2(bflo(uu.x) * x0[0], bfhi(uu.x) * x0[1]); w.y = pk2(bflo(uu.y) * x0[2], bfhi(uu.y) * x0[3]);
            w.z = pk2(bflo(uu.z) * x1[0], bfhi(uu.z) * x1[1]); w.w = pk2(bflo(uu.w) * x1[2], bfhi(uu.w) * x1[3]);
            *(u32x4*)(OC + ro * 512 + 128 * g + seg * 8) = w; }
        __syncthreads();
    }
}

__device__ __forceinline__ void p5_readout(Frame& F, const Params& p, int l) {
    const int gw = F.bx * 8 + F.wave, NGW = F.G * 8, lane = F.lane, c0 = 8 * lane;
    const bf16_t* PROJ = WSP(bf16_t, WS_PROJ);
    const float* YF = WSP(float, WS_YFB); const float* YB = YF + (size_t)MT * 512;
    const bf16_t* GG = WSP(bf16_t, WS_GG);
    bf16_t* OB = WSP(bf16_t, WS_OA) + OABC_STRIDE;
    const float* cw = inp(p, 9) + (size_t)l * 3 * 1536;
    const float* rk = inp(p, 15) + (size_t)l * 512; const float* lg = inp(p, 17) + (size_t)l * 512; const float* lb = inp(p, 18) + (size_t)l * 512;
    const int nrows = (l == 3) ? NLAT : MT;
    float cwr_[3][8], cwk_[3][8], cwv_[3][8], rk_[8], lg_[8], lb_[8];
#pragma unroll
    for (int tp = 0; tp < 3; ++tp)
#pragma unroll
        for (int e = 0; e < 8; ++e) { cwr_[tp][e] = cw[tp * 1536 + c0 + e]; cwk_[tp][e] = cw[tp * 1536 + 512 + c0 + e]; cwv_[tp][e] = cw[tp * 1536 + 1024 + c0 + e]; }
#pragma unroll
    for (int e = 0; e < 8; ++e) { rk_[e] = rk[c0 + e]; lg_[e] = lg[c0 + e]; lb_[e] = lb[c0 + e]; }
#pragma unroll 2
    for (int r = gw; r < nrows; r += NGW) {
        const bool islat = r < NLAT; const int t = islat ? (r & 4095) : ((r - NLAT) & 255), L = islat ? 4096 : 256;
        float y[8];
        { const f32x4 a0 = *(const f32x4*)(YF + (size_t)r * 512 + c0), a1 = *(const f32x4*)(YF + (size_t)r * 512 + c0 + 4), b0 = *(const f32x4*)(YB + (size_t)r * 512 + c0), b1 = *(const f32x4*)(YB + (size_t)r * 512 + c0 + 4);
#pragma unroll
          for (int e = 0; e < 4; ++e) { y[e] = a0[e] + b0[e]; y[4 + e] = a1[e] + b1[e]; } }
        float s = 0.f;
#pragma unroll
        for (int e = 0; e < 8; ++e) s += y[e];
        s = sum8(s);
        const float mean = s * (1.f / 64.f);
        float q = 0.f;
#pragma unroll
        for (int e = 0; e < 8; ++e) { y[e] -= mean; q += y[e] * y[e]; }
        q = sum8(q);
        const float rstd = frsq(q * (1.f / 64.f) + 64e-5f);
        float rr[8], kk[8], vv[8];
#pragma unroll
        for (int e = 0; e < 8; ++e) { rr[e] = 0.f; kk[e] = 0.f; vv[e] = 0.f; }
#pragma unroll
        for (int tp = 0; tp < 3; ++tp) {
            const int tt = t + tp - 1; const bool ok = tt >= 0 && tt < L; const int rw = ok ? r + tp - 1 : r; const float mk = ok ? 1.f : 0.f;
            const bf16_t* src = PROJ + (size_t)rw * PLD + PRKV + c0;
            const u32x4 xr = *(const u32x4*)src, xk = *(const u32x4*)(src + 512), xv = *(const u32x4*)(src + 1024);
            const float fr_[8] = {bflo(xr.x), bfhi(xr.x), bflo(xr.y), bfhi(xr.y), bflo(xr.z), bfhi(xr.z), bflo(xr.w), bfhi(xr.w)};
            const float fk_[8] = {bflo(xk.x), bfhi(xk.x), bflo(xk.y), bfhi(xk.y), bflo(xk.z), bfhi(xk.z), bflo(xk.w), bfhi(xk.w)};
            const float fv_[8] = {bflo(xv.x), bfhi(xv.x), bflo(xv.y), bfhi(xv.y), bflo(xv.z), bfhi(xv.z), bflo(xv.w), bfhi(xv.w)};
#pragma unroll
            for (int e = 0; e < 8; ++e) { rr[e] += mk * cwr_[tp][e] * fr_[e]; kk[e] += mk * cwk_[tp][e] * fk_[e]; vv[e] += mk * cwv_[tp][e] * fv_[e]; }
        }
        float bsum = 0.f;
#pragma unroll
        for (int e = 0; e < 8; ++e) bsum += rr[e] * kk[e] * rk_[e];
        bsum = sum8(bsum);
        const u32x4 gw4 = *(const u32x4*)(GG + (size_t)r * 512 + c0);
        const float gg[8] = {bflo(gw4.x), bfhi(gw4.x), bflo(gw4.y), bfhi(gw4.y), bflo(gw4.z), bfhi(gw4.z), bflo(gw4.w), bfhi(gw4.w)};
        float o[8];
#pragma unroll
        for (int e = 0; e < 8; ++e) o[e] = (y[e] * rstd * lg_[e] + lb_[e] + bsum * vv[e]) * gg[e];
        u32x4 ow; ow.x = pk2(o[0], o[1]); ow.y = pk2(o[2], o[3]); ow.z = pk2(o[4], o[5]); ow.w = pk2(o[6], o[7]);
        *(u32x4*)(OB + (size_t)r * 512 + c0) = ow;
    }
}

__device__ __forceinline__ void p8_postmix(Frame& F, const Params& p, int l) {
    const int gw = F.bx * 8 + F.wave, NGW = F.G * 8, lane = F.lane;
    const int rows = (l == 3) ? NLAT : MT;
    const bf16_t* OL = WSP(bf16_t, WS_OL);
    const bool moe = (l & 1) != 0; const int li = l >> 1;
    const float* router = inp(p, 27) + (size_t)li * 1024 * 8;
    unsigned* cnt = WSP(unsigned, WS_CTL) + CW_MOE + li * 8 * 64;
    int* route = WSP(int, WS_ROUTE);
    f32x4 rw0[4][4], rw1[4][4];
    if (moe) {
#pragma unroll
        for (int j = 0; j < 4; ++j)
#pragma unroll
            for (int i = 0; i < 4; ++i) { const int c = 4 * lane + 256 * j + i; rw0[j][i] = *(const f32x4*)(router + (size_t)c * 8); rw1[j][i] = *(const f32x4*)(router + (size_t)c * 8 + 4); } }
    unsigned long long pk0 = 0ull, pk1 = 0ull; int kk_ = 0, klat = 0;
    int ec[8];
#pragma unroll
    for (int e = 0; e < 8; ++e) ec[e] = 0;
#pragma unroll 1
    for (int seg = 0; seg < 2; ++seg) {
    const int rbeg = seg == 0 ? (gw & 7) * 4096 + (gw >> 3) : NLAT + gw, rstep = seg == 0 ? (NGW >> 3) : NGW, rend = seg == 0 ? (gw & 7) * 4096 + 4096 : rows;
    if (rbeg >= rend) continue;
    f32x4 gg[4], gs[4], sh[4];
    load_gg(F, p, l, 1, 2, seg == 0 ? (gw & 7) : 8, gg); load_gs(F, p, l, 2, 4, 3, seg == 0 ? (gw & 7) : 8, gs, sh);
    u32x2 nf[4], nx[4];
#pragma unroll
    for (int j = 0; j < 4; ++j) { nf[j] = *(const u32x2*)(OL + (size_t)rbeg * D + 4 * lane + 256 * j); nx[j] = *(const u32x2*)(xres_row(F, rbeg) + 4 * lane + 256 * j); }
    for (int r = rbeg; r < rend; r += rstep) {
        f32x4 fv[4], xv[4], hv[4]; u32x2 cx[4];
#pragma unroll
        for (int j = 0; j < 4; ++j) { fv[j] = unp4(nf[j]); cx[j] = nx[j]; }
        { const int rn = (r + rstep < rend) ? r + rstep : r;
#pragma unroll
          for (int j = 0; j < 4; ++j) { nf[j] = *(const u32x2*)(OL + (size_t)rn * D + 4 * lane + 256 * j); nx[j] = *(const u32x2*)(xres_row(F, rn) + 4 * lane + 256 * j); } }
        residual_update_v(F, p, fv, cx, r, gg, xv, false);
        emit_h_v(F, xv, r, gs, sh, hv);
        if (moe) {
            float lg[8];
#pragma unroll
            for (int e = 0; e < 8; ++e) lg[e] = 0.f;
#pragma unroll
            for (int j = 0; j < 4; ++j)
#pragma unroll
                for (int i = 0; i < 4; ++i) { const f32x4 w0 = rw0[j][i], w1 = rw1[j][i];
                    const float hval = hv[j][i];
#pragma unroll
                    for (int e = 0; e < 4; ++e) { lg[e] += hval * w0[e]; lg[4 + e] += hval * w1[e]; } }
#pragma unroll
            for (int e = 0; e < 8; ++e) lg[e] = wave_sum(lg[e]);
            int i0 = 0; float v0 = lg[0];
#pragma unroll
            for (int e = 1; e < 8; ++e) if (lg[e] > v0) { v0 = lg[e]; i0 = e; }
            int i1 = (i0 == 0) ? 1 : 0; float v1 = -3.4e38f;
#pragma unroll
            for (int e = 0; e < 8; ++e) if (e != i0 && lg[e] > v1) { v1 = lg[e]; i1 = e; }
            const float w1 = 1.f / (1.f + __expf(v0 - v1)), w0 = 1.f - w1;
            const int u0 = __builtin_amdgcn_readfirstlane(i0), u1 = __builtin_amdgcn_readfirstlane(i1);
            pk0 |= (unsigned long long)u0 << (3 * kk_); pk1 |= (unsigned long long)u1 << (3 * kk_); ++kk_;
#pragma unroll
            for (int e = 0; e < 8; ++e) ec[e] += (u0 == e ? 1 : 0) + (u1 == e ? 1 : 0);
            if (lane == 0) { int* rt = route + (size_t)r * 8; rt[0] = u0; rt[1] = u1; rt[4] = __float_as_int(w0); rt[5] = __float_as_int(w1); }
        }
    }
    if (seg == 0) klat = kk_;
    }
    if (moe) {
        int cv = 0;
#pragma unroll
        for (int e = 0; e < 8; ++e) cv = (lane == e) ? ec[e] : cv;
        volatile LAS int* lc = (volatile LAS int*)F.lds;
        if (F.tid < 16) lc[F.tid] = 0;
        __syncthreads();
        int bv = 0;
        if (lane < 8 && cv > 0) bv = __hip_atomic_fetch_add((LAS int*)F.lds + lane, cv, __ATOMIC_RELAXED, __HIP_MEMORY_SCOPE_WORKGROUP);
        __syncthreads();
        if (F.tid < 8) { const int tot = lc[F.tid]; lc[8 + F.tid] = tot > 0 ? (int)__hip_atomic_fetch_add(cnt + F.tid * 64, (unsigned)tot, __ATOMIC_RELAXED, __HIP_MEMORY_SCOPE_AGENT) : 0; }
        __syncthreads();
        if (lane < 8) bv += lc[8 + lane];
        for (int k = 0; k < kk_; ++k) {
            const int u0 = (int)((pk0 >> (3 * k)) & 7ull), u1 = (int)((pk1 >> (3 * k)) & 7ull);
            const int s0 = __builtin_amdgcn_readlane(bv, u0); bv += (lane == u0) ? 1 : 0;
            const int s1 = __builtin_amdgcn_readlane(bv, u1); bv += (lane == u1) ? 1 : 0;
            const int row = k < klat ? (gw & 7) * 4096 + (gw >> 3) + k * (NGW >> 3) : NLAT + gw + (k - klat) * NGW;
            if (lane == 0) { int* rt = route + (size_t)row * 8; rt[2] = s0; rt[3] = s1; }
        }
    }
}
__device__ __forceinline__ void moe_tile_starts(Frame& F, int li, int (&ts)[9]) {
    unsigned* cnt = WSP(unsigned, WS_CTL) + CW_MOE + li * 8 * 64;
    ts[0] = 0;
#pragma unroll
    for (int e = 0; e < 8; ++e) { const unsigned c = __builtin_amdgcn_readfirstlane(__hip_atomic_load(cnt + e * 64, __ATOMIC_RELAXED, __HIP_MEMORY_SCOPE_AGENT)); ts[e + 1] = ts[e] + (int)((c + 255u) >> 8); }
}
__device__ __forceinline__ void p9_gather(Frame& F, const Params& p, int l) {
    const int gw = F.bx * 8 + F.wave, NGW = F.G * 8, lane = F.lane;
    const int rows = (l == 3) ? NLAT : MT;
    int ts[9]; moe_tile_starts(F, l >> 1, ts);
    const int* route = WSP(int, WS_ROUTE); int* prow = WSP(int, WS_PROW);
    const bf16_t* H = WSP(bf16_t, WS_H); bf16_t* HP = WSP(bf16_t, WS_HPERM);
#pragma unroll 2
    for (int r = gw; r < rows; r += NGW) {
        const int rv = route[(size_t)r * 8 + (lane & 3)];
        const int e0 = __builtin_amdgcn_readlane(rv, 0), e1 = __builtin_amdgcn_readlane(rv, 1), s0 = __builtin_amdgcn_readlane(rv, 2), s1 = __builtin_amdgcn_readlane(rv, 3);
        int t0 = 0, t1 = 0;
#pragma unroll
        for (int e = 0; e < 8; ++e) { t0 = (e0 == e) ? ts[e] : t0; t1 = (e1 == e) ? ts[e] : t1; }
        const int p0 = 256 * t0 + s0, p1 = 256 * t1 + s1;
        const u32x4 a = *(const u32x4*)(H + (size_t)r * D + 8 * lane), c = *(const u32x4*)(H + (size_t)r * D + 512 + 8 * lane);
        *(u32x4*)(HP + (size_t)p0 * D + 8 * lane) = a; *(u32x4*)(HP + (size_t)p0 * D + 512 + 8 * lane) = c;
        *(u32x4*)(HP + (size_t)p1 * D + 8 * lane) = a; *(u32x4*)(HP + (size_t)p1 * D + 512 + 8 * lane) = c;
        if (lane == 0) { prow[(size_t)r * 2] = p0; prow[(size_t)r * 2 + 1] = p1; }
    }
}
__device__ __forceinline__ void p12_postffn(Frame& F, const Params& p, int l) {
    const int gw = F.bx * 8 + F.wave, NGW = F.G * 8, lane = F.lane;
    const int rows = (l == 3) ? NLAT : MT;
    const bool moe = (l & 1) != 0;
    const bf16_t* FO = WSP(bf16_t, WS_YP);
    const int* route = WSP(int, WS_ROUTE); const int* prow = WSP(int, WS_PROW);
    u32x2 nx[4]; int npv = 0, nwv = 0;
#pragma unroll 1
    for (int seg = 0; seg < 2; ++seg) {
    const int rbeg = seg == 0 ? (gw & 7) * 4096 + (gw >> 3) : NLAT + gw, rstep = seg == 0 ? (NGW >> 3) : NGW, rend = seg == 0 ? (gw & 7) * 4096 + 4096 : rows;
    if (rbeg >= rend) continue;
    const int mvi = seg == 0 ? (gw & 7) : 8;
    f32x4 gg[4], gs[4], sh[4];
    load_gg(F, p, l, 3, 5, mvi, gg);
    if (l < 3) load_gs(F, p, l + 1, 0, 1, 0, mvi, gs, sh);
#pragma unroll
    for (int j = 0; j < 4; ++j) nx[j] = *(const u32x2*)(xres_row(F, rbeg) + 4 * lane + 256 * j);
    if (moe) { npv = prow[(size_t)rbeg * 2 + (lane & 1)]; nwv = route[(size_t)rbeg * 8 + 4 + (lane & 1)]; }
    for (int r = rbeg; r < rend; r += rstep) {
        f32x4 fv[4], xv[4], hv[4]; u32x2 cx[4];
#pragma unroll
        for (int j = 0; j < 4; ++j) cx[j] = nx[j];
        const int pv = npv, wv = nwv;
        { const int rn = (r + rstep < rend) ? r + rstep : r;
#pragma unroll
          for (int j = 0; j < 4; ++j) nx[j] = *(const u32x2*)(xres_row(F, rn) + 4 * lane + 256 * j);
          if (moe) { npv = prow[(size_t)rn * 2 + (lane & 1)]; nwv = route[(size_t)rn * 8 + 4 + (lane & 1)]; } }
        if (moe) {
            const int p0 = __builtin_amdgcn_readlane(pv, 0), p1 = __builtin_amdgcn_readlane(pv, 1); const float w0 = __int_as_float(__builtin_amdgcn_readlane(wv, 0)), w1 = __int_as_float(__builtin_amdgcn_readlane(wv, 1));
#pragma unroll
            for (int j = 0; j < 4; ++j) fv[j] = w0 * unp4(*(const u32x2*)(FO + (size_t)p0 * D + 4 * lane + 256 * j)) + w1 * unp4(*(const u32x2*)(FO + (size_t)p1 * D + 4 * lane + 256 * j));
        } else {
#pragma unroll
            for (int j = 0; j < 4; ++j) fv[j] = unp4(*(const u32x2*)(FO + (size_t)r * D + 4 * lane + 256 * j));
        }
        residual_update_v(F, p, fv, cx, r, gg, xv, l == 3);
        if (l < 3) emit_h_v(F, xv, r, gs, sh, hv);
    }
    }
}


#ifndef DIGEST_AFTER
#define DIGEST_AFTER 0
#define DIGEST_GAIN 1.0f
#define DIGEST_SEL 7
#define P4_MASK 7
#endif
__device__ __forceinline__ void digest_phase(Frame& F, const Params& p, int upto) {
    const int gw = F.bx * 8 + F.wave, NGW = F.G * 8, lane = F.lane;
    for (int r = gw; r < NLAT; r += NGW) {
        const int rc = NLAT + (r & 2047);
        float* xr = outp(p) + (size_t)r * D;
        for (int j = 0; j < 16; ++j) {
            const int c = lane + 64 * j;
            float acc = 0.f;
            for (int rr_ = 0; rr_ < 2; ++rr_) { const int row = rr_ ? rc : r;
                if (upto == 1) { acc += bf1(WSP(bf16_t, WS_H)[(size_t)row * D + c]) + bf1(WSP(bf16_t, WS_WIN)[(size_t)(row % PLD) * 1024 + c]) + WSP(float, WS_MODV)[((size_t)row * 1024 + c) % (9 * 6144)]; }
                if (upto >= 2) { for (int k = 0; k < 6; ++k) acc += bf1(WSP(bf16_t, WS_PROJ)[(size_t)row * PLD + c + 1024 * k]); acc += bf1(WSP(bf16_t, WS_PROJ)[(size_t)row * PLD + 6144 + (c % 768)]); }
                if (upto >= 3) { acc += bf1(WSP(bf16_t, WS_WDEC)[(size_t)row * 1024 + c]) + bf1(WSP(bf16_t, WS_AICLR)[(size_t)row * 1024 + c]) + bf1(WSP(bf16_t, WS_GG)[(size_t)row * 512 + (c & 511)]);
                    acc += bf1(WSP(bf16_t, WS_QN)[((size_t)row * 1024 + c) % ((size_t)NB * 8 * NKEY * 64)]) + bf1(WSP(bf16_t, WS_KN)[((size_t)row * 1024 + c) % ((size_t)NB * 2 * NKEY * 64)]) + bf1(WSP(bf16_t, WS_VT)[((size_t)row * 1024 + c) % ((size_t)NB * 2 * NKEY * 64)]); }
                if (upto >= 4) { if (DIGEST_SEL & 1) acc += bf1(WSP(bf16_t, WS_OA)[(size_t)row * 512 + (c & 511)]); if (DIGEST_SEL & 2) acc += bf1(WSP(bf16_t, WS_OA)[2 * OABC_STRIDE + (size_t)row * 512 + (c & 511)]);
                    if (DIGEST_SEL & 4) acc += WSP(float, WS_YFB)[(size_t)row * 512 + (c & 511)] + WSP(float, WS_YFB)[(size_t)MT * 512 + (size_t)row * 512 + (c & 511)]; }
                if (upto == 5) acc += bf1(WSP(bf16_t, WS_OA)[OABC_STRIDE + (size_t)row * 512 + (c & 511)]);
                if (upto == 6) acc += bf1(WSP(bf16_t, WS_YM)[(size_t)row * 1024 + c]);
                if (upto == 7) acc += WSP(float, WS_OL)[(size_t)row * 1024 + c];
            }
            xr[c] = (__hip_atomic_load(WSP(unsigned, WS_CTL) + 64, __ATOMIC_RELAXED, __HIP_MEMORY_SCOPE_AGENT) != 0u) ? __builtin_nanf("") : DIGEST_GAIN * acc;
        }
    }
}
__global__ void __launch_bounds__(512, 2) mk_fwd(Params p) {
    extern __shared__ __attribute__((aligned(16))) unsigned char lds_raw[];
    Frame F;
    F.lds = (LAS unsigned char*)lds_raw;
    F.tid = threadIdx.x; F.lane = F.tid & 63; F.wave = __builtin_amdgcn_readfirstlane(F.tid >> 6);
    F.G = gridDim.x; F.bx = blockIdx.x; F.ws = (GAS unsigned char*)p.ws;
    volatile LAS unsigned* MISC = (volatile LAS unsigned*)(F.lds + LDS_MISC);
#ifdef LDSZERO
    for (int i = F.tid; i < LDS_BYTES / 16; i += 512) *(LAS u32x4*)(F.lds + 16 * i) = (u32x4){0u, 0u, 0u, 0u};
#endif
#ifdef LDSTEST
    unsigned lds_err = 0;
    for (int round = 0; round < 4; ++round) {
        for (int i = 0; i < 72; ++i) ((LAS unsigned*)F.lds)[i * 512 + F.tid] = (unsigned)(F.tid * 2654435761u + round * 7919u + i * 104729u);
        __syncthreads();
        const int t2 = (F.tid + 1 + 64 * round) & 511;
        for (int i = 0; i < 72; ++i) lds_err += (((LAS unsigned*)F.lds)[i * 512 + t2] != (unsigned)(t2 * 2654435761u + round * 7919u + i * 104729u)) ? 1u : 0u;
        __syncthreads();
    }
    if (lds_err) __hip_atomic_fetch_add(WSP(unsigned, WS_CTL) + 64, lds_err, __ATOMIC_RELAXED, __HIP_MEMORY_SCOPE_AGENT);
    for (int i = F.tid; i < LDS_BYTES / 16; i += 512) *(LAS u32x4*)(F.lds + 16 * i) = (u32x4){0u, 0u, 0u, 0u};
#endif
    if (F.tid < 64) MISC[F.tid] = 0u;
    __syncthreads();
#ifdef L2FLUSH
    {
        const u32x4* src = (const u32x4*)(GAS const u32x4*)(unsigned long long)p.in[28] + (size_t)F.bx * 65536 + F.tid;
        unsigned accx = 0;
#pragma unroll 8
        for (int i = 0; i < 128; ++i) { const u32x4 v = src[(size_t)i * 512]; accx ^= v.x ^ v.y ^ v.z ^ v.w; }
        if (accx == 0x12345u && F.tid == 1023) p.out[0] = 0.f;
        asm volatile("" :: "v"(accx));
    }
#endif
    XcdBarrier bar = xcd_barrier_post(WSP(unsigned, WS_CTL) + CW_BAR, MISC + 8);
#define GRID_BAR() do { XcdBarrier _b = bar; unsigned long long _t = (unsigned long long)_b.bar; int _wv0 = __builtin_amdgcn_readfirstlane(F.wave); asm volatile("" : "+s"(_t), "+s"(_wv0)); _b.bar = (unsigned*)(GAS unsigned*)_t; xcd_barrier(_b, (_wv0 == 0) && (lane_id() == 0)); } while (0)
#define LAUNDER() do { unsigned long long _w = (unsigned long long)p.ws; int _wv = __builtin_amdgcn_readfirstlane(F.wave); asm volatile("" : "+s"(_w), "+s"(_wv)); F.ws = (GAS unsigned char*)_w; F.wave = _wv; F.lane = lane_id(); F.tid = _wv * 64 + F.lane; } while (0)
    const int stop = p.stop_after;

    const bool p4split = (F.G & 15) == 0 && F.G >= 16;
    p0_prologue(F, p, p4split);
    GRID_BAR(); LAUNDER();
    p1_input(F, p);
    GRID_BAR(); LAUNDER();
    if (DIGEST_AFTER == 1) { digest_phase(F, p, 1); return; }
#ifdef SYNTH
    { const size_t gt = (size_t)F.bx * 512 + F.tid, NT = (size_t)F.G * 512;
      bf16_t* H = WSP(bf16_t, WS_H); bf16_t* W = WSP(bf16_t, WS_WIN);
      for (size_t i = gt; i < (size_t)MT * D; i += NT) { const int r = (int)(i >> 10), k = (int)(i & 1023); H[i] = (bf16_t)pk2((float)(((r * 131 + k * 71) % 257) - 128) * (1.f / 128.f), 0.f); }
      for (size_t i = gt; i < (size_t)PLD * 1024; i += NT) { const int n = (int)(i >> 10), k = (int)(i & 1023); W[i] = (bf16_t)pk2((float)(((n * 37 + k * 101) % 263) - 131) * (1.f / 131.f), 0.f); } }
    GRID_BAR(); LAUNDER();
#endif
    if (stop == 0) return;

    for (int l = 0; l < 4; ++l) {
        const int li = l >> 1;
#ifdef LDSTEST2
        { unsigned lds_err = 0;
          for (int round = 0; round < 256; ++round) {
              for (int i = 0; i < 8; ++i) { const unsigned v = (unsigned)(F.tid * 2654435761u + round * 7919u + i * 104729u); *(LAS u32x4*)(F.lds + (F.tid >> 3) * 144 + (F.tid & 7) * 16 + i * 9216) = (u32x4){v, v + 1u, v + 2u, v + 3u}; }
              __syncthreads();
              const int t2 = (F.tid * 7 + 64 * round + 13) & 511;
              for (int i = 0; i < 8; ++i) { const unsigned v = (unsigned)(t2 * 2654435761u + round * 7919u + i * 104729u); const u32x4 q = *(const LAS u32x4*)(F.lds + (t2 >> 3) * 144 + (t2 & 7) * 16 + i * 9216);
                  lds_err += (q.x != v || q.y != v + 1u || q.z != v + 2u || q.w != v + 3u) ? 1u : 0u; }
              __syncthreads();
          }
          if (lds_err) __hip_atomic_fetch_add(WSP(unsigned, WS_CTL) + 64, lds_err, __ATOMIC_RELAXED, __HIP_MEMORY_SCOPE_AGENT); }
#endif
#ifdef FAKE_P2
        { const bf16_t* H = WSP(bf16_t, WS_H); const bf16_t* W = WSP(bf16_t, WS_WIN); bf16_t* P = WSP(bf16_t, WS_PROJ);
          for (size_t i = (size_t)F.bx * 512 + F.tid; i < (size_t)MT * PLD; i += (size_t)F.G * 512) { const int r = (int)(i / PLD), n = (int)(i % PLD);
              P[i] = (bf16_t)pk2(bf1(H[(size_t)r * D + (n & 1023)]) * bf1(W[(size_t)n * 1024 + (r & 1023)]), 0.f); } }
        if (0)
#endif
        { pg8::Gemm g{WSP(bf16_t, WS_H), WSP(bf16_t, WS_WIN) + (size_t)l * PLD * 1024, 1024, 1024, 1024, 0, 0};
          pg8::InProjOrder S; if (l == 3) S.init2(NLAT / 256, NCTX / 256, PLD / 256, PQ / 256, F.G, F.bx); else S.init2(MT / 256, 0, PLD / 256, 0, F.G, F.bx);
          pg8::EpiProj E{WSP(bf16_t, WS_PROJ)};
          GEMM_CALL(F.lds, F.tid, g, S, E); LAUNDER(); if (GEMM_REPEAT) { GEMM_CALL(F.lds, F.tid, g, S, E); LAUNDER(); } }
        GRID_BAR(); LAUNDER();
        if (DIGEST_AFTER == 2) { digest_phase(F, p, 2); return; }
        { pg8::Gemm g{WSP(bf16_t, WS_PROJ) + PWLOW, WSP(bf16_t, WS_WLORA) + (size_t)l * 2560 * 384, 384, PLD, 384, 0, 0};
          pg8::LoraOrder S; S.init(MT / 256, 10, F.G, F.bx);
          pg8::EpiLora E{WSP(bf16_t, WS_WDEC), WSP(bf16_t, WS_AICLR), WSP(bf16_t, WS_GG), inp(p, 10) + (size_t)l * 1024, inp(p, 12) + (size_t)l * 1024};
          GEMM_CALL(F.lds, F.tid, g, S, E); LAUNDER(); if (GEMM_REPEAT) { GEMM_CALL(F.lds, F.tid, g, S, E); LAUNDER(); } }
        p3_qk(F, p, l);
        p3_vt(F);
        GRID_BAR(); LAUNDER();
        if (DIGEST_AFTER == 3) { digest_phase(F, p, 3); return; }
#ifndef P4_MASK
#define P4_MASK 7
#endif
        if (p4split) {
            const int hg = F.G >> 1;
            const int nchx = ((l == 3) ? NLAT : MT) / 128 / 8 * 4, ksplit = (nchx * CMLP_SCAN_SHARE) / 100;
            if (F.bx < hg) { for (int cid = F.bx; cid < 128; cid += hg) scan_unit2(F, p, l, cid); LAUNDER();
                for (int k = F.bx >> 3; k < ksplit; k += (hg >> 3)) cmlp_unit(F, p, l, (F.bx & 7) + 8 * (k >> 2), k & 3); }
            else {
                const int ab = F.bx - hg, nunits = (l < 3) ? 1088 : 1024;
                for (int u = ab; u < nunits; u += hg) {
                    if (u < 1024) { const int qt = u >> 6, h = (u >> 3) & 7, b = u & 7; attn_unit(F, b, h, 256 + 256 * qt, NKEY, b * 4096 + 256 * qt); }
                    else { const int cu = u - 1024, h = cu >> 3, b = cu & 7; attn_unit(F, b, h, 0, 256, NLAT + b * 256); }
                }
                LAUNDER();
                const int nch = ((l == 3) ? NLAT : MT) / 128, xcd = F.bx & 7, perx = hg >> 3;
                for (int k = ksplit + (ab >> 3); ; k += perx) { const int chk = xcd + 8 * (k >> 2); if (chk >= nch) break; cmlp_unit(F, p, l, chk, k & 3); }
                LAUNDER(); __syncthreads();
                p0_slot(F, p, l, ab * 8 + F.wave, hg * 8);
            }
        } else {
        if (P4_MASK & 1) { const int nunits = (l < 3) ? 1088 : 1024;
          for (int rep = 0; rep < ATT_REPEAT; ++rep)
          for (int u = F.bx; u < nunits; u += F.G) {
              if (u < 1024) { const int qt = u >> 6, h = (u >> 3) & 7, b = u & 7; attn_unit(F, b, h, 256 + 256 * qt, NKEY, b * 4096 + 256 * qt); }
              else { const int cu = u - 1024, h = cu >> 3, b = cu & 7; attn_unit(F, b, h, 0, 256, NLAT + b * 256); }
          } }
        LAUNDER();
        if (P4_MASK & 2) for (int cid = F.bx; cid < 256; cid += F.G) scan_unit(F, p, l, cid);
        LAUNDER();
        if (P4_MASK & 4) { const int nch = ((l == 3) ? NLAT : MT) / 128, xcd = F.bx & 7, perx = F.G >> 3;
          if ((F.G & 7) == 0) { for (int k = (perx == 32) ? (((F.bx >> 3) + 24) & 31) : (F.bx >> 3); ; k += perx) { const int chk = xcd + 8 * (k >> 2); if (chk >= nch) break; cmlp_unit(F, p, l, chk, k & 3); } }
          else for (int u = F.bx; u < 4 * nch; u += F.G) cmlp_unit(F, p, l, u >> 2, u & 3); }
        }
        GRID_BAR(); LAUNDER();
        if (DIGEST_AFTER == 4) { digest_phase(F, p, 4); return; }
        p5_readout(F, p, l);
        GRID_BAR(); LAUNDER();
        if (DIGEST_AFTER == 5) { digest_phase(F, p, 5); return; }
        { pg8::Gemm g{WSP(bf16_t, WS_OA), WSP(bf16_t, WS_WBR) + (size_t)l * 3 * 1024 * 512, 512, 512, 512, OABC_STRIDE, (size_t)1024 * 512};
          pg8::MergeOrder S; S.init(((l == 3) ? NLAT : MT) / 256, 4, F.G, F.bx);
          pg8::EpiMerge E{WSP(bf16_t, WS_PROJ), WSP(bf16_t, WS_TMP), WSP(bf16_t, WS_YM)};
          GEMM_CALL(F.lds, F.tid, g, S, E); LAUNDER(); if (GEMM_REPEAT) { GEMM_CALL(F.lds, F.tid, g, S, E); LAUNDER(); } }
        GRID_BAR(); LAUNDER();
        if (DIGEST_AFTER == 6) { digest_phase(F, p, 6); return; }
        { pg8::Gemm g{WSP(bf16_t, WS_YM), WSP(bf16_t, WS_WOUT) + (size_t)l * 1024 * 1024, 1024, 1024, 1024, 0, 0};
          pg8::StaticOrder S; S.init(((l == 3) ? NLAT : MT) / 256, 4, F.G, F.bx);
          pg8::EpiBf16Out E{WSP(bf16_t, WS_OL), 1024};
          GEMM_CALL(F.lds, F.tid, g, S, E); LAUNDER(); if (GEMM_REPEAT) { GEMM_CALL(F.lds, F.tid, g, S, E); LAUNDER(); } }
        GRID_BAR(); LAUNDER();
        if (DIGEST_AFTER == 7) { digest_phase(F, p, 7); return; }
        p8_postmix(F, p, l);
        GRID_BAR(); LAUNDER();
        const int mrows = (l == 3) ? NLAT : MT;
        if ((l & 1) == 0) {
            LAUNDER();
            { pg8::Gemm g{WSP(bf16_t, WS_H), WSP(bf16_t, WS_WGU) + (size_t)li * 2 * FD * 1024, 1024, 1024, 1024, 0, 0};
              pg8::StaticOrder S; S.init(mrows / 256, 2 * FD / 256, F.G, F.bx);
              pg8::EpiSwiglu E{WSP(bf16_t, WS_HID), FD};
              GEMM_CALL(F.lds, F.tid, g, S, E); LAUNDER(); if (GEMM_REPEAT) { GEMM_CALL(F.lds, F.tid, g, S, E); LAUNDER(); } }
            GRID_BAR(); LAUNDER();
            { pg8::Gemm g{WSP(bf16_t, WS_HID), WSP(bf16_t, WS_WDN) + (size_t)li * 1024 * FD, FD, FD, FD, 0, 0};
              pg8::StaticOrder S; S.init(mrows / 256, 4, F.G, F.bx);
              pg8::EpiBf16Out E{WSP(bf16_t, WS_YP), 1024};
              GEMM_CALL(F.lds, F.tid, g, S, E); LAUNDER(); if (GEMM_REPEAT) { GEMM_CALL(F.lds, F.tid, g, S, E); LAUNDER(); } }
            GRID_BAR(); LAUNDER();
        } else {
            LAUNDER();
            p9_gather(F, p, l);
            GRID_BAR(); LAUNDER();
            { pg8::Gemm g{WSP(bf16_t, WS_HPERM), WSP(bf16_t, WS_MGU) + (size_t)li * 8 * 2 * FE * 1024, 1024, 1024, 1024, 0, (size_t)2 * FE * 1024};
              pg8::GroupOrder S; int ts[9]; moe_tile_starts(F, li, ts); { int* tp = WSP(int, WS_CTL) + 65536 + F.bx * 16;
#pragma unroll
                for (int j = 0; j < 9; ++j) tp[j] = ts[j];
                S.tsp = tp; } S.init(ts[8], 2 * FE / 256, F.G, F.bx);
              pg8::EpiSwiglu E{WSP(bf16_t, WS_HID), FE};
              GEMM_CALL(F.lds, F.tid, g, S, E); LAUNDER(); if (GEMM_REPEAT) { GEMM_CALL(F.lds, F.tid, g, S, E); LAUNDER(); } }
            GRID_BAR(); LAUNDER();
            { pg8::Gemm g{WSP(bf16_t, WS_HID), WSP(bf16_t, WS_MDN) + (size_t)li * 8 * 1024 * FE, FE, FE, FE, 0, (size_t)1024 * FE};
              pg8::GroupOrder S; int ts[9]; moe_tile_starts(F, li, ts); { int* tp = WSP(int, WS_CTL) + 65536 + F.bx * 16;
#pragma unroll
                for (int j = 0; j < 9; ++j) tp[j] = ts[j];
                S.tsp = tp; } S.init(ts[8], 4, F.G, F.bx);
              pg8::EpiBf16Out E{WSP(bf16_t, WS_YP), 1024};
              GEMM_CALL(F.lds, F.tid, g, S, E); LAUNDER(); if (GEMM_REPEAT) { GEMM_CALL(F.lds, F.tid, g, S, E); LAUNDER(); } }
            GRID_BAR(); LAUNDER();
        }
        p12_postffn(F, p, l);
        GRID_BAR(); LAUNDER();
        if (stop == 2 * l + 2) return;
    }
}

extern "C" void kernel_launch(void* const* d_in, const int* in_sizes, int n_in, void* d_out, int out_size, void* d_ws, size_t ws_size, hipStream_t stream) {
    static int grid = 0;
    if (grid == 0) {
        if (n_in != 30 || out_size != NLAT * D || ws_size < WS_END) { fprintf(stderr, "kernel_launch: unexpected shapes (n_in %d out %d ws %zu, need ws >= %zu); nothing launched\n", n_in, out_size, ws_size, (size_t)WS_END); grid = -1; return; }
        int dev = 0, cus = 0, per_cu = 0;
        if (hipGetDevice(&dev) != hipSuccess || hipDeviceGetAttribute(&cus, hipDeviceAttributeMultiprocessorCount, dev) != hipSuccess) { grid = -1; return; }
        if (hipFuncSetAttribute((const void*)mk_fwd, hipFuncAttributeMaxDynamicSharedMemorySize, LDS_BYTES) != hipSuccess) { fprintf(stderr, "kernel_launch: hipFuncSetAttribute failed\n"); grid = -1; return; }
        if (hipOccupancyMaxActiveBlocksPerMultiprocessor(&per_cu, (const void*)mk_fwd, 512, LDS_BYTES) != hipSuccess || per_cu < 1)
            fprintf(stderr, "kernel_launch: occupancy query reports %d blocks per CU\n", per_cu);
        (void)hipGetLastError();
        grid = cus;
    }
    if (grid < 0) return;
    (void)hipMemsetAsync((char*)d_ws + WS_CTL, 0, CTL_BYTES, stream);
    Params p{};
    for (int i = 0; i < 30; ++i) p.in[i] = (const float*)d_in[i];
    p.out = (float*)d_out; p.ws = (unsigned char*)d_ws; p.stop_after = STOP_AFTER; p.pad = 0;
    hipLaunchKernelGGL(mk_fwd, dim3(grid), dim3(512), LDS_BYTES, stream, p);
}
```

```cpp
#include <hip/hip_runtime.h>
#include <cstdio>
#include <cstdint>


#define USE_SG32S 1
#define GEMM_REPEAT 0
#define CMLP_SCAN_SHARE 0
#define ATT_REPEAT 1

#define USE_SG 1
#define LDSZERO 1
#ifndef STOP_AFTER
#define STOP_AFTER 8
#endif

#define LAS __attribute__((address_space(3)))
#define GAS __attribute__((address_space(1)))
typedef unsigned short bf16_t;
typedef short bf16x8 __attribute__((ext_vector_type(8)));
typedef float f32x4 __attribute__((ext_vector_type(4)));
typedef float f32x16 __attribute__((ext_vector_type(16)));
typedef unsigned u32x4 __attribute__((ext_vector_type(4)));
typedef unsigned u32x2 __attribute__((ext_vector_type(2)));

constexpr int D = 1024, NB = 8, SEQ = 4096, CTXL = 256;
constexpr int NLAT = NB * SEQ, NCTX = NB * CTXL, MT = NLAT + NCTX, NKEY = CTXL + SEQ;
constexpr int PLD = 6912;
constexpr int PK = 0, PV = 128, PRKV = 256, PWLOW = 1792, PALOW = 1920, PGLOW = 2048, PQ = 2304, PUV = 2816, PGATE = 3840;
constexpr int FD = 2816, FE = 3584, NE = 8;
constexpr int INW = 6784;
constexpr int MOE_CAP_ROWS = 71680;
constexpr float EPS = 1e-6f;

constexpr size_t MiB = 1u << 20;
constexpr size_t WS_CTL = 0, CTL_BYTES = 1 * MiB;
constexpr size_t WS_MODV = 1 * MiB, WS_ROPE = 2 * MiB, WS_ROUTE = 3 * MiB, WS_PROW = 5 * MiB, WS_WCM = 6 * MiB, WS_WLORA = 8 * MiB;
constexpr size_t WS_WIN = 16 * MiB, WS_WBR = 70 * MiB, WS_WOUT = 82 * MiB, WS_WGU = 90 * MiB, WS_WDN = 112 * MiB, WS_MGU = 124 * MiB, WS_MDN = 348 * MiB;
constexpr size_t WS_XC = 460 * MiB, WS_H = 468 * MiB, WS_PROJ = 536 * MiB, WS_QN = 995 * MiB, WS_KN = 1029 * MiB, WS_VT = 1038 * MiB;
constexpr size_t WS_WDEC = 1047 * MiB, WS_AICLR = 1183 * MiB, WS_GG = 1251 * MiB, WS_YFB = 1285 * MiB, WS_OA = 1421 * MiB;
constexpr size_t WS_TMP = WS_WDEC, WS_YM = WS_AICLR, WS_OL = WS_YFB;
constexpr size_t WS_HID = 536 * MiB, WS_HPERM = 1026 * MiB, WS_YP = 1166 * MiB;
constexpr size_t WS_XB = 1523 * MiB;
constexpr size_t WS_END = 1591 * MiB;
constexpr size_t OABC_STRIDE = 34 * MiB / 2;
constexpr int CW_BAR = 4096, CW_MOE = 16384;

constexpr int LDS_BYTES = 147456, LDS_MISC = 131072;

struct Params { const float* in[30]; float* out; unsigned char* ws; int stop_after; int pad; };

__device__ __forceinline__ const float* inp(const Params& p, int k) { unsigned long long q = (unsigned long long)p.in[k]; asm volatile("" : "+s"(q)); return (const float*)(GAS const float*)q; }
__device__ __forceinline__ float* outp(const Params& p) { unsigned long long q = (unsigned long long)p.out; asm volatile("" : "+s"(q)); return (float*)(GAS float*)q; }
__device__ __forceinline__ int lane_id() { int l; asm volatile("v_mbcnt_lo_u32_b32 %0, -1, 0\n\tv_mbcnt_hi_u32_b32 %0, -1, %0" : "=v"(l)); return l; }
typedef __bf16 bf16x2_t __attribute__((ext_vector_type(2)));
typedef float f32x2_t __attribute__((ext_vector_type(2)));
__device__ __forceinline__ unsigned pk2(float lo, float hi) { f32x2_t v = {lo, hi}; bf16x2_t b = __builtin_convertvector(v, bf16x2_t); return __builtin_bit_cast(unsigned, b); }
__device__ __forceinline__ float bflo(unsigned u) { return __uint_as_float(u << 16); }
__device__ __forceinline__ float bfhi(unsigned u) { return __uint_as_float(u & 0xffff0000u); }
__device__ __forceinline__ float bf1(bf16_t b) { return __uint_as_float(((unsigned)b) << 16); }
__device__ __forceinline__ f32x4 unp4(u32x2 v) { return (f32x4){bflo(v.x), bfhi(v.x), bflo(v.y), bfhi(v.y)}; }
__device__ __forceinline__ float fexp2(float x) { return __builtin_amdgcn_exp2f(x); }
__device__ __forceinline__ float frcp(float x) { return __builtin_amdgcn_rcpf(x); }
__device__ __forceinline__ float frsq(float x) { return __builtin_amdgcn_rsqf(x); }
__device__ __forceinline__ float fsig(float x) { return frcp(1.f + fexp2(-1.44269504089f * x)); }
__device__ __forceinline__ float ftanh(float x) { return 2.f * fsig(2.f * x) - 1.f; }
__device__ __forceinline__ float fgelu(float x) { return x * fsig(1.5957691216f * (x + 0.044715f * x * x * x)); }
template <int CTRL> __device__ __forceinline__ float dppf(float v) { return __int_as_float(__builtin_amdgcn_update_dpp(0, __float_as_int(v), CTRL, 0xF, 0xF, true)); }
__device__ __forceinline__ float dpp_sum16(float v) {
    v += dppf<0xB1>(v); v += dppf<0x4E>(v); v += dppf<0x141>(v); v += dppf<0x140>(v); return v;
}
__device__ __forceinline__ float sum4(float v) { v += dppf<0xB1>(v); v += dppf<0x4E>(v); return v; }
__device__ __forceinline__ float sum8(float v) { v += dppf<0xB1>(v); v += dppf<0x4E>(v); v += dppf<0x141>(v); return v; }
__device__ __forceinline__ float rlf(float v, int l) { return __int_as_float(__builtin_amdgcn_readlane(__float_as_int(v), l)); }
__device__ __forceinline__ float wave_sum(float v) { v = dpp_sum16(v); return (rlf(v, 0) + rlf(v, 16)) + (rlf(v, 32) + rlf(v, 48)); }

#define XB_TMO      128
#define XB_XCNT(j)  (256  + 64 * (j))
#define XB_XSUB(j)  (1280 + 64 * (j))
#define XB_XGEN(j)  (2304 + 64 * (j))
#define XB_TOP      3328
#define XB_TOPGEN   3392
#define XCD_BAR_WORDS 3456
#define XB_SPIN_CAP (1u << 20)

__device__ __forceinline__ unsigned xb_ld(unsigned* p)              { return __hip_atomic_load(p, __ATOMIC_RELAXED, __HIP_MEMORY_SCOPE_AGENT); }
__device__ __forceinline__ unsigned xb_add(unsigned* p, unsigned v) { return __hip_atomic_fetch_add(p, v, __ATOMIC_RELAXED, __HIP_MEMORY_SCOPE_AGENT); }
__device__ __forceinline__ unsigned xb_xcc_id() { return (unsigned)__builtin_amdgcn_s_getreg((3 << 11) | 20) & 0xFu; }
#define XB_SPIN(cond, bar) do { unsigned _sp = 0; while (cond) { __builtin_amdgcn_s_sleep(1); \
    if ((++_sp & 255u) == 0u) { if (xb_ld(&(bar)[XB_TMO])) break; if (_sp > XB_SPIN_CAP) { atomicAdd(&(bar)[XB_TMO], 1u); break; } } } } while (0)

struct XcdBarrier { unsigned* bar; unsigned x; volatile LAS unsigned* st; };

__device__ __forceinline__ XcdBarrier xcd_barrier_post(unsigned* bar, volatile LAS unsigned* st) {
    XcdBarrier b; b.bar = bar; b.x = xb_xcc_id(); b.st = st;
    if (threadIdx.x == 0) (void)xb_add(&bar[XB_XCNT(b.x)], 1u);
    return b;
}
__device__ __forceinline__ void xcd_barrier_complete(unsigned* bar, unsigned x, unsigned& nloc, unsigned& nx) {
    const unsigned G = gridDim.x * gridDim.y * gridDim.z;
    unsigned sum, cnt, mine, sp = 0u;
    for (;;) {
        sum = 0u; cnt = 0u; mine = 0u;
#pragma unroll
        for (unsigned j = 0; j < 16; ++j) { const unsigned c = xb_ld(&bar[XB_XCNT(j)]); sum += c; cnt += (c > 0u) ? 1u : 0u; mine = (j == x) ? c : mine; }
        if (sum == G) break;
        __builtin_amdgcn_s_sleep(1);
        if ((++sp & 255u) == 0u) { if (xb_ld(&bar[XB_TMO])) break; if (sp > XB_SPIN_CAP) { atomicAdd(&bar[XB_TMO], 1u); break; } }
    }
    nloc = mine > 0u ? mine : 1u; nx = cnt > 0u ? cnt : 1u;
}
__device__ __forceinline__ void xcd_barrier(const XcdBarrier& b, const bool is_t0) {
    asm volatile("s_waitcnt vmcnt(0)" ::: "memory");
    __syncthreads();
    if (is_t0) {
        unsigned* bar = b.bar;
        __builtin_amdgcn_s_waitcnt(0);
        unsigned nloc = b.st[0], nx = b.st[1];
        if (nloc == 0u) { xcd_barrier_complete(bar, b.x, nloc, nx); b.st[0] = nloc; b.st[1] = nx; }
        const unsigned old = xb_add(&bar[XB_XSUB(b.x)], 1u);
        const unsigned gen = old / nloc;
        if (old + 1u == (gen + 1u) * nloc) {
            __builtin_amdgcn_fence(__ATOMIC_RELEASE, "agent");
            asm volatile("s_waitcnt vmcnt(0)" ::: "memory");
            const unsigned og = xb_add(&bar[XB_TOP], 1u);
            const unsigned tg = og / nx;
            if (og + 1u == (tg + 1u) * nx) xb_add(&bar[XB_TOPGEN], 1u);
            else XB_SPIN(xb_ld(&bar[XB_TOPGEN]) == tg, bar);
            __builtin_amdgcn_fence(__ATOMIC_ACQUIRE, "agent");
            xb_add(&bar[XB_XGEN(b.x)], 1u);
            asm volatile("s_waitcnt vmcnt(0)" ::: "memory");
        } else {
            XB_SPIN(xb_ld(&bar[XB_XGEN(b.x)]) == gen, bar);
            __builtin_amdgcn_fence(__ATOMIC_ACQUIRE, "agent");
            asm volatile("s_waitcnt vmcnt(0)" ::: "memory");
        }
    }
    __syncthreads();
}

namespace pg8 {
constexpr int BM = 256, BK = 64, HALF = 128, HTB = HALF * BK * 2, STAGE_BYTES = 8 * HTB, NXCD = 8, WGM = 8;
__host__ __device__ __forceinline__ int lds_byte(int r, int c) { const int st = (r >> 4) * 2 + (c >> 5), rr = r & 15, cc = c & 31, ob = rr * 64 + cc * 2; return st * 1024 + (ob ^ (((ob >> 9) & 1) << 5)); }
__host__ __device__ __forceinline__ void stage_rc(int b, int& R, int& C) { const int st = b / 1024, sb = b % 1024, swz = sb ^ (((sb >> 9) & 1) << 5); R = (st >> 1) * 16 + swz / 64; C = (st & 1) * 32 + (swz % 64) / 2; }
__host__ __device__ __forceinline__ int perm32(int rho) { const int n = rho >> 4, i = rho & 15; return 8 * (i >> 2) + 4 * n + (i & 3); }

struct Unit { int pm, pn, ga, gb; };
struct Gemm { const bf16_t* A; const bf16_t* Bt; int K, lda, ldb; size_t agstride, bgstride; };

struct StaticOrder {
    int nM, nN, nwg, G, c;
    __device__ void init(int nM_, int nN_, int G_, int c_) { nM = nM_; nN = nN_; nwg = nM * nN; G = G_; c = c_; }
    __device__ bool map(long L, Unit& u) const {
        if (L >= nwg) return false;
        int wgid = (int)L; { const int q = nwg / NXCD, r = nwg % NXCD, xcd = wgid % NXCD, off = wgid / NXCD; wgid = (xcd < r ? xcd * (q + 1) : r * (q + 1) + (xcd - r) * q) + off; }
        const int nig = WGM * nN, gid = wgid / nig, fm = gid * WGM, gsz = (nM - fm) < WGM ? (nM - fm) : WGM;
        u.pm = fm + ((wgid % nig) % gsz); u.pn = (wgid % nig) / gsz; u.ga = 0; u.gb = 0; return true;
    }
    __device__ bool next(int i, Unit& u) const { return map((long)i * G + c, u); }
    __device__ int kbeg(const Unit&) const { return 0; }
    __device__ int ksteps(const Unit&, int full) const { return full; }
};
struct InProjOrder {
    StaticOrder lat; int nlat, nctxN, ntot;
    __device__ void init2(int nMlat, int nMctx, int nN_, int nctxN_, int G_, int c_) { lat.init(nMlat, nN_, G_, c_); nlat = lat.nwg; nctxN = nctxN_; ntot = nlat + nMctx * nctxN_; }
    __device__ bool next(int i, Unit& u) const {
        const long Lx = (long)i * lat.G + lat.c;
        if (Lx >= ntot) return false;
        if (Lx < nlat) return lat.map(Lx, u);
        const int j = (int)(Lx - nlat); u.pm = lat.nM + j / nctxN; u.pn = j % nctxN; u.ga = 0; u.gb = 0; return true;
    }
    __device__ int kbeg(const Unit&) const { return 0; }
    __device__ int ksteps(const Unit&, int full) const { return full; }
};
struct LoraOrder : StaticOrder {
    __device__ int kbeg(const Unit& u) const { return u.pn < 8 ? 2 * (u.pn >> 1) : 8; }
    __device__ int ksteps(const Unit& u, int) const { return u.pn < 8 ? 2 : 4; }
};
struct MergeOrder : StaticOrder {
    __device__ bool next(int i, Unit& u) const { const int t = i / 3, br = i - 3 * t; if (!map((long)t * G + c, u)) return false; u.ga = br; u.gb = br; return true; }
};
struct GroupOrder : StaticOrder {
    const LAS int* tsp;
    __device__ bool next(int i, Unit& u) const {
        if (!map((long)i * G + c, u)) return false;
        int e = 0;
#pragma unroll
        for (int j = 1; j < 8; ++j) e += (u.pm >= tsp[j]) ? 1 : 0;
        u.gb = __builtin_amdgcn_readfirstlane(e); return true;
    }
};

template <class Epi, class Sched>
__device__ __forceinline__ void gemm_phase(LAS unsigned char* lds, const int tid, const Gemm g, const Sched& S, const Epi& E) {
    const int wid = __builtin_amdgcn_readfirstlane(tid >> 6), lane = tid & 63, wr = wid >> 2, wc = wid & 3, fr = lane & 15, fq = lane >> 4;
    const int K = g.K, nt = K / BK;
    unsigned voffA[2], voffB[2];
#pragma unroll
    for (int i = 0; i < 2; ++i) { int R, C; stage_rc(tid * 16 + i * 8192, R, C); const int Rb = Epi::PERM ? ((R & ~31) + perm32(R & 31)) : R;
        voffA[i] = (unsigned)(R * g.lda + C) * 2u; voffB[i] = (unsigned)(Rb * g.ldb + C) * 2u; }
    const size_t kstep = (size_t)(BK * 2);
    const size_t hsA = (size_t)HALF * g.lda * 2, hsB = (size_t)HALF * g.ldb * 2;
    const size_t tsA = 2 * hsA, tsB = 2 * hsB;
    const unsigned ldsw = (unsigned)wid * 1024u;
    const int aoff = lds_byte(wr * 64 + fr, fq * 8), boff = lds_byte(wc * 32 + fr, fq * 8);
#define PG8_SA(b, h) (((b) * 2 + (h)) * HTB)
#define PG8_SB(b, h) ((4 + (b) * 2 + (h)) * HTB)
#define PG8_STAGE(bufoff, gbase, voff) do { _Pragma("unroll") for (int _i = 0; _i < 2; ++_i) \
        __builtin_amdgcn_global_load_lds((const unsigned*)((const char*)(gbase) + (voff)[_i]), (LAS unsigned*)(lds + (bufoff) + ldsw + _i * 8192), 16, 0, 0); } while (0)
#define PG8_LDA(dst, b, h) do { _Pragma("unroll") for (int m = 0; m < 4; ++m) _Pragma("unroll") for (int k = 0; k < 2; ++k) dst[m][k] = *(const LAS bf16x8*)(lds + PG8_SA(b, h) + aoff + m * 2048 + k * 1024); } while (0)
#define PG8_LDB(dst, b, h) do { _Pragma("unroll") for (int n = 0; n < 2; ++n) _Pragma("unroll") for (int k = 0; k < 2; ++k) dst[n][k] = *(const LAS bf16x8*)(lds + PG8_SB(b, h) + boff + n * 2048 + k * 1024); } while (0)
#define PG8_MMA(ai, bj, At, Bt) do { __builtin_amdgcn_s_setprio(1); _Pragma("unroll") for (int m = 0; m < 4; ++m) _Pragma("unroll") for (int n = 0; n < 2; ++n) _Pragma("unroll") for (int k = 0; k < 2; ++k) \
        acc[ai][bj][m][n] = __builtin_amdgcn_mfma_f32_16x16x32_bf16(Bt[n][k], At[m][k], acc[ai][bj][m][n], 0, 0, 0); __builtin_amdgcn_s_setprio(0); } while (0)
#define PG8_WAIT_V(n) asm volatile("s_waitcnt vmcnt(" #n ")" ::: "memory")
#define PG8_WAIT_L(n) asm volatile("s_waitcnt lgkmcnt(" #n ")" ::: "memory")
#define PG8_BAR __builtin_amdgcn_s_barrier()
#define PG8_SCHED __builtin_amdgcn_sched_barrier(0)
    Unit cur, nxt; int ui = 0;
    if (!S.next(0, cur)) return;
    f32x4 acc[2][2][4][2];
#pragma unroll
    for (int a = 0; a < 2; ++a)
#pragma unroll
        for (int b = 0; b < 2; ++b)
#pragma unroll
            for (int m = 0; m < 4; ++m)
#pragma unroll
                for (int n = 0; n < 2; ++n) acc[a][b][m][n] = (f32x4){0.f, 0.f, 0.f, 0.f};
    bf16x8 At[4][2], B0[2][2], B1[2][2];
    const char* cA = (const char*)g.A + ((size_t)cur.ga * g.agstride) * 2 + (size_t)cur.pm * tsA;
    const char* cB = (const char*)g.Bt + ((size_t)cur.gb * g.bgstride) * 2 + (size_t)cur.pn * tsB;
    PG8_STAGE(PG8_SB(0, 0), cB, voffB); PG8_STAGE(PG8_SA(0, 0), cA, voffA); PG8_STAGE(PG8_SB(0, 1), cB + hsB, voffB); PG8_STAGE(PG8_SA(0, 1), cA + hsA, voffA);
    if (wr == 1) PG8_BAR;
    PG8_WAIT_V(4); PG8_BAR;
    PG8_STAGE(PG8_SB(1, 0), cB + kstep, voffB); PG8_STAGE(PG8_SA(1, 0), cA + kstep, voffA); PG8_STAGE(PG8_SB(1, 1), cB + hsB + kstep, voffB);
    PG8_WAIT_V(6); PG8_BAR;
    for (;;) {
        const bool has_next = S.next(ui + 1, nxt);
        const char* nA = has_next ? (const char*)g.A + ((size_t)nxt.ga * g.agstride) * 2 + (size_t)nxt.pm * tsA : cA;
        const char* nB = has_next ? (const char*)g.Bt + ((size_t)nxt.gb * g.bgstride) * 2 + (size_t)nxt.pn * tsB : cB;
        for (int t = 0; t < nt; t += 2) {
            const bool last = (t == nt - 2);
            const char* a1 = cA + (size_t)(t + 1) * kstep;
            const char* a2 = last ? nA : cA + (size_t)(t + 2) * kstep; const char* b2 = last ? nB : cB + (size_t)(t + 2) * kstep;
            const char* a3 = a2 + kstep; const char* b3 = b2 + kstep;
            PG8_LDB(B0, 0, 0); PG8_SCHED; PG8_LDA(At, 0, 0); PG8_STAGE(PG8_SA(1, 1), a1 + hsA, voffA);
            PG8_WAIT_L(8); PG8_BAR; PG8_WAIT_L(0); PG8_MMA(0, 0, At, B0); PG8_BAR; PG8_SCHED;
            PG8_LDB(B1, 0, 1); PG8_STAGE(PG8_SB(0, 0), b2, voffB);
            PG8_BAR; PG8_WAIT_L(0); PG8_MMA(0, 1, At, B1); PG8_BAR;
            PG8_LDA(At, 0, 1); PG8_STAGE(PG8_SA(0, 0), a2, voffA);
            PG8_BAR; PG8_WAIT_L(0); PG8_MMA(1, 0, At, B0); PG8_BAR; PG8_SCHED;
            PG8_STAGE(PG8_SB(0, 1), b2 + hsB, voffB);
            PG8_WAIT_V(6); PG8_BAR; PG8_MMA(1, 1, At, B1); PG8_BAR;
            PG8_LDB(B0, 1, 0); PG8_SCHED; PG8_LDA(At, 1, 0); PG8_STAGE(PG8_SA(0, 1), a2 + hsA, voffA);
            PG8_WAIT_L(8); PG8_BAR; PG8_WAIT_L(0); PG8_MMA(0, 0, At, B0); PG8_BAR; PG8_SCHED;
            PG8_LDB(B1, 1, 1); PG8_STAGE(PG8_SB(1, 0), b3, voffB);
            PG8_BAR; PG8_WAIT_L(0); PG8_MMA(0, 1, At, B1); PG8_BAR;
            PG8_LDA(At, 1, 1); PG8_STAGE(PG8_SA(1, 0), a3, voffA);
            PG8_BAR; PG8_WAIT_L(0); PG8_MMA(1, 0, At, B0); PG8_BAR; PG8_SCHED;
            PG8_STAGE(PG8_SB(1, 1), b3 + hsB, voffB);
            PG8_WAIT_V(6); PG8_BAR; PG8_MMA(1, 1, At, B1); PG8_BAR;
        }
        { const int l2 = lane_id(); E(acc, cur, wr, wc, l2 & 15, l2 >> 4); }
        if (!has_next) break;
#pragma unroll
        for (int a = 0; a < 2; ++a)
#pragma unroll
            for (int b = 0; b < 2; ++b)
#pragma unroll
                for (int m = 0; m < 4; ++m)
#pragma unroll
                    for (int n = 0; n < 2; ++n) acc[a][b][m][n] = (f32x4){0.f, 0.f, 0.f, 0.f};
        cur = nxt; cA = nA; cB = nB; ++ui;
    }
    PG8_WAIT_V(0);
    if (wr == 0) PG8_BAR;
    PG8_BAR;
#undef PG8_SA
#undef PG8_SB
#undef PG8_STAGE
#undef PG8_LDA
#undef PG8_LDB
#undef PG8_MMA
#undef PG8_WAIT_V
#undef PG8_WAIT_L
#undef PG8_BAR
#undef PG8_SCHED
}


template <class Epi, class Sched>
__device__ __forceinline__ void gemm_simple(LAS unsigned char* lds, const int tid, const Gemm g, const Sched& S, const Epi& E) {
    const int wid = __builtin_amdgcn_readfirstlane(tid >> 6), lane = tid & 63, wr = wid >> 2, wc = wid & 3, fr = lane & 15, fq = lane >> 4;
    const int nt = g.K / 64, lrow = tid >> 3, lch = tid & 7;
    LAS unsigned char* As = lds; LAS unsigned char* Bs = lds + 36864;
    unsigned offA[4], offB[4];
#pragma unroll
    for (int i = 0; i < 4; ++i) { const int slot = lrow + 64 * i; const int br = Epi::PERM ? ((slot & ~31) + perm32(slot & 31)) : slot;
        offA[i] = (unsigned)(slot * g.lda + lch * 8) * 2u; offB[i] = (unsigned)(br * g.ldb + lch * 8) * 2u; }
    const unsigned wofs = (unsigned)(lrow * 144 + lch * 16);
    const unsigned aofs = (unsigned)((64 * wr + fr) * 144 + fq * 16), bofs = (unsigned)((32 * wc + fr) * 144 + fq * 16);
    Unit u;
    for (int ui = 0; S.next(ui, u); ++ui) {
        const char* Ab = (const char*)g.A + ((size_t)u.ga * g.agstride + (size_t)u.pm * 256 * g.lda) * 2;
        const char* Bb = (const char*)g.Bt + ((size_t)u.gb * g.bgstride + (size_t)u.pn * 256 * g.ldb) * 2;
        f32x4 acc[2][2][4][2];
#pragma unroll
        for (int a = 0; a < 2; ++a)
#pragma unroll
            for (int b = 0; b < 2; ++b)
#pragma unroll
                for (int m = 0; m < 4; ++m)
#pragma unroll
                    for (int n = 0; n < 2; ++n) acc[a][b][m][n] = (f32x4){0.f, 0.f, 0.f, 0.f};
        u32x4 ra[4], rb[4];
#pragma unroll
        for (int i = 0; i < 4; ++i) { ra[i] = *(const u32x4*)(Ab + offA[i]); rb[i] = *(const u32x4*)(Bb + offB[i]); }
        for (int t = 0; t < nt; ++t) {
            if (t > 0) __syncthreads();
#pragma unroll
            for (int i = 0; i < 4; ++i) { *(LAS u32x4*)(As + wofs + i * 9216) = ra[i]; *(LAS u32x4*)(Bs + wofs + i * 9216) = rb[i]; }
            __syncthreads();
            if (t + 1 < nt) { const char* An = Ab + (size_t)(t + 1) * 128; const char* Bn = Bb + (size_t)(t + 1) * 128;
#pragma unroll
                for (int i = 0; i < 4; ++i) { ra[i] = *(const u32x4*)(An + offA[i]); rb[i] = *(const u32x4*)(Bn + offB[i]); } }
#pragma unroll 1
            for (int kk = 0; kk < 2; ++kk) {
                bf16x8 Bf[2][2];
#pragma unroll
                for (int bj = 0; bj < 2; ++bj)
#pragma unroll
                    for (int n = 0; n < 2; ++n) Bf[bj][n] = *(const LAS bf16x8*)(Bs + bofs + (128 * bj + 16 * n) * 144 + kk * 64);
#pragma unroll
                for (int ai = 0; ai < 2; ++ai) {
                    bf16x8 Af[4];
#pragma unroll
                    for (int m = 0; m < 4; ++m) Af[m] = *(const LAS bf16x8*)(As + aofs + (128 * ai + 16 * m) * 144 + kk * 64);
#pragma unroll
                    for (int m = 0; m < 4; ++m)
#pragma unroll
                        for (int bj = 0; bj < 2; ++bj)
#pragma unroll
                            for (int n = 0; n < 2; ++n) acc[ai][bj][m][n] = __builtin_amdgcn_mfma_f32_16x16x32_bf16(Bf[bj][n], Af[m], acc[ai][bj][m][n], 0, 0, 0);
                }
            }
        }
        { const int l2 = lane_id(); E(acc, u, wr, wc, l2 & 15, l2 >> 4); }
        __syncthreads();
    }
}

template <class Epi, class Sched>
__device__ __forceinline__ void gemm_sg32(LAS unsigned char* lds, const int tid, const Gemm g, const Sched& S, const Epi& E) {
    const int wid = __builtin_amdgcn_readfirstlane(tid >> 6), lane = tid & 63, wr = wid >> 2, wc = wid & 3, fr = lane & 15, fq = lane >> 4;
    const int nt = g.K / 32, lrow = tid >> 2, lch = tid & 3;
    LAS unsigned char* As = lds; LAS unsigned char* Bs = lds + 20480;
    unsigned offA[2], offB[2];
#pragma unroll
    for (int i = 0; i < 2; ++i) { const int slot = lrow + 128 * i; const int br = Epi::PERM ? ((slot & ~31) + perm32(slot & 31)) : slot;
        offA[i] = (unsigned)(slot * g.lda + lch * 8) * 2u; offB[i] = (unsigned)(br * g.ldb + lch * 8) * 2u; }
    const unsigned wofs = (unsigned)(lrow * 80 + lch * 16);
    const unsigned aofs = (unsigned)((64 * wr + fr) * 80 + fq * 16), bofs = (unsigned)((32 * wc + fr) * 80 + fq * 16);
    Unit u;
    for (int ui = 0; S.next(ui, u); ++ui) {
        const char* Ab = (const char*)g.A + ((size_t)u.ga * g.agstride + (size_t)u.pm * 256 * g.lda) * 2;
        const char* Bb = (const char*)g.Bt + ((size_t)u.gb * g.bgstride + (size_t)u.pn * 256 * g.ldb) * 2;
        f32x4 acc[2][2][4][2];
#pragma unroll
        for (int a = 0; a < 2; ++a)
#pragma unroll
            for (int b = 0; b < 2; ++b)
#pragma unroll
                for (int m = 0; m < 4; ++m)
#pragma unroll
                    for (int n = 0; n < 2; ++n) acc[a][b][m][n] = (f32x4){0.f, 0.f, 0.f, 0.f};
        u32x4 ra[2], rb[2];
#pragma unroll
        for (int i = 0; i < 2; ++i) { ra[i] = *(const u32x4*)(Ab + offA[i]); rb[i] = *(const u32x4*)(Bb + offB[i]); }
#pragma unroll 1
        for (int t = 0; t < nt; ++t) {
            if (t > 0) __syncthreads();
#pragma unroll
            for (int i = 0; i < 2; ++i) { *(LAS u32x4*)(As + wofs + i * 10240) = ra[i]; *(LAS u32x4*)(Bs + wofs + i * 10240) = rb[i]; }
            __syncthreads();
            if (t + 1 < nt) { const char* An = Ab + (size_t)(t + 1) * 64; const char* Bn = Bb + (size_t)(t + 1) * 64;
#pragma unroll
                for (int i = 0; i < 2; ++i) { ra[i] = *(const u32x4*)(An + offA[i]); rb[i] = *(const u32x4*)(Bn + offB[i]); } }
            bf16x8 Bf[2][2];
#pragma unroll
            for (int bj = 0; bj < 2; ++bj)
#pragma unroll
                for (int n = 0; n < 2; ++n) Bf[bj][n] = *(const LAS bf16x8*)(Bs + bofs + (128 * bj + 16 * n) * 80);
#pragma unroll
            for (int ai = 0; ai < 2; ++ai) {
                bf16x8 Af[4];
#pragma unroll
                for (int m = 0; m < 4; ++m) Af[m] = *(const LAS bf16x8*)(As + aofs + (128 * ai + 16 * m) * 80);
#pragma unroll
                for (int m = 0; m < 4; ++m)
#pragma unroll
                    for (int bj = 0; bj < 2; ++bj)
#pragma unroll
                        for (int n = 0; n < 2; ++n) acc[ai][bj][m][n] = __builtin_amdgcn_mfma_f32_16x16x32_bf16(Bf[bj][n], Af[m], acc[ai][bj][m][n], 0, 0, 0);
            }
        }
        { const int l2 = lane_id(); E(acc, u, wr, wc, l2 & 15, l2 >> 4); }
        __syncthreads();
    }
}

template <class Epi, class Sched>
__device__ __forceinline__ void gemm_sg32d(LAS unsigned char* lds, const int tid, const Gemm g, const Sched& S, const Epi& E) {
    const int wid = __builtin_amdgcn_readfirstlane(tid >> 6), lane = tid & 63, wr = wid >> 2, wc = wid & 3, fr = lane & 15, fq = lane >> 4;
    const int nt = g.K / 32, lrow = tid >> 2, lch = tid & 3;
    unsigned offA[2], offB[2];
#pragma unroll
    for (int i = 0; i < 2; ++i) { const int slot = lrow + 128 * i; const int br = Epi::PERM ? ((slot & ~31) + perm32(slot & 31)) : slot;
        offA[i] = (unsigned)(slot * g.lda + lch * 8) * 2u; offB[i] = (unsigned)(br * g.ldb + lch * 8) * 2u; }
    const unsigned wofs = (unsigned)(lrow * 64 + ((lch ^ ((lrow >> 2) & 3)) * 16));
    const unsigned sw = (unsigned)((fq ^ ((fr >> 2) & 3)) * 16);
    const unsigned aofs = (unsigned)((64 * wr + fr) * 64) + sw, bofs = 16384u + (unsigned)((32 * wc + fr) * 64) + sw;
    Unit u;
    for (int ui = 0; S.next(ui, u); ++ui) {
        const char* Ab = (const char*)g.A + ((size_t)u.ga * g.agstride + (size_t)u.pm * 256 * g.lda) * 2;
        const char* Bb = (const char*)g.Bt + ((size_t)u.gb * g.bgstride + (size_t)u.pn * 256 * g.ldb) * 2;
        f32x4 acc[2][2][4][2];
#pragma unroll
        for (int a = 0; a < 2; ++a)
#pragma unroll
            for (int b = 0; b < 2; ++b)
#pragma unroll
                for (int m = 0; m < 4; ++m)
#pragma unroll
                    for (int n = 0; n < 2; ++n) acc[a][b][m][n] = (f32x4){0.f, 0.f, 0.f, 0.f};
        u32x4 ra[2], rb[2];
#pragma unroll
        for (int i = 0; i < 2; ++i) { ra[i] = *(const u32x4*)(Ab + offA[i]); rb[i] = *(const u32x4*)(Bb + offB[i]); }
#pragma unroll
        for (int i = 0; i < 2; ++i) { *(LAS u32x4*)(lds + wofs + i * 8192) = ra[i]; *(LAS u32x4*)(lds + 16384 + wofs + i * 8192) = rb[i]; }
        if (nt > 1) {
#pragma unroll
            for (int i = 0; i < 2; ++i) { ra[i] = *(const u32x4*)(Ab + 64 + offA[i]); rb[i] = *(const u32x4*)(Bb + 64 + offB[i]); } }
        __syncthreads();
#pragma unroll 1
        for (int t = 0; t < nt; ++t) {
            LAS unsigned char* cur = lds + (t & 1) * 32768;
            bf16x8 Bf[2][2], Af[2][4];
#pragma unroll
            for (int bj = 0; bj < 2; ++bj)
#pragma unroll
                for (int n = 0; n < 2; ++n) Bf[bj][n] = *(const LAS bf16x8*)(cur + bofs + (128 * bj + 16 * n) * 64);
#pragma unroll
            for (int ai = 0; ai < 2; ++ai)
#pragma unroll
                for (int m = 0; m < 4; ++m) Af[ai][m] = *(const LAS bf16x8*)(cur + aofs + (128 * ai + 16 * m) * 64);
            __builtin_amdgcn_sched_barrier(0);
            if (t + 1 < nt) {
                LAS unsigned char* nxt = lds + ((t + 1) & 1) * 32768;
#pragma unroll
                for (int i = 0; i < 2; ++i) { *(LAS u32x4*)(nxt + wofs + i * 8192) = ra[i]; *(LAS u32x4*)(nxt + 16384 + wofs + i * 8192) = rb[i]; }
                if (t + 2 < nt) { const char* An = Ab + (size_t)(t + 2) * 64; const char* Bn = Bb + (size_t)(t + 2) * 64;
#pragma unroll
                    for (int i = 0; i < 2; ++i) { ra[i] = *(const u32x4*)(An + offA[i]); rb[i] = *(const u32x4*)(Bn + offB[i]); } }
            }
            __builtin_amdgcn_sched_barrier(0);
#pragma unroll
            for (int ai = 0; ai < 2; ++ai)
#pragma unroll
                for (int m = 0; m < 4; ++m)
#pragma unroll
                    for (int bj = 0; bj < 2; ++bj)
#pragma unroll
                        for (int n = 0; n < 2; ++n) acc[ai][bj][m][n] = __builtin_amdgcn_mfma_f32_16x16x32_bf16(Bf[bj][n], Af[ai][m], acc[ai][bj][m][n], 0, 0, 0);
            __syncthreads();
        }
        { const int l2 = lane_id(); E(acc, u, wr, wc, l2 & 15, l2 >> 4); }
    }
}

template <class Epi, class Sched>
__device__ __forceinline__ void gemm_sg32s(LAS unsigned char* lds, const int tid, const Gemm g, const Sched& S, const Epi& E) {
    const int wid = __builtin_amdgcn_readfirstlane(tid >> 6), lane = tid & 63, wr = wid >> 2, wc = wid & 3, fr = lane & 15, fq = lane >> 4;
    const int ntfull = g.K / 32, lrow = tid >> 2, lch = tid & 3;
    const int br0 = Epi::PERM ? ((lrow & ~31) + perm32(lrow & 31)) : lrow;
    const int offA = (lrow * g.lda + lch * 8) * 2, offB = (br0 * g.ldb + lch * 8) * 2;
    const int dA = 128 * g.lda * 2, dB = 128 * g.ldb * 2;
    const unsigned wofs = (unsigned)(lrow * 64 + ((lch ^ ((0x78 >> (2 * ((lrow >> 2) & 3))) & 3)) * 16));
    const unsigned sw = (unsigned)((fq ^ ((0x78 >> (2 * ((fr >> 2) & 3))) & 3)) * 16);
    const unsigned frsw = (unsigned)(fr * 64) + sw; const int aofs = wr * 4096, bofs = 16384 + wc * 2048;
#define SGS_BAR() do { asm volatile("s_waitcnt lgkmcnt(0)" ::: "memory"); __builtin_amdgcn_s_barrier(); asm volatile("" ::: "memory"); } while (0)
#define SGS_LOAD(RA, RB, TT) do { const int _so = (TT) * 64; \
        RA[0] = __builtin_amdgcn_raw_buffer_load_b128(rsA, offA, _so, 0); RB[0] = __builtin_amdgcn_raw_buffer_load_b128(rsB, offB, _so, 0); \
        RA[1] = __builtin_amdgcn_raw_buffer_load_b128(rsA, offA, _so + dA, 0); RB[1] = __builtin_amdgcn_raw_buffer_load_b128(rsB, offB, _so + dB, 0); } while (0)
#define SGS_WRITE(RA, RB, BUFP) do { _Pragma("unroll") for (int i = 0; i < 2; ++i) { *(LAS u32x4*)((BUFP) + wofs + i * 8192) = RA[i]; *(LAS u32x4*)((BUFP) + 16384 + wofs + i * 8192) = RB[i]; } } while (0)
#define SGS_LDSPHASE(TT, RA, RB) do { \
            LAS unsigned char* cur = lds + ((TT) & 1) * 32768; \
            _Pragma("unroll") for (int bj = 0; bj < 2; ++bj) _Pragma("unroll") for (int n = 0; n < 2; ++n) Bf[bj][n] = *(const LAS bf16x8*)((cur + bofs) + frsw + (128 * bj + 16 * n) * 64); \
            _Pragma("unroll") for (int ai = 0; ai < 2; ++ai) _Pragma("unroll") for (int m = 0; m < 4; ++m) Af[ai][m] = *(const LAS bf16x8*)((cur + aofs) + frsw + (128 * ai + 16 * m) * 64); \
            if ((TT) + 1 < nt) { SGS_WRITE(RA, RB, lds + (((TT) + 1) & 1) * 32768); if ((TT) + 3 < nt) SGS_LOAD(RA, RB, (TT) + 3); } } while (0)
#define SGS_MMA() do { __builtin_amdgcn_sched_barrier(0); \
            _Pragma("unroll") for (int ai = 0; ai < 2; ++ai) _Pragma("unroll") for (int m = 0; m < 4; ++m) _Pragma("unroll") for (int bj = 0; bj < 2; ++bj) _Pragma("unroll") for (int n = 0; n < 2; ++n) \
                acc[ai][bj][m][n] = __builtin_amdgcn_mfma_f32_16x16x32_bf16(Bf[bj][n], Af[ai][m], acc[ai][bj][m][n], 0, 0, 0); \
            __builtin_amdgcn_sched_barrier(0); } while (0)
    Unit u;
    for (int ui = 0; S.next(ui, u); ++ui) {
        const int nt = S.ksteps(u, ntfull), kb = S.kbeg(u);
        const char* Ab = (const char*)g.A + ((size_t)u.ga * g.agstride + (size_t)u.pm * 256 * g.lda + (size_t)kb * 32) * 2;
        const char* Bb = (const char*)g.Bt + ((size_t)u.gb * g.bgstride + (size_t)u.pn * 256 * g.ldb + (size_t)kb * 32) * 2;
        f32x4 acc[2][2][4][2];
#pragma unroll
        for (int a = 0; a < 2; ++a)
#pragma unroll
            for (int b = 0; b < 2; ++b)
#pragma unroll
                for (int m = 0; m < 4; ++m)
#pragma unroll
                    for (int n = 0; n < 2; ++n) acc[a][b][m][n] = (f32x4){0.f, 0.f, 0.f, 0.f};
        u32x4 ra0[2], rb0[2], ra1[2], rb1[2];
        bf16x8 Bf[2][2], Af[2][4];
        int rs_nr = 0x7fffffff, rs_fl = 0x00020000; asm volatile("" : "+s"(rs_nr), "+s"(rs_fl));
        const __amdgpu_buffer_rsrc_t rsA = __builtin_amdgcn_make_buffer_rsrc((void*)Ab, 0, rs_nr, rs_fl);
        const __amdgpu_buffer_rsrc_t rsB = __builtin_amdgcn_make_buffer_rsrc((void*)Bb, 0, rs_nr, rs_fl);
        SGS_LOAD(ra0, rb0, 0);
        SGS_LOAD(ra1, rb1, 1);
        SGS_WRITE(ra0, rb0, lds);
        if (nt > 2) SGS_LOAD(ra0, rb0, 2);
        SGS_BAR();
        if (wr == 0) {
#pragma unroll 1
            for (int t = 0; t < nt; t += 2) {
                SGS_LDSPHASE(t, ra1, rb1); SGS_BAR(); SGS_MMA(); SGS_BAR();
                SGS_LDSPHASE(t + 1, ra0, rb0); SGS_BAR(); SGS_MMA(); SGS_BAR();
            }
        } else {
#pragma unroll 1
            for (int t = 0; t < nt; t += 2) {
                if (t > 0) SGS_MMA();
                SGS_BAR(); SGS_LDSPHASE(t, ra1, rb1); SGS_BAR();
                SGS_MMA();
                SGS_BAR(); SGS_LDSPHASE(t + 1, ra0, rb0); SGS_BAR();
            }
            SGS_MMA();
        }
        { const int l2 = lane_id(); E(acc, u, wr, wc, l2 & 15, l2 >> 4); }
    }
#undef SGS_BAR
#undef SGS_LOAD
#undef SGS_WRITE
#undef SGS_LDSPHASE
#undef SGS_MMA
}

template <class Epi, class Sched>
__device__ __forceinline__ void gemm_nolds(LAS unsigned char* lds, const int tid, const Gemm g, const Sched& S, const Epi& E) {
    const int wid = __builtin_amdgcn_readfirstlane(tid >> 6), lane = tid & 63, wr = wid >> 2, wc = wid & 3, fr = lane & 15, fq = lane >> 4;
    const int nt = g.K / 32;
    Unit u;
    for (int ui = 0; S.next(ui, u); ++ui) {
        const bf16_t* Ab = g.A + (size_t)u.ga * g.agstride + (size_t)u.pm * 256 * g.lda + fq * 8;
        const bf16_t* Bb = g.Bt + (size_t)u.gb * g.bgstride + (size_t)u.pn * 256 * g.ldb + fq * 8;
        f32x4 acc[2][2][4][2];
#pragma unroll
        for (int a = 0; a < 2; ++a)
#pragma unroll
            for (int b = 0; b < 2; ++b)
#pragma unroll
                for (int m = 0; m < 4; ++m)
#pragma unroll
                    for (int n = 0; n < 2; ++n) acc[a][b][m][n] = (f32x4){0.f, 0.f, 0.f, 0.f};
#pragma unroll 1
        for (int t = 0; t < nt; ++t) {
            bf16x8 Bf[2][2];
#pragma unroll
            for (int bj = 0; bj < 2; ++bj)
#pragma unroll
                for (int n = 0; n < 2; ++n) { const int slot = 128 * bj + 32 * wc + 16 * n + fr; const int br = Epi::PERM ? ((slot & ~31) + perm32(slot & 31)) : slot;
                    Bf[bj][n] = *(const bf16x8*)(Bb + (size_t)br * g.ldb + t * 32); }
#pragma unroll
            for (int ai = 0; ai < 2; ++ai) {
                bf16x8 Af[4];
#pragma unroll
                for (int m = 0; m < 4; ++m) Af[m] = *(const bf16x8*)(Ab + (size_t)(128 * ai + 64 * wr + 16 * m + fr) * g.lda + t * 32);
#pragma unroll
                for (int m = 0; m < 4; ++m)
#pragma unroll
                    for (int bj = 0; bj < 2; ++bj)
#pragma unroll
                        for (int n = 0; n < 2; ++n) acc[ai][bj][m][n] = __builtin_amdgcn_mfma_f32_16x16x32_bf16(Bf[bj][n], Af[m], acc[ai][bj][m][n], 0, 0, 0);
            }
        }
        { const int l2 = lane_id(); E(acc, u, wr, wc, l2 & 15, l2 >> 4); }
    }
}

typedef const f32x4 (&AccRef)[2][2][4][2];

enum { ACT_NONE = 0, ACT_TANH = 1, ACT_SIG = 2, ACT_GELU = 3 };
template <int ACT> __device__ __forceinline__ float actf(float x) {
    if (ACT == ACT_TANH) return ftanh(x);
    if (ACT == ACT_SIG) return fsig(x);
    if (ACT == ACT_GELU) return fgelu(x);
    return x;
}
template <int ACT> __device__ __forceinline__ u32x4 act_pack(f32x4 v0, f32x4 v1) {
    u32x4 w;
    w.x = pk2(actf<ACT>(v0[0]), actf<ACT>(v0[1])); w.y = pk2(actf<ACT>(v0[2]), actf<ACT>(v0[3]));
    w.z = pk2(actf<ACT>(v1[0]), actf<ACT>(v1[1])); w.w = pk2(actf<ACT>(v1[2]), actf<ACT>(v1[3]));
    return w;
}
constexpr int EPS_OFF = 65536;
struct EpiTr {
    LAS unsigned char* w; int rd, wr_;
    __device__ __forceinline__ EpiTr(int wave, int fr, int fq) {
        LAS unsigned char* base = (LAS unsigned char*)(size_t)0; asm volatile("" : "+v"(base));
        w = base + EPS_OFF + wave * 1024; const int L = fq * 16 + fr, r = L >> 2, c = L & 3;
        wr_ = fr * 64 + (((fq + (fr >> 2)) & 3) * 16); rd = r * 64 + (((c + (r >> 2)) & 3) * 16);
    }
    __device__ __forceinline__ u32x4 operator()(u32x4 v) const { *(LAS u32x4*)(w + wr_) = v; return *(const LAS u32x4*)(w + rd); }
};
struct EpiProj {
    static constexpr bool PERM = true;
    bf16_t* P;
    template <int A0, int A1> __device__ __forceinline__ void store(AccRef acc, const Unit& u, int wr, int wc, int fr, int fq) const {
        const EpiTr T(wr * 4 + wc, fr, fq); const int L = fq * 16 + fr;
        const int row0 = u.pm * BM + wr * 64 + (L >> 2), col0 = u.pn * BM + wc * 32 + 8 * (L & 3);
#pragma unroll
        for (int ai = 0; ai < 2; ++ai)
#pragma unroll
            for (int m = 0; m < 4; ++m) { bf16_t* rowp = P + (size_t)(row0 + ai * HALF + m * 16) * PLD + col0;
                __builtin_nontemporal_store(T(act_pack<A0>(acc[ai][0][m][0], acc[ai][0][m][1])), (u32x4*)(rowp));
                __builtin_nontemporal_store(T(act_pack<A1>(acc[ai][1][m][0], acc[ai][1][m][1])), (u32x4*)(rowp + HALF)); }
    }
    __device__ __forceinline__ void operator()(AccRef acc, const Unit& u, int wr, int wc, int fr, int fq) const {
        const int pn = u.pn;
        if (pn == 7) store<ACT_TANH, ACT_NONE>(acc, u, wr, wc, fr, fq);
        else if (pn == 8) store<ACT_SIG, ACT_NONE>(acc, u, wr, wc, fr, fq);
        else if (pn >= 11 && pn < 15) store<ACT_GELU, ACT_GELU>(acc, u, wr, wc, fr, fq);
        else if (pn >= 15) store<ACT_SIG, ACT_SIG>(acc, u, wr, wc, fr, fq);
        else store<ACT_NONE, ACT_NONE>(acc, u, wr, wc, fr, fq);
    }
};
struct EpiLora {
    static constexpr bool PERM = true;
    bf16_t* WDEC; bf16_t* AICLR; bf16_t* GG; const float* w0; const float* a0;
    __device__ __forceinline__ void operator()(AccRef acc, const Unit& u, int wr, int wc, int fr, int fq) const {
        const EpiTr T(wr * 4 + wc, fr, fq); const int L = fq * 16 + fr;
        const int rowT = u.pm * BM + wr * 64 + (L >> 2), pn = u.pn;
#pragma unroll
        for (int bj = 0; bj < 2; ++bj) {
            const int n0 = pn * BM + bj * HALF + wc * 32 + 8 * fq;
            const int nT = pn * BM + bj * HALF + wc * 32 + 8 * (L & 3);
            if (pn < 4) {
                const f32x4 b0 = *(const f32x4*)(w0 + n0), b1 = *(const f32x4*)(w0 + n0 + 4);
#pragma unroll
                for (int ai = 0; ai < 2; ++ai)
#pragma unroll
                    for (int m = 0; m < 4; ++m) { bf16_t* rp = WDEC + (size_t)(rowT + ai * HALF + m * 16) * 1024 + nT;
                        f32x4 x0 = acc[ai][bj][m][0] + b0, x1 = acc[ai][bj][m][1] + b1, o0, o1;
#pragma unroll
                        for (int j = 0; j < 4; ++j) { o0[j] = -0.8750375f * fsig(x0[j]); o1[j] = -0.8750375f * fsig(x1[j]); }
                        *(u32x4*)rp = T(act_pack<ACT_NONE>(o0, o1)); }
            } else if (pn < 8) {
                const int n1 = n0 - 1024;
                const f32x4 b0 = *(const f32x4*)(a0 + n1), b1 = *(const f32x4*)(a0 + n1 + 4);
#pragma unroll
                for (int ai = 0; ai < 2; ++ai)
#pragma unroll
                    for (int m = 0; m < 4; ++m) { bf16_t* rp = AICLR + (size_t)(rowT + ai * HALF + m * 16) * 1024 + (nT - 1024);
                        *(u32x4*)rp = T(act_pack<ACT_SIG>(acc[ai][bj][m][0] + b0, acc[ai][bj][m][1] + b1)); }
            } else {
#pragma unroll
                for (int ai = 0; ai < 2; ++ai)
#pragma unroll
                    for (int m = 0; m < 4; ++m) { bf16_t* rp = GG + (size_t)(rowT + ai * HALF + m * 16) * 512 + (nT - 2048);
                        *(u32x4*)rp = T(act_pack<ACT_NONE>(acc[ai][bj][m][0], acc[ai][bj][m][1])); }
            }
        }
    }
};
struct EpiMerge {
    static constexpr bool PERM = true;
    const bf16_t* P; bf16_t* TMP; bf16_t* YM;
    __device__ __forceinline__ void operator()(AccRef acc, const Unit& u, int wr, int wc, int fr, int fq) const {
        const EpiTr T(wr * 4 + wc, fr, fq); const int L = fq * 16 + fr;
        const int row0 = u.pm * BM + wr * 64 + fr, rowT = u.pm * BM + wr * 64 + (L >> 2), br = u.gb;
#pragma unroll
        for (int ai = 0; ai < 2; ++ai)
#pragma unroll
            for (int m = 0; m < 4; ++m) {
                const int row = row0 + ai * HALF + m * 16, rT = rowT + ai * HALF + m * 16;
#pragma unroll
                for (int bj = 0; bj < 2; ++bj) {
                    const int c0 = u.pn * BM + bj * HALF + wc * 32 + 8 * fq, cT = u.pn * BM + bj * HALF + wc * 32 + 8 * (L & 3);
                    const u32x4 gw = *(const u32x4*)(P + (size_t)row * PLD + PGATE + br * 1024 + c0);
                    f32x4 v0 = acc[ai][bj][m][0], v1 = acc[ai][bj][m][1];
                    v0[0] *= bflo(gw.x); v0[1] *= bfhi(gw.x); v0[2] *= bflo(gw.y); v0[3] *= bfhi(gw.y);
                    v1[0] *= bflo(gw.z); v1[1] *= bfhi(gw.z); v1[2] *= bflo(gw.w); v1[3] *= bfhi(gw.w);
                    u32x4 pk = T(act_pack<ACT_NONE>(v0, v1));
                    bf16_t* tp = TMP + (size_t)rT * 1024 + cT;
                    if (br != 0) {
                        const u32x4 t = *(const u32x4*)tp;
                        pk.x = pk2(bflo(pk.x) + bflo(t.x), bfhi(pk.x) + bfhi(t.x)); pk.y = pk2(bflo(pk.y) + bflo(t.y), bfhi(pk.y) + bfhi(t.y));
                        pk.z = pk2(bflo(pk.z) + bflo(t.z), bfhi(pk.z) + bfhi(t.z)); pk.w = pk2(bflo(pk.w) + bflo(t.w), bfhi(pk.w) + bfhi(t.w));
                    }
                    if (br == 2) *(u32x4*)(YM + (size_t)rT * 1024 + cT) = pk; else *(u32x4*)tp = pk;
                }
            }
    }
};
struct EpiF32 {
    static constexpr bool PERM = false;
    float* C; int ldc;
    __device__ __forceinline__ void operator()(AccRef acc, const Unit& u, int wr, int wc, int fr, int fq) const {
        const int row0 = u.pm * BM + wr * 64 + fr, col0 = u.pn * BM + wc * 32 + 4 * fq;
#pragma unroll
        for (int ai = 0; ai < 2; ++ai)
#pragma unroll
            for (int m = 0; m < 4; ++m) { float* rowp = C + (size_t)(row0 + ai * HALF + m * 16) * ldc + col0;
#pragma unroll
                for (int bj = 0; bj < 2; ++bj)
#pragma unroll
                    for (int n = 0; n < 2; ++n) *(f32x4*)(rowp + bj * HALF + n * 16) = acc[ai][bj][m][n]; }
    }
};
struct EpiBf16Out {
    static constexpr bool PERM = true;
    bf16_t* C; int ldc;
    __device__ __forceinline__ void operator()(AccRef acc, const Unit& u, int wr, int wc, int fr, int fq) const {
        const EpiTr T(wr * 4 + wc, fr, fq); const int L = fq * 16 + fr;
        const int row0 = u.pm * BM + wr * 64 + (L >> 2), col0 = u.pn * BM + wc * 32 + 8 * (L & 3);
#pragma unroll
        for (int ai = 0; ai < 2; ++ai)
#pragma unroll
            for (int m = 0; m < 4; ++m) { bf16_t* rowp = C + (size_t)(row0 + ai * HALF + m * 16) * ldc + col0;
                *(u32x4*)(rowp) = T(act_pack<ACT_NONE>(acc[ai][0][m][0], acc[ai][0][m][1]));
                *(u32x4*)(rowp + HALF) = T(act_pack<ACT_NONE>(acc[ai][1][m][0], acc[ai][1][m][1])); }
    }
};
struct EpiSwiglu {
    static constexpr bool PERM = true;
    bf16_t* Hd; int ldh;
    __device__ __forceinline__ void operator()(AccRef acc, const Unit& u, int wr, int wc, int fr, int fq) const {
        const EpiTr T(wr * 4 + wc, fr, fq); const int L = fq * 16 + fr;
        const int row0 = u.pm * BM + wr * 64 + (L >> 2), hc = u.pn * HALF + wc * 32 + 8 * (L & 3);
#pragma unroll
        for (int ai = 0; ai < 2; ++ai)
#pragma unroll
            for (int m = 0; m < 4; ++m) {
                f32x4 o0, o1;
#pragma unroll
                for (int j = 0; j < 4; ++j) { const float g0 = acc[ai][0][m][0][j], g1 = acc[ai][0][m][1][j];
                    o0[j] = g0 * fsig(g0) * acc[ai][1][m][0][j]; o1[j] = g1 * fsig(g1) * acc[ai][1][m][1][j]; }
                __builtin_nontemporal_store(T(act_pack<ACT_NONE>(o0, o1)), (u32x4*)(Hd + (size_t)(row0 + ai * HALF + m * 16) * ldh + hc));
            }
    }
};
}

#if defined(USE_SG32S)
#define GEMM_CALL pg8::gemm_sg32s
#elif defined(USE_SG32D)
#define GEMM_CALL pg8::gemm_sg32d
#elif defined(USE_SG32)
#define GEMM_CALL pg8::gemm_sg32
#elif defined(USE_NOLDS)
#define GEMM_CALL pg8::gemm_nolds
#elif defined(USE_SG)
#define GEMM_CALL pg8::gemm_simple
#else
#define GEMM_CALL pg8::gemm_phase
#endif
struct Frame {
    LAS unsigned char* lds;
    int tid, lane, wave, G, bx;
    GAS unsigned char* ws;
};
#define WSP(T, off) ((T*)(GAS T*)(F.ws + (off)))

__device__ __forceinline__ void transpose_item(const float* W, int K, int N, bf16_t* WT, size_t dest_row0, int k0, int n0, LAS float* scr, int lane) {
#pragma unroll 8
    for (int i = 0; i < 32; ++i) { const int kk = 2 * i + (lane >> 5); scr[kk * 33 + (lane & 31)] = W[(size_t)(k0 + kk) * N + n0 + (lane & 31)]; }
    asm volatile("s_waitcnt lgkmcnt(0)" ::: "memory");
    const int c = lane & 7;
#pragma unroll
    for (int j = 0; j < 4; ++j) { const int n = (lane >> 3) + 8 * j; const LAS float* s = scr + (8 * c) * 33 + n;
        u32x4 o; o.x = pk2(s[0 * 33], s[1 * 33]); o.y = pk2(s[2 * 33], s[3 * 33]); o.z = pk2(s[4 * 33], s[5 * 33]); o.w = pk2(s[6 * 33], s[7 * 33]);
        *(u32x4*)(WT + (dest_row0 + n) * (size_t)K + k0 + 8 * c) = o; }
    asm volatile("s_waitcnt lgkmcnt(0)" ::: "memory");
}
__device__ __forceinline__ int map_win(int n0) {
    if (n0 < 2048) return n0;
    if (n0 < 2560) return n0 - 2048 + PQ;
    if (n0 < 2688) return n0 - 2560 + PGLOW;
    if (n0 < 3712) return n0 - 2688 + PUV;
    return n0 - 3712 + PGATE;
}
__device__ __forceinline__ int map_gu(int n0, int Fh) {
    if (n0 < Fh) return 256 * (n0 >> 7) + (n0 & 127);
    const int c = n0 - Fh; return 256 * (c >> 7) + 128 + (c & 127);
}

namespace p0i {
constexpr int I0 = 16 * 212, I1 = 8 * 32, I2 = 16 * 32, I3 = 16 * 176, I4 = 44 * 32, I5 = 16 * 224, I6 = 56 * 32;
constexpr int C0 = 4 * I0, C1 = C0 + 12 * I1, C2 = C1 + 4 * I2, C3 = C2 + 2 * I3, C4 = C3 + 2 * I4, C5 = C4 + 16 * I5, C6 = C5 + 16 * I6;
constexpr int NSEG = 11;
__device__ __forceinline__ int def_item(int x) {
    const int beg[NSEG] = {C5, C4, 2 * I0, C0 + 6 * I1, C1 + 2 * I2, C2 + I3, C3 + I4, 3 * I0, C0 + 9 * I1, C1 + 3 * I2, C4 + 8 * I5};
    const int len[NSEG] = {8 * I6, 8 * I5, I0, 3 * I1, I2, I3, I4, I0, 3 * I1, I2, 8 * I5};
#pragma unroll
    for (int i = 0; i < NSEG; ++i) { if (x < len[i]) return beg[i] + x; x -= len[i]; }
    return C5 + 8 * I6 + x;
}
constexpr int DEF_TOTAL = 8 * I6 + 8 * I5 + (I0 + 3 * I1 + I2) + (I3 + I4) + (I0 + 3 * I1 + I2) + 8 * I5 + 8 * I6, SLOTN = DEF_TOTAL / 4;
static_assert(DEF_TOTAL % 4 == 0 && 2 * SLOTN >= 8 * I6 + 8 * I5 + I0 + 3 * I1 + I2 && 3 * SLOTN >= DEF_TOTAL - 8 * I5 - 8 * I6, "slot deadlines");
__device__ __forceinline__ bool deferred(int it) {
    if (it >= C4) return true;
    if (it < C0) return it >= 2 * I0;
    if (it < C1) return it >= C0 + 6 * I1;
    if (it < C2) return it >= C1 + 2 * I2;
    if (it < C3) return it >= C2 + I3;
    return it >= C3 + I4;
}
}
__device__ __forceinline__ void p0_item(Frame& F, const Params& p, int it, LAS float* scr) {
    using namespace p0i;
        if (it < C0) { const int mat = it / I0, r = it % I0, kb = r / 212, nb = r % 212;
            transpose_item(inp(p, 7) + (size_t)mat * 1024 * INW, 1024, INW, WSP(bf16_t, WS_WIN) + (size_t)mat * PLD * 1024, (size_t)map_win(nb * 32), kb * 64, nb * 32, scr, F.lane); }
        else if (it < C1) { const int q = it - C0, mat = q / I1, r = q % I1, kb = r / 32, nb = r % 32;
            transpose_item(inp(p, 23) + (size_t)mat * 512 * 1024, 512, 1024, WSP(bf16_t, WS_WBR) + (size_t)mat * 1024 * 512, (size_t)(nb * 32), kb * 64, nb * 32, scr, F.lane); }
        else if (it < C2) { const int q = it - C1, mat = q / I2, r = q % I2, kb = r / 32, nb = r % 32;
            transpose_item(inp(p, 24) + (size_t)mat * 1024 * 1024, 1024, 1024, WSP(bf16_t, WS_WOUT) + (size_t)mat * 1024 * 1024, (size_t)(nb * 32), kb * 64, nb * 32, scr, F.lane); }
        else if (it < C3) { const int q = it - C2, mat = q / I3, r = q % I3, kb = r / 176, nb = r % 176;
            transpose_item(inp(p, 25) + (size_t)mat * 1024 * 2 * FD, 1024, 2 * FD, WSP(bf16_t, WS_WGU) + (size_t)mat * 2 * FD * 1024, (size_t)map_gu(nb * 32, FD), kb * 64, nb * 32, scr, F.lane); }
        else if (it < C4) { const int q = it - C3, mat = q / I4, r = q % I4, kb = r / 32, nb = r % 32;
            transpose_item(inp(p, 26) + (size_t)mat * FD * 1024, FD, 1024, WSP(bf16_t, WS_WDN) + (size_t)mat * 1024 * FD, (size_t)(nb * 32), kb * 64, nb * 32, scr, F.lane); }
        else if (it < C5) { const int q = it - C4, mat = q / I5, r = q % I5, kb = r / 224, nb = r % 224;
            transpose_item(inp(p, 28) + (size_t)mat * 1024 * 2 * FE, 1024, 2 * FE, WSP(bf16_t, WS_MGU) + (size_t)mat * 2 * FE * 1024, (size_t)map_gu(nb * 32, FE), kb * 64, nb * 32, scr, F.lane); }
        else { const int q = it - C5, mat = q / I6, r = q % I6, kb = r / 32, nb = r % 32;
            transpose_item(inp(p, 29) + (size_t)mat * FE * 1024, FE, 1024, WSP(bf16_t, WS_MDN) + (size_t)mat * 1024 * FE, (size_t)(nb * 32), kb * 64, nb * 32, scr, F.lane); }
}
__device__ __forceinline__ void p0_slot(Frame& F, const Params& p, int l, int worker, int nw) {
    using namespace p0i;
    LAS float* scr = (LAS float*)(F.lds + F.wave * 16384);
    for (int x = worker; x < SLOTN; x += nw) p0_item(F, p, def_item(l * SLOTN + x), scr);
}
__device__ __forceinline__ void p0_prologue(Frame& F, const Params& p, bool split) {
    using namespace p0i;
    LAS float* scr = (LAS float*)(F.lds + F.wave * 16384);
    const int gw = F.bx * 8 + F.wave, NGW = F.G * 8;
    for (int it = gw; it < C6; it += NGW) {
        if (split && deferred(it)) continue;
        p0_item(F, p, it, scr);
    }
    const size_t gt = (size_t)F.bx * 512 + F.tid, NT = (size_t)F.G * 512;
    for (size_t i = gt; i < (size_t)4 * 2560 * 384; i += NT) {
        const int l = (int)(i / (2560 * 384)), r = (int)(i % (2560 * 384)), n = r / 384, k = r % 384, seg = n >> 9, c = n & 511;
        float v = 0.f;
        if (seg < 2) { const int kk = k - 64 * seg; if (kk >= 0 && kk < 64) v = inp(p, 11)[(((size_t)l * 2 + seg) * 64 + kk) * 512 + c]; }
        else if (seg < 4) { const int d = seg - 2, kk = k - 128 - 64 * d; if (kk >= 0 && kk < 64) v = inp(p, 13)[(((size_t)l * 2 + d) * 64 + kk) * 512 + c]; }
        else { const int kk = k - 256; if (kk >= 0) v = inp(p, 16)[((size_t)l * 128 + kk) * 512 + c]; }
        WSP(bf16_t, WS_WLORA)[i] = (bf16_t)pk2(v, 0.f);
    }
    for (size_t i = gt; i < (size_t)4 * 4 * 128 * 128; i += NT) WSP(bf16_t, WS_WCM)[i] = (bf16_t)pk2(inp(p, 21)[i], 0.f);
    for (size_t i = gt; i < (size_t)4 * 128 * 1024; i += NT) { const int l = (int)(i / (128 * 1024)), r = (int)(i % (128 * 1024));
        WSP(bf16_t, WS_WIN)[(size_t)l * PLD * 1024 + (size_t)(2176 + r / 1024) * 1024 + (r % 1024)] = 0; }
    if (gt < 1024) { const int pos = (int)gt >> 4, i = (int)gt & 15; const float fr = fexp2(-0.83048202372f * (float)i), rev = (float)pos * fr * 0.15915494309f;
        const float fx = rev - floorf(rev);
        WSP(float, WS_ROPE)[2 * gt] = __builtin_amdgcn_cosf(fx); WSP(float, WS_ROPE)[2 * gt + 1] = __builtin_amdgcn_sinf(fx); }
#ifdef NANFILL
    { u32x4* q = WSP(u32x4, WS_XC); const size_t n16 = (WS_END - WS_XC) / 16;
      for (size_t i = gt; i < n16; i += NT) q[i] = (u32x4){0x7fc07fc0u, 0x7fc07fc0u, 0x7fc07fc0u, 0x7fc07fc0u}; }
#endif
    __syncthreads();
    LAS float* sil = (LAS float*)F.lds;
    LAS float* red = (LAS float*)(F.lds + 36864);
    if (F.bx < 192) {
        for (int i = F.tid; i < 9 * 1024; i += 512) { const int v = i >> 10, k = i & 1023; const float cv = v < 8 ? inp(p, 1)[v * 1024 + k] : inp(p, 3)[k]; sil[i] = cv / (1.f + __expf(-cv)); }
        __syncthreads();
        for (int it = F.bx; it < 192; it += F.G) {
            const int l = it / 48, cc = it % 48, s = F.tid >> 7, col = F.tid & 127;
            const float* W = inp(p, 4) + (size_t)l * 1024 * 6144 + (size_t)cc * 128 + col;
            float a[9];
#pragma unroll
            for (int v = 0; v < 9; ++v) a[v] = 0.f;
#pragma unroll 4
            for (int k = s * 256; k < s * 256 + 256; ++k) { const float w = W[(size_t)k * 6144];
#pragma unroll
                for (int v = 0; v < 9; ++v) a[v] += sil[v * 1024 + k] * w; }
#pragma unroll
            for (int v = 0; v < 9; ++v) red[(s * 9 + v) * 128 + col] = a[v];
            __syncthreads();
            for (int i = F.tid; i < 9 * 128; i += 512) { const int v = i >> 7, c2 = i & 127;
                const float sum = red[(0 * 9 + v) * 128 + c2] + red[(1 * 9 + v) * 128 + c2] + red[(2 * 9 + v) * 128 + c2] + red[(3 * 9 + v) * 128 + c2];
                WSP(float, WS_MODV)[((size_t)l * 9 + v) * 6144 + cc * 128 + c2] = sum + inp(p, 5)[(size_t)l * 6144 + cc * 128 + c2]; }
            __syncthreads();
        }
    }
}

__device__ __forceinline__ bf16_t* xres_row(Frame& F, int r) { return WSP(bf16_t, WS_XB) + (size_t)r * D; }
__device__ __forceinline__ int row_mv(int r) { return r < NLAT ? (r >> 12) : 8; }
__device__ __forceinline__ void emit_h(Frame& F, const Params& p, const f32x4 (&xv)[4], int r, int l, int ngi, int sci, int shi, f32x4 (&hv)[4]) {
    float ss = 0.f;
#pragma unroll
    for (int j = 0; j < 4; ++j) ss += xv[j].x * xv[j].x + xv[j].y * xv[j].y + xv[j].z * xv[j].z + xv[j].w * xv[j].w;
    const float rstd = frsq(wave_sum(ss) * (1.f / D) + EPS);
    const float* ng = inp(p, 6) + ((size_t)l * 4 + ngi) * D;
    const float* mv = WSP(float, WS_MODV) + ((size_t)l * 9 + row_mv(r)) * 6144;
    bf16_t* hrow = WSP(bf16_t, WS_H) + (size_t)r * D;
#pragma unroll
    for (int j = 0; j < 4; ++j) { const int c = 4 * F.lane + 256 * j;
        const f32x4 g = *(const f32x4*)(ng + c), sc = *(const f32x4*)(mv + sci * 1024 + c), sh = *(const f32x4*)(mv + shi * 1024 + c);
        hv[j] = xv[j] * rstd * g * (sc + 1.f) + sh;
        u32x2 o; o.x = pk2(hv[j].x, hv[j].y); o.y = pk2(hv[j].z, hv[j].w);
        *(u32x2*)(hrow + c) = o; }
}
__device__ __forceinline__ void residual_update(Frame& F, const Params& p, const f32x4 (&fv)[4], const u32x2 (&xraw)[4], int r, int l, int ngi, int gai, f32x4 (&xv)[4], bool fin = false) {
    float ss = 0.f;
#pragma unroll
    for (int j = 0; j < 4; ++j) ss += fv[j].x * fv[j].x + fv[j].y * fv[j].y + fv[j].z * fv[j].z + fv[j].w * fv[j].w;
    const float rstd = frsq(wave_sum(ss) * (1.f / D) + EPS);
    const float* ng = inp(p, 6) + ((size_t)l * 4 + ngi) * D;
    const float* mv = WSP(float, WS_MODV) + ((size_t)l * 9 + row_mv(r)) * 6144;
    bf16_t* xr = xres_row(F, r);
#pragma unroll
    for (int j = 0; j < 4; ++j) { const int c = 4 * F.lane + 256 * j;
        const f32x4 g = *(const f32x4*)(ng + c), ga = *(const f32x4*)(mv + gai * 1024 + c), x0 = unp4(xraw[j]);
        xv[j] = x0 + ga * (fv[j] * rstd * g);
        if (fin) *(f32x4*)(outp(p) + (size_t)r * D + c) = xv[j];
        else { u32x2 o; o.x = pk2(xv[j].x, xv[j].y); o.y = pk2(xv[j].z, xv[j].w); *(u32x2*)(xr + c) = o; } }
}

__device__ __forceinline__ void load_gg(Frame& F, const Params& p, int l, int ngi, int gai, int mvidx, f32x4 (&gg)[4]) {
    const float* ng = inp(p, 6) + ((size_t)l * 4 + ngi) * D;
    const float* mv = WSP(float, WS_MODV) + ((size_t)l * 9 + mvidx) * 6144;
#pragma unroll
    for (int j = 0; j < 4; ++j) { const int c = 4 * F.lane + 256 * j; gg[j] = *(const f32x4*)(ng + c) * *(const f32x4*)(mv + gai * 1024 + c); }
}
__device__ __forceinline__ void load_gs(Frame& F, const Params& p, int l, int ngi, int sci, int shi, int mvidx, f32x4 (&gs)[4], f32x4 (&sh)[4]) {
    const float* ng = inp(p, 6) + ((size_t)l * 4 + ngi) * D;
    const float* mv = WSP(float, WS_MODV) + ((size_t)l * 9 + mvidx) * 6144;
#pragma unroll
    for (int j = 0; j < 4; ++j) { const int c = 4 * F.lane + 256 * j; gs[j] = *(const f32x4*)(ng + c) * (*(const f32x4*)(mv + sci * 1024 + c) + 1.f); sh[j] = *(const f32x4*)(mv + shi * 1024 + c); }
}
__device__ __forceinline__ void emit_h_v(Frame& F, const f32x4 (&xv)[4], int r, const f32x4 (&gs)[4], const f32x4 (&sh)[4], f32x4 (&hv)[4]) {
    float ss = 0.f;
#pragma unroll
    for (int j = 0; j < 4; ++j) ss += xv[j].x * xv[j].x + xv[j].y * xv[j].y + xv[j].z * xv[j].z + xv[j].w * xv[j].w;
    const float rstd = frsq(wave_sum(ss) * (1.f / D) + EPS);
    bf16_t* hrow = WSP(bf16_t, WS_H) + (size_t)r * D;
#pragma unroll
    for (int j = 0; j < 4; ++j) { const int c = 4 * F.lane + 256 * j;
        hv[j] = (xv[j] * rstd) * gs[j] + sh[j];
        u32x2 o; o.x = pk2(hv[j].x, hv[j].y); o.y = pk2(hv[j].z, hv[j].w);
        *(u32x2*)(hrow + c) = o; }
}
__device__ __forceinline__ void residual_update_v(Frame& F, const Params& p, const f32x4 (&fv)[4], const u32x2 (&xraw)[4], int r, const f32x4 (&gg)[4], f32x4 (&xv)[4], bool fin) {
    float ss = 0.f;
#pragma unroll
    for (int j = 0; j < 4; ++j) ss += fv[j].x * fv[j].x + fv[j].y * fv[j].y + fv[j].z * fv[j].z + fv[j].w * fv[j].w;
    const float rstd = frsq(wave_sum(ss) * (1.f / D) + EPS);
    bf16_t* xr = xres_row(F, r);
#pragma unroll
    for (int j = 0; j < 4; ++j) { const int c = 4 * F.lane + 256 * j;
        xv[j] = unp4(xraw[j]) + gg[j] * (fv[j] * rstd);
        if (fin) *(f32x4*)(outp(p) + (size_t)r * D + c) = xv[j];
        else { u32x2 o; o.x = pk2(xv[j].x, xv[j].y); o.y = pk2(xv[j].z, xv[j].w); *(u32x2*)(xr + c) = o; } }
}

__device__ __forceinline__ void p1_input(Frame& F, const Params& p) {
    const int gw = F.bx * 8 + F.wave, NGW = F.G * 8;
#pragma unroll 1
    for (int seg = 0; seg < 2; ++seg) {
        const int rbeg = seg == 0 ? (gw & 7) * 4096 + (gw >> 3) : NLAT + gw, rstep = seg == 0 ? (NGW >> 3) : NGW, rend = seg == 0 ? (gw & 7) * 4096 + 4096 : MT;
        if (rbeg >= rend) continue;
        f32x4 gs[4], sh[4];
        load_gs(F, p, 0, 0, 1, 0, seg == 0 ? (gw & 7) : 8, gs, sh);
#pragma unroll 2
        for (int r = rbeg; r < rend; r += rstep) {
            const float* src = r < NLAT ? inp(p, 0) + (size_t)r * D : inp(p, 2) + (size_t)(r - NLAT) * D;
            bf16_t* xr = xres_row(F, r);
            f32x4 xv[4], hv[4];
#pragma unroll
            for (int j = 0; j < 4; ++j) { xv[j] = *(const f32x4*)(src + 4 * F.lane + 256 * j); u32x2 o; o.x = pk2(xv[j].x, xv[j].y); o.y = pk2(xv[j].z, xv[j].w); *(u32x2*)(xr + 4 * F.lane + 256 * j) = o; }
            emit_h_v(F, xv, r, gs, sh, hv);
        }
    }
}

__device__ __forceinline__ void p3_qk(Frame& F, const Params& p, int l) {
    const int gw = F.bx * 8 + F.wave, NGW = F.G * 8, lane = F.lane, sub = lane & 7;
    const bf16_t* PROJ = WSP(bf16_t, WS_PROJ);
    const float* rope = WSP(float, WS_ROPE);
    const float* qg = inp(p, 8) + (size_t)l * 128;
    float qg_[2][8];
#pragma unroll
    for (int w = 0; w < 2; ++w)
#pragma unroll
        for (int j = 0; j < 8; ++j) qg_[w][j] = qg[w * 64 + 8 * sub + j];
#pragma unroll 2
    for (int r = gw; r < MT; r += NGW) {
        const bool islat = r < NLAT;
        const int b = islat ? (r >> 12) : ((r - NLAT) >> 8), t = islat ? (r & 4095) : ((r - NLAT) & 255), pos = islat ? 256 + t : t;
        const int ppos = (sub < 4) ? (t >> 6) : (t & 63);
        const float sgn = (sub & 2) ? 1.f : -1.f;
        f32x4 rp[4];
#pragma unroll
        for (int i = 0; i < 4; ++i) rp[i] = *(const f32x4*)(rope + (size_t)(ppos * 16 + 8 * (sub & 1)) * 2 + 4 * i);
#pragma unroll
        for (int which = 0; which < 2; ++which) {
            const int l2 = which ? (lane & 15) : lane;
            const u32x4 raw = *(const u32x4*)(PROJ + (size_t)r * PLD + (which ? PK : PQ) + l2 * 8);
            float x[8] = {bflo(raw.x), bfhi(raw.x), bflo(raw.y), bfhi(raw.y), bflo(raw.z), bfhi(raw.z), bflo(raw.w), bfhi(raw.w)};
            float ss = 0.f;
#pragma unroll
            for (int j = 0; j < 8; ++j) ss += x[j] * x[j];
            ss = sum8(ss);
            const float rstd = frsq(ss * (1.f / 64.f) + EPS);
            float y[8];
#pragma unroll
            for (int j = 0; j < 8; ++j) y[j] = x[j] * rstd * qg_[which][j];
#pragma unroll
            for (int j = 0; j < 8; ++j) { const float pr = dppf<0x4E>(y[j]);
                if (islat) { const float cs = rp[j >> 1][(j & 1) * 2], sn = rp[j >> 1][(j & 1) * 2 + 1]; x[j] = y[j] * cs + sgn * pr * sn; }
                else x[j] = y[j]; }
            const float sc = which ? 1.f : 0.18033688011f;
            u32x4 o; o.x = pk2(x[0] * sc, x[1] * sc); o.y = pk2(x[2] * sc, x[3] * sc); o.z = pk2(x[4] * sc, x[5] * sc); o.w = pk2(x[6] * sc, x[7] * sc);
            if (which == 0) *(u32x4*)(WSP(bf16_t, WS_QN) + ((size_t)(b * 8 + (lane >> 3)) * NKEY + pos) * 64 + 8 * sub) = o;
            else if (lane < 16) *(u32x4*)(WSP(bf16_t, WS_KN) + ((size_t)(b * 2 + (lane >> 3)) * NKEY + pos) * 64 + 8 * sub) = o;
        }
    }
}
__device__ __forceinline__ void p3_vt(Frame& F) {
    const bf16_t* PROJ = WSP(bf16_t, WS_PROJ);
    bf16_t* VT = WSP(bf16_t, WS_VT);
    LAS unsigned char* tile = F.lds;
    for (int it = F.bx; it < NB * 68; it += F.G) {
        const int b = it / 68, tb = it % 68, pos0 = tb * 64;
        const int row0 = tb < 4 ? NLAT + b * 256 + pos0 : b * 4096 + pos0 - 256;
        { const int tok = F.tid >> 3, ch = F.tid & 7; const bf16_t* src = PROJ + (size_t)(row0 + tok) * PLD + PV + 16 * ch;
          const u32x4 a = *(const u32x4*)src, c = *(const u32x4*)(src + 8);
          *(LAS u32x4*)(tile + tok * 272 + ch * 32) = a; *(LAS u32x4*)(tile + tok * 272 + ch * 32 + 16) = c; }
        __syncthreads();
        { const int dc = F.tid >> 2, tq = F.tid & 3; unsigned w[8];
#pragma unroll
          for (int i = 0; i < 8; ++i) { const unsigned lo = *(const LAS unsigned short*)(tile + (16 * tq + 2 * i) * 272 + dc * 2), hi = *(const LAS unsigned short*)(tile + (16 * tq + 2 * i + 1) * 272 + dc * 2); w[i] = lo | (hi << 16); }
          bf16_t* dst = VT + ((size_t)(b * 2 + (dc >> 6)) * 64 + (dc & 63)) * NKEY + pos0 + 16 * tq;
          *(u32x4*)dst = (u32x4){w[0], w[1], w[2], w[3]}; *(u32x4*)(dst + 8) = (u32x4){w[4], w[5], w[6], w[7]}; }
        __syncthreads();
    }
}

__device__ __forceinline__ void attn_unit(Frame& F, int b, int h, int qpos0, int nkeys, int orow0) {
    const int tid = F.tid, wave = F.wave, lane = F.lane, c = lane & 31, h2 = lane >> 5, kvh = h >> 2;
    const bf16_t* Kb = WSP(bf16_t, WS_KN) + (size_t)(b * 2 + kvh) * NKEY * 64;
    const bf16_t* Vb = WSP(bf16_t, WS_VT) + (size_t)(b * 2 + kvh) * 64 * NKEY;
    const bf16_t* Qb = WSP(bf16_t, WS_QN) + ((size_t)(b * 8 + h) * NKEY + qpos0 + wave * 32 + c) * 64;
    bf16x8 qf[4];
#pragma unroll
    for (int s = 0; s < 4; ++s) qf[s] = *(const bf16x8*)(Qb + 16 * s + 8 * h2);
    f32x16 O0, O1;
#pragma unroll
    for (int i = 0; i < 16; ++i) { O0[i] = 0.f; O1[i] = 0.f; }
    float mrun = 0.f, lsum = 0.f;
    f32x16 NM;
#pragma unroll
    for (int i = 0; i < 16; ++i) NM[i] = 0.f;
    const int skey = tid >> 3, sch = tid & 7, ntile = nkeys >> 6;
    LAS unsigned char* lds = F.lds;
    u32x4 kr = *(const u32x4*)(Kb + (size_t)skey * 64 + sch * 8);
    u32x4 vr = *(const u32x4*)(Vb + (size_t)skey * NKEY + sch * 8);
    u32x4 kr2 = kr, vr2 = vr;
    if (ntile > 1) { kr2 = *(const u32x4*)(Kb + (size_t)(64 + skey) * 64 + sch * 8); vr2 = *(const u32x4*)(Vb + (size_t)skey * NKEY + 64 + sch * 8); }
    *(LAS u32x4*)(lds + skey * 144 + sch * 16) = kr;
    const int vwo = skey * 144 + (sch >> 1) * 32 + (sch & 1) * 8;
    *(LAS u32x2*)(lds + 18432 + vwo) = (u32x2){vr.x, vr.y}; *(LAS u32x2*)(lds + 18432 + vwo + 16) = (u32x2){vr.z, vr.w};
    kr = kr2; vr = vr2;
    __syncthreads();
    auto tile_step = [&](const int t, u32x4& KX, u32x4& VX, u32x4& KY, u32x4& VY) {
        const int cur = t & 1;
        LAS unsigned char* kb = lds + cur * 9216;
        LAS unsigned char* vb = lds + 18432 + cur * 9216;
        if (t + 2 < ntile) { KY = *(const u32x4*)(Kb + (size_t)((t + 2) * 64 + skey) * 64 + sch * 8); VY = *(const u32x4*)(Vb + (size_t)skey * NKEY + (t + 2) * 64 + sch * 8); }
        f32x16 S0, S1;
#pragma unroll
        for (int s = 0; s < 4; ++s) {
            const bf16x8 a0 = *(const LAS bf16x8*)(kb + c * 144 + s * 32 + h2 * 16);
            const bf16x8 a1 = *(const LAS bf16x8*)(kb + (32 + c) * 144 + s * 32 + h2 * 16);
            S0 = __builtin_amdgcn_mfma_f32_32x32x16_bf16(a0, qf[s], s == 0 ? NM : S0, 0, 0, 0);
            S1 = __builtin_amdgcn_mfma_f32_32x32x16_bf16(a1, qf[s], s == 0 ? NM : S1, 0, 0, 0);
        }
        float mx = __builtin_fmaxf(__builtin_fmaxf(S0[0], S0[1]), S1[0]);
#pragma unroll
        for (int i = 1; i < 15; i += 2) mx = __builtin_fmaxf(__builtin_fmaxf(mx, S0[i + 1]), S0[i + 2 < 16 ? i + 2 : 15]);
#pragma unroll
        for (int i = 1; i < 16; i += 2) mx = __builtin_fmaxf(__builtin_fmaxf(mx, S1[i]), S1[i + 1 < 16 ? i + 1 : 15]);
        if (__builtin_amdgcn_ballot_w64(mx > 8.f) != 0ull) {
            const float mo = __int_as_float(__builtin_amdgcn_ds_bpermute((lane ^ 32) << 2, __float_as_int(mx)));
            const float m2 = fmaxf(mx, mo), d = m2 > 8.f ? m2 : 0.f, alpha = fexp2(-d);
            mrun += d; lsum *= alpha;
#pragma unroll
            for (int i = 0; i < 16; ++i) { S0[i] -= d; S1[i] -= d; O0[i] *= alpha; O1[i] *= alpha; NM[i] = -mrun; }
        }
        f32x2_t rs2 = (f32x2_t){0.f, 0.f};
#pragma unroll
        for (int i = 0; i < 16; i += 2) { S0[i] = fexp2(S0[i]); S0[i + 1] = fexp2(S0[i + 1]); S1[i] = fexp2(S1[i]); S1[i + 1] = fexp2(S1[i + 1]);
            rs2 += (f32x2_t){S0[i], S0[i + 1]}; rs2 += (f32x2_t){S1[i], S1[i + 1]}; }
        lsum += rs2.x + rs2.y;
        bf16x8 pf[4];
        { u32x4 w;
          w.x = pk2(S0[0], S0[1]); w.y = pk2(S0[2], S0[3]); w.z = pk2(S0[4], S0[5]); w.w = pk2(S0[6], S0[7]); pf[0] = __builtin_bit_cast(bf16x8, w);
          w.x = pk2(S0[8], S0[9]); w.y = pk2(S0[10], S0[11]); w.z = pk2(S0[12], S0[13]); w.w = pk2(S0[14], S0[15]); pf[1] = __builtin_bit_cast(bf16x8, w);
          w.x = pk2(S1[0], S1[1]); w.y = pk2(S1[2], S1[3]); w.z = pk2(S1[4], S1[5]); w.w = pk2(S1[6], S1[7]); pf[2] = __builtin_bit_cast(bf16x8, w);
          w.x = pk2(S1[8], S1[9]); w.y = pk2(S1[10], S1[11]); w.z = pk2(S1[12], S1[13]); w.w = pk2(S1[14], S1[15]); pf[3] = __builtin_bit_cast(bf16x8, w); }
#pragma unroll
        for (int ks = 0; ks < 4; ++ks) {
            const bf16x8 va0 = *(const LAS bf16x8*)(vb + c * 144 + 32 * ks + 16 * h2), va1 = *(const LAS bf16x8*)(vb + (32 + c) * 144 + 32 * ks + 16 * h2);
            O0 = __builtin_amdgcn_mfma_f32_32x32x16_bf16(va0, pf[ks], O0, 0, 0, 0);
            O1 = __builtin_amdgcn_mfma_f32_32x32x16_bf16(va1, pf[ks], O1, 0, 0, 0);
        }
        if (t + 1 < ntile) {
            LAS unsigned char* kn = lds + (cur ^ 1) * 9216; LAS unsigned char* vn = lds + 18432 + (cur ^ 1) * 9216;
            *(LAS u32x4*)(kn + skey * 144 + sch * 16) = KX;
            *(LAS u32x2*)(vn + vwo) = (u32x2){VX.x, VX.y}; *(LAS u32x2*)(vn + vwo + 16) = (u32x2){VX.z, VX.w};
        }
        __syncthreads();
    };
    for (int t = 0; t < ntile; t += 2) { tile_step(t, kr, vr, kr2, vr2); tile_step(t + 1, kr2, vr2, kr, vr); }
    lsum += __int_as_float(__builtin_amdgcn_ds_bpermute((lane ^ 32) << 2, __float_as_int(lsum)));
    const float inv = 1.f / lsum;
    bf16_t* orow = WSP(bf16_t, WS_OA) + (size_t)(orow0 + wave * 32 + c) * 512 + h * 64;
#pragma unroll
    for (int g4 = 0; g4 < 4; ++g4) {
        u32x2 o0, o1;
        o0.x = pk2(O0[4 * g4] * inv, O0[4 * g4 + 1] * inv); o0.y = pk2(O0[4 * g4 + 2] * inv, O0[4 * g4 + 3] * inv);
        o1.x = pk2(O1[4 * g4] * inv, O1[4 * g4 + 1] * inv); o1.y = pk2(O1[4 * g4 + 2] * inv, O1[4 * g4 + 3] * inv);
        *(u32x2*)(orow + 8 * g4 + 4 * h2) = o0; *(u32x2*)(orow + 32 + 8 * g4 + 4 * h2) = o1;
    }
}

struct ScanRaw { u32x2 x[3][3]; u32x2 a; u32x2 w; float mp, mn; };
__device__ __forceinline__ void scan_unit(Frame& F, const Params& p, int l, int cid) {
    const int tid = F.tid, sidx = tid >> 4, j = tid & 15;
    const int b = cid >> 5, h = (cid >> 2) & 7, dir = (cid >> 1) & 1, half = cid & 1;
    const int ch = h * 64 + 4 * j;
    const bf16_t* PROJ = WSP(bf16_t, WS_PROJ);
    const bf16_t* AIC = WSP(bf16_t, WS_AICLR);
    const bf16_t* WDEC = WSP(bf16_t, WS_WDEC);
    float* Y = WSP(float, WS_YFB) + (size_t)dir * MT * 512;
    const float* cw = inp(p, 9) + (size_t)l * 3 * 1536;
    f32x4 cwr[3], cwk[3], cwv[3];
#pragma unroll
    for (int tp = 0; tp < 3; ++tp) { cwr[tp] = *(const f32x4*)(cw + tp * 1536 + ch); cwk[tp] = *(const f32x4*)(cw + tp * 1536 + 512 + ch); cwv[tp] = *(const f32x4*)(cw + tp * 1536 + 1024 + ch); }
    const f32x4 kk0 = *(const f32x4*)(inp(p, 14) + (size_t)l * 1024 + ch), kk1 = *(const f32x4*)(inp(p, 14) + (size_t)l * 1024 + 512 + ch);
    f32x2_t SL = (f32x2_t){0.f, 0.f}, SH = (f32x2_t){0.f, 0.f};
    LAS unsigned char* lds = F.lds;
    constexpr int REC = 1408, BUF = 32 * REC;

    auto load_raw = [&](int c, ScanRaw& R) {
        const bool isctx = c < 8; const int cc = isctx ? c : c - 8, L = isctx ? 256 : 4096, base = isctx ? NLAT + b * 256 : b * 4096;
        const int t = dir ? (L - 1 - 32 * cc - sidx) : (32 * cc + sidx), row = base + t;
        R.mp = t > 0 ? 1.f : 0.f; R.mn = t < L - 1 ? 1.f : 0.f;
        const int rp = t > 0 ? row - 1 : row, rn = t < L - 1 ? row + 1 : row;
        const bf16_t* q0 = PROJ + (size_t)rp * PLD + PRKV + ch; const bf16_t* q1 = PROJ + (size_t)row * PLD + PRKV + ch; const bf16_t* q2 = PROJ + (size_t)rn * PLD + PRKV + ch;
#pragma unroll
        for (int k = 0; k < 3; ++k) { R.x[0][k] = *(const u32x2*)(q0 + 512 * k); R.x[1][k] = *(const u32x2*)(q1 + 512 * k); R.x[2][k] = *(const u32x2*)(q2 + 512 * k); }
        R.a = *(const u32x2*)(AIC + (size_t)row * 1024 + dir * 512 + ch);
        R.w = *(const u32x2*)(WDEC + (size_t)row * 1024 + dir * 512 + ch);
    };
    auto finish = [&](const ScanRaw& R, LAS unsigned char* buf) {
        const f32x4 r = cwr[0] * unp4(R.x[0][0]) * R.mp + cwr[1] * unp4(R.x[1][0]) + cwr[2] * unp4(R.x[2][0]) * R.mn;
        const f32x4 k = cwk[0] * unp4(R.x[0][1]) * R.mp + cwk[1] * unp4(R.x[1][1]) + cwk[2] * unp4(R.x[2][1]) * R.mn;
        const f32x4 v = cwv[0] * unp4(R.x[0][2]) * R.mp + cwv[1] * unp4(R.x[1][2]) + cwv[2] * unp4(R.x[2][2]) * R.mn;
        f32x4 kkv = k * kk0;
        float ss = kkv.x * kkv.x + kkv.y * kkv.y + kkv.z * kkv.z + kkv.w * kkv.w;
        ss = dpp_sum16(ss);
        kkv = kkv * frsq(ss + 1e-12f);
        const f32x4 a = unp4(R.a);
        const f32x4 kt = k * ((a - 1.f) * kk1 + 1.f);
        const f32x4 bb = kkv * a;
        LAS unsigned char* rec = buf + sidx * REC;
        { const f32x4 lw = unp4(R.w); *(LAS f32x4*)(rec + j * 16) = (f32x4){fexp2(lw.x), fexp2(lw.y), fexp2(lw.z), fexp2(lw.w)}; } *(LAS f32x4*)(rec + 256 + j * 16) = r; *(LAS f32x4*)(rec + 512 + j * 16) = kt;
        *(LAS f32x4*)(rec + 768 + j * 16) = kkv; *(LAS f32x4*)(rec + 1024 + j * 16) = bb;
        if ((j >> 3) == half) *(LAS f32x4*)(rec + 1280 + (j & 7) * 16) = v;
    };
    ScanRaw R;
    load_raw(0, R); finish(R, lds); __syncthreads();
    for (int c = 0; c < 136; ++c) {
        if (c + 1 < 136) load_raw(c + 1, R);
        {
            const bool isctx = c < 8; const int cc = isctx ? c : c - 8, L = isctx ? 256 : 4096, base = isctx ? NLAT + b * 256 : b * 4096;
            const int t0 = dir ? (L - 1 - 32 * cc) : (32 * cc);
            const int ysgn = dir ? -1 : 1;
            float* yb = Y + (size_t)(base + t0 + ysgn * j) * 512 + h * 64 + 32 * half + sidx;
            const ptrdiff_t ystep16 = (ptrdiff_t)ysgn * 16 * 512;
            const LAS unsigned char* buf = lds;
            float ykeep = 0.f, qp = 0.f;
            f32x4 w = *(const LAS f32x4*)(buf + j * 16), rr = *(const LAS f32x4*)(buf + 256 + j * 16), kt = *(const LAS f32x4*)(buf + 512 + j * 16);
            f32x4 kkv = *(const LAS f32x4*)(buf + 768 + j * 16), bb = *(const LAS f32x4*)(buf + 1024 + j * 16);
            float vv = *(const LAS float*)(buf + 1280 + sidx * 4);
#pragma unroll
            for (int s = 0; s < 32; ++s) {
                const LAS unsigned char* nrec = buf + (s < 31 ? s + 1 : 31) * REC;
                const f32x4 nw = *(const LAS f32x4*)(nrec + j * 16), nrr = *(const LAS f32x4*)(nrec + 256 + j * 16), nkt = *(const LAS f32x4*)(nrec + 512 + j * 16);
                const f32x4 nkk = *(const LAS f32x4*)(nrec + 768 + j * 16), nbb = *(const LAS f32x4*)(nrec + 1024 + j * 16);
                const float nvv = *(const LAS float*)(nrec + 1280 + sidx * 4);
                __builtin_amdgcn_sched_barrier(0);
                const f32x2_t pdv = SL * (f32x2_t){kkv.x, kkv.y} + SH * (f32x2_t){kkv.z, kkv.w};
                float pd = pdv.x + pdv.y;
                pd += dppf<0xB1>(pd); qp += dppf<0xB1>(qp);
                pd += dppf<0x4E>(pd); qp += dppf<0x4E>(qp);
                pd += dppf<0x141>(pd); qp += dppf<0x141>(qp);
                pd += dppf<0x140>(pd); qp += dppf<0x140>(qp);
                if (s > 0) { ykeep = (((s - 1) & 15) == j) ? qp : ykeep; if (((s - 1) & 15) == 15) { *yb = ykeep; yb += ystep16; } }
                const f32x2_t sa2 = (f32x2_t){-pd, -pd}, vv2 = (f32x2_t){vv, vv};
                SL = SL * (f32x2_t){w.x, w.y} + ((f32x2_t){bb.x, bb.y} * sa2 + (f32x2_t){kt.x, kt.y} * vv2);
                SH = SH * (f32x2_t){w.z, w.w} + ((f32x2_t){bb.z, bb.w} * sa2 + (f32x2_t){kt.z, kt.w} * vv2);
                const f32x2_t qv = SL * (f32x2_t){rr.x, rr.y} + SH * (f32x2_t){rr.z, rr.w};
                qp = qv.x + qv.y;
                w = nw; rr = nrr; kt = nkt; kkv = nkk; bb = nbb; vv = nvv;
            }
            qp = dpp_sum16(qp);
            ykeep = (j == 15) ? qp : ykeep;
            *yb = ykeep;
        }
        __syncthreads();
        if (c + 1 < 136) finish(R, lds);
        __syncthreads();
    }
}

__device__ __forceinline__ void scan_unit2(Frame& F, const Params& p, int l, int cid) {
    const int tid = F.tid, sidx = tid >> 4, j = tid & 15;
    const int b = cid >> 4, h = (cid >> 1) & 7, dir = cid & 1;
    const int ch = h * 64 + 4 * j;
    const bf16_t* PROJ = WSP(bf16_t, WS_PROJ);
    const bf16_t* AIC = WSP(bf16_t, WS_AICLR);
    const bf16_t* WDEC = WSP(bf16_t, WS_WDEC);
    float* Y = WSP(float, WS_YFB) + (size_t)dir * MT * 512;
    const float* cw = inp(p, 9) + (size_t)l * 3 * 1536;
    f32x4 cwr[3], cwk[3], cwv[3];
#pragma unroll
    for (int tp = 0; tp < 3; ++tp) { cwr[tp] = *(const f32x4*)(cw + tp * 1536 + ch); cwk[tp] = *(const f32x4*)(cw + tp * 1536 + 512 + ch); cwv[tp] = *(const f32x4*)(cw + tp * 1536 + 1024 + ch); }
    const f32x4 kk0 = *(const f32x4*)(inp(p, 14) + (size_t)l * 1024 + ch), kk1 = *(const f32x4*)(inp(p, 14) + (size_t)l * 1024 + 512 + ch);
    f32x2_t SLa = (f32x2_t){0.f, 0.f}, SHa = (f32x2_t){0.f, 0.f}, SLb = (f32x2_t){0.f, 0.f}, SHb = (f32x2_t){0.f, 0.f};
    LAS unsigned char* lds = F.lds;
    constexpr int REC = 1536, BUF = 32 * REC;

    auto load_raw = [&](int c, ScanRaw& R) {
        const bool isctx = c < 8; const int cc = isctx ? c : c - 8, L = isctx ? 256 : 4096, base = isctx ? NLAT + b * 256 : b * 4096;
        const int t = dir ? (L - 1 - 32 * cc - sidx) : (32 * cc + sidx), row = base + t;
        R.mp = t > 0 ? 1.f : 0.f; R.mn = t < L - 1 ? 1.f : 0.f;
        const int rp = t > 0 ? row - 1 : row, rn = t < L - 1 ? row + 1 : row;
        const bf16_t* q0 = PROJ + (size_t)rp * PLD + PRKV + ch; const bf16_t* q1 = PROJ + (size_t)row * PLD + PRKV + ch; const bf16_t* q2 = PROJ + (size_t)rn * PLD + PRKV + ch;
#pragma unroll
        for (int k = 0; k < 3; ++k) { R.x[0][k] = *(const u32x2*)(q0 + 512 * k); R.x[1][k] = *(const u32x2*)(q1 + 512 * k); R.x[2][k] = *(const u32x2*)(q2 + 512 * k); }
        R.a = *(const u32x2*)(AIC + (size_t)row * 1024 + dir * 512 + ch);
        R.w = *(const u32x2*)(WDEC + (size_t)row * 1024 + dir * 512 + ch);
    };
    auto finish = [&](const ScanRaw& R, LAS unsigned char* buf) {
        const f32x4 r = cwr[0] * unp4(R.x[0][0]) * R.mp + cwr[1] * unp4(R.x[1][0]) + cwr[2] * unp4(R.x[2][0]) * R.mn;
        const f32x4 k = cwk[0] * unp4(R.x[0][1]) * R.mp + cwk[1] * unp4(R.x[1][1]) + cwk[2] * unp4(R.x[2][1]) * R.mn;
        const f32x4 v = cwv[0] * unp4(R.x[0][2]) * R.mp + cwv[1] * unp4(R.x[1][2]) + cwv[2] * unp4(R.x[2][2]) * R.mn;
        f32x4 kkv = k * kk0;
        float ss = kkv.x * kkv.x + kkv.y * kkv.y + kkv.z * kkv.z + kkv.w * kkv.w;
        ss = dpp_sum16(ss);
        kkv = kkv * frsq(ss + 1e-12f);
        const f32x4 a = unp4(R.a);
        const f32x4 kt = k * ((a - 1.f) * kk1 + 1.f);
        const f32x4 bb = kkv * a;
        LAS unsigned char* rec = buf + sidx * REC;
        { const f32x4 lw = unp4(R.w); *(LAS f32x4*)(rec + j * 16) = (f32x4){fexp2(lw.x), fexp2(lw.y), fexp2(lw.z), fexp2(lw.w)}; } *(LAS f32x4*)(rec + 256 + j * 16) = r; *(LAS f32x4*)(rec + 512 + j * 16) = kt;
        *(LAS f32x4*)(rec + 768 + j * 16) = kkv; *(LAS f32x4*)(rec + 1024 + j * 16) = bb;
        { LAS float* vp = (LAS float*)(rec + 1280 + (j & 7) * 32 + (j >> 3) * 4); vp[0] = v.x; vp[2] = v.y; vp[4] = v.z; vp[6] = v.w; }
    };
    ScanRaw R;
    load_raw(0, R); finish(R, lds); __syncthreads();
    for (int c = 0; c < 136; ++c) {
        if (c + 1 < 136) load_raw(c + 1, R);
        {
            const bool isctx = c < 8; const int cc = isctx ? c : c - 8, L = isctx ? 256 : 4096, base = isctx ? NLAT + b * 256 : b * 4096;
            const int t0 = dir ? (L - 1 - 32 * cc) : (32 * cc);
            const int ysgn = dir ? -1 : 1;
            float* yb = Y + (size_t)(base + t0 + ysgn * (j >> 1)) * 512 + h * 64 + (j & 1) * 32 + sidx;
            const ptrdiff_t ystep16 = (ptrdiff_t)ysgn * 16 * 512;
            const LAS unsigned char* buf = lds;
            float keep0 = 0.f, keep1 = 0.f, qpa = 0.f, qpb = 0.f;
            const bool oddl = (j & 1) != 0; const ptrdiff_t y8 = (ptrdiff_t)ysgn * 8 * 512;
            f32x4 w = *(const LAS f32x4*)(buf + j * 16), rr = *(const LAS f32x4*)(buf + 256 + j * 16), kt = *(const LAS f32x4*)(buf + 512 + j * 16);
            f32x4 kkv = *(const LAS f32x4*)(buf + 768 + j * 16), bb = *(const LAS f32x4*)(buf + 1024 + j * 16);
            f32x2_t vv0 = *(const LAS f32x2_t*)(buf + 1280 + sidx * 8); float vva = vv0.x, vvb = vv0.y;
#pragma unroll
            for (int s = 0; s < 32; ++s) {
                const LAS unsigned char* nrec = buf + (s < 31 ? s + 1 : 31) * REC;
                const f32x4 nw = *(const LAS f32x4*)(nrec + j * 16), nrr = *(const LAS f32x4*)(nrec + 256 + j * 16), nkt = *(const LAS f32x4*)(nrec + 512 + j * 16);
                const f32x4 nkk = *(const LAS f32x4*)(nrec + 768 + j * 16), nbb = *(const LAS f32x4*)(nrec + 1024 + j * 16);
                const f32x2_t nvv = *(const LAS f32x2_t*)(nrec + 1280 + sidx * 8); const float nvva = nvv.x, nvvb = nvv.y;
                __builtin_amdgcn_sched_barrier(0);
                const f32x2_t kl = (f32x2_t){kkv.x, kkv.y}, kh = (f32x2_t){kkv.z, kkv.w};
                const f32x2_t pva = SLa * kl + SHa * kh, pvb = SLb * kl + SHb * kh;
                float pda = pva.x + pva.y, pdb = pvb.x + pvb.y;
                float z = (oddl ? qpb : qpa) + dppf<0xB1>(oddl ? qpa : qpb);
                pda += dppf<0xB1>(pda); pdb += dppf<0xB1>(pdb);
                pda += dppf<0x4E>(pda); pdb += dppf<0x4E>(pdb); z += dppf<0x4E>(z);
                pda += dppf<0x141>(pda); pdb += dppf<0x141>(pdb); z += dppf<0x124>(z);
                pda += dppf<0x140>(pda); pdb += dppf<0x140>(pdb); z += dppf<0x128>(z);
                if (s > 0) { const int q = (s - 1) & 15; const bool mine = (j >> 1) == (q & 7);
                    if (q < 8) keep0 = mine ? z : keep0; else keep1 = mine ? z : keep1;
                    if (q == 15) { yb[0] = keep0; yb[y8] = keep1; yb += ystep16; } }
                const f32x2_t wl = (f32x2_t){w.x, w.y}, wh = (f32x2_t){w.z, w.w}, bl = (f32x2_t){bb.x, bb.y}, bh = (f32x2_t){bb.z, bb.w}, tl = (f32x2_t){kt.x, kt.y}, th = (f32x2_t){kt.z, kt.w};
                const f32x2_t saa = (f32x2_t){-pda, -pda}, sab = (f32x2_t){-pdb, -pdb}, va2 = (f32x2_t){vva, vva}, vb2 = (f32x2_t){vvb, vvb};
                SLa = SLa * wl + (bl * saa + tl * va2); SHa = SHa * wh + (bh * saa + th * va2);
                SLb = SLb * wl + (bl * sab + tl * vb2); SHb = SHb * wh + (bh * sab + th * vb2);
                const f32x2_t rl = (f32x2_t){rr.x, rr.y}, rh = (f32x2_t){rr.z, rr.w};
                const f32x2_t qva = SLa * rl + SHa * rh, qvb = SLb * rl + SHb * rh;
                qpa = qva.x + qva.y; qpb = qvb.x + qvb.y;
                w = nw; rr = nrr; kt = nkt; kkv = nkk; bb = nbb; vva = nvva; vvb = nvvb;
            }
            { float z = (oddl ? qpb : qpa) + dppf<0xB1>(oddl ? qpa : qpb); z += dppf<0x4E>(z); z += dppf<0x124>(z); z += dppf<0x128>(z);
              keep1 = ((j >> 1) == 7) ? z : keep1; }
            yb[0] = keep0; yb[y8] = keep1;
        }
        __syncthreads();
        if (c + 1 < 136) finish(R, lds);
        __syncthreads();
    }
}

__device__ __forceinline__ void cmlp_unit(Frame& F, const Params& p, int l, int chk, int g) {
    const int tid = F.tid, wave = F.wave, lane = F.lane, c = lane & 31, h2 = lane >> 5;
    const bf16_t* PROJ = WSP(bf16_t, WS_PROJ);
    const bf16_t* WCM = WSP(bf16_t, WS_WCM) + (size_t)l * 4 * 128 * 128;
    const float* lg = inp(p, 19) + (size_t)l * 512; const float* lb = inp(p, 20) + (size_t)l * 512; const float* bs = inp(p, 22) + (size_t)l * 512;
    bf16_t* OC = WSP(bf16_t, WS_OA) + 2 * OABC_STRIDE;
    LAS unsigned char* vt = F.lds;
    LAS float* stats = (LAS float*)(F.lds + 40960);
    const int R0 = chk * 128;
    { const int tok = tid >> 2, q4 = tid & 3; const bf16_t* src = PROJ + (size_t)(R0 + tok) * PLD + PUV + 512 + q4 * 128;
      float s = 0.f, ss = 0.f;
#pragma unroll
      for (int i = 0; i < 16; ++i) { const u32x4 x = *(const u32x4*)(src + 8 * i);
          const float f[8] = {bflo(x.x), bfhi(x.x), bflo(x.y), bfhi(x.y), bflo(x.z), bfhi(x.z), bflo(x.w), bfhi(x.w)};
#pragma unroll
          for (int e = 0; e < 8; ++e) { s += f[e]; ss += f[e] * f[e]; } }
      s = sum4(s); ss = sum4(ss);
      const float mean = s * (1.f / 512.f), var = fmaxf(ss * (1.f / 512.f) - mean * mean, 0.f);
      if (q4 == 0) { stats[tok * 2] = mean; stats[tok * 2 + 1] = frsq(var + EPS); } }
    __syncthreads();
    {
        { const int q = tid >> 2, cg = tid & 3; const bf16_t* src = PROJ + (size_t)(R0 + q) * PLD + PUV + 512 + 128 * g + 32 * cg;
          const float mean = stats[q * 2], rstd = stats[q * 2 + 1];
#pragma unroll
          for (int i = 0; i < 4; ++i) { const u32x4 x = *(const u32x4*)(src + 8 * i);
              const float f[8] = {bflo(x.x), bfhi(x.x), bflo(x.y), bfhi(x.y), bflo(x.z), bfhi(x.z), bflo(x.w), bfhi(x.w)};
#pragma unroll
              for (int e = 0; e < 8; ++e) { const int cl = 32 * cg + 8 * i + e, chn = 128 * g + cl;
                  const float val = (f[e] - mean) * rstd * lg[chn] + lb[chn];
                  *(LAS unsigned short*)(vt + cl * 272 + q * 2) = (unsigned short)pk2(val, 0.f); } } }
        __syncthreads();
        const int pb = wave >> 1, cbase = 64 * (wave & 1);
        f32x16 a0, a1;
#pragma unroll
        for (int i = 0; i < 16; ++i) { a0[i] = 0.f; a1[i] = 0.f; }
#pragma unroll
        for (int ks = 0; ks < 8; ++ks) {
            const bf16x8 A = *(const bf16x8*)(WCM + ((size_t)(g * 128 + 32 * pb + c)) * 128 + 16 * ks + 8 * h2);
            const bf16x8 B0 = *(const LAS bf16x8*)(vt + (cbase + c) * 272 + 32 * ks + 16 * h2);
            const bf16x8 B1 = *(const LAS bf16x8*)(vt + (cbase + 32 + c) * 272 + 32 * ks + 16 * h2);
            a0 = __builtin_amdgcn_mfma_f32_32x32x16_bf16(B0, A, a0, 0, 0, 0);
            a1 = __builtin_amdgcn_mfma_f32_32x32x16_bf16(B1, A, a1, 0, 0, 0);
        }
        LAS unsigned char* ot = F.lds + 49152;
        { const int pr = 32 * pb + c; const float bsv = bs[g * 128 + pr];
#pragma unroll
          for (int g4 = 0; g4 < 4; ++g4) {
              const int ch = cbase + 8 * g4 + 4 * h2;
              *(LAS f32x4*)(ot + pr * 528 + ch * 4) = (f32x4){a0[4 * g4] + bsv, a0[4 * g4 + 1] + bsv, a0[4 * g4 + 2] + bsv, a0[4 * g4 + 3] + bsv};
              *(LAS f32x4*)(ot + pr * 528 + (ch + 32) * 4) = (f32x4){a1[4 * g4] + bsv, a1[4 * g4 + 1] + bsv, a1[4 * g4 + 2] + bsv, a1[4 * g4 + 3] + bsv}; } }
        __syncthreads();
#pragma unroll
        for (int i = 0; i < 4; ++i) { const int q = tid + 512 * i, tok = q >> 4, seg = q & 15; const size_t ro = (size_t)(R0 + tok);
            const f32x4 x0 = *(const LAS f32x4*)(ot + tok * 528 + seg * 32), x1 = *(const LAS f32x4*)(ot + tok * 528 + seg * 32 + 16);
            const u32x4 uu = *(const u32x4*)(PROJ + ro * PLD + PUV + 128 * g + seg * 8);
            u32x4 w;
            w.x = pk2(bflo(uu.x) * x0[0], bfhi(uu.x) * x0[1]); w.y = pk2(bflo(uu.y) * x0[2], bfhi(uu.y) * x0[3]);
            w.z = pk2(bflo(uu.z) * x1[0], bfhi(uu.z) * x1[1]); w.w = pk2(bflo(uu.w) * x1[2], bfhi(uu.w) * x1[3]);
            *(u32x4*)(OC + ro * 512 + 128 * g + seg * 8) = w; }
        __syncthreads();
    }
}

__device__ __forceinline__ void p5_readout(Frame& F, const Params& p, int l) {
    const int gw = F.bx * 8 + F.wave, NGW = F.G * 8, lane = F.lane, c0 = 8 * lane;
    const bf16_t* PROJ = WSP(bf16_t, WS_PROJ);
    const float* YF = WSP(float, WS_YFB); const float* YB = YF + (size_t)MT * 512;
    const bf16_t* GG = WSP(bf16_t, WS_GG);
    bf16_t* OB = WSP(bf16_t, WS_OA) + OABC_STRIDE;
    const float* cw = inp(p, 9) + (size_t)l * 3 * 1536;
    const float* rk = inp(p, 15) + (size_t)l * 512; const float* lg = inp(p, 17) + (size_t)l * 512; const float* lb = inp(p, 18) + (size_t)l * 512;
    const int nrows = (l == 3) ? NLAT : MT;
    float cwr_[3][8], cwk_[3][8], cwv_[3][8], rk_[8], lg_[8], lb_[8];
#pragma unroll
    for (int tp = 0; tp < 3; ++tp)
#pragma unroll
        for (int e = 0; e < 8; ++e) { cwr_[tp][e] = cw[tp * 1536 + c0 + e]; cwk_[tp][e] = cw[tp * 1536 + 512 + c0 + e]; cwv_[tp][e] = cw[tp * 1536 + 1024 + c0 + e]; }
#pragma unroll
    for (int e = 0; e < 8; ++e) { rk_[e] = rk[c0 + e]; lg_[e] = lg[c0 + e]; lb_[e] = lb[c0 + e]; }
#pragma unroll 2
    for (int r = gw; r < nrows; r += NGW) {
        const bool islat = r < NLAT; const int t = islat ? (r & 4095) : ((r - NLAT) & 255), L = islat ? 4096 : 256;
        float y[8];
        { const f32x4 a0 = *(const f32x4*)(YF + (size_t)r * 512 + c0), a1 = *(const f32x4*)(YF + (size_t)r * 512 + c0 + 4), b0 = *(const f32x4*)(YB + (size_t)r * 512 + c0), b1 = *(const f32x4*)(YB + (size_t)r * 512 + c0 + 4);
#pragma unroll
          for (int e = 0; e < 4; ++e) { y[e] = a0[e] + b0[e]; y[4 + e] = a1[e] + b1[e]; } }
        float s = 0.f;
#pragma unroll
        for (int e = 0; e < 8; ++e) s += y[e];
        s = sum8(s);
        const float mean = s * (1.f / 64.f);
        float q = 0.f;
#pragma unroll
        for (int e = 0; e < 8; ++e) { y[e] -= mean; q += y[e] * y[e]; }
        q = sum8(q);
        const float rstd = frsq(q * (1.f / 64.f) + 64e-5f);
        float rr[8], kk[8], vv[8];
#pragma unroll
        for (int e = 0; e < 8; ++e) { rr[e] = 0.f; kk[e] = 0.f; vv[e] = 0.f; }
#pragma unroll
        for (int tp = 0; tp < 3; ++tp) {
            const int tt = t + tp - 1; const bool ok = tt >= 0 && tt < L; const int rw = ok ? r + tp - 1 : r; const float mk = ok ? 1.f : 0.f;
            const bf16_t* src = PROJ + (size_t)rw * PLD + PRKV + c0;
            const u32x4 xr = *(const u32x4*)src, xk = *(const u32x4*)(src + 512), xv = *(const u32x4*)(src + 1024);
            const float fr_[8] = {bflo(xr.x), bfhi(xr.x), bflo(xr.y), bfhi(xr.y), bflo(xr.z), bfhi(xr.z), bflo(xr.w), bfhi(xr.w)};
            const float fk_[8] = {bflo(xk.x), bfhi(xk.x), bflo(xk.y), bfhi(xk.y), bflo(xk.z), bfhi(xk.z), bflo(xk.w), bfhi(xk.w)};
            const float fv_[8] = {bflo(xv.x), bfhi(xv.x), bflo(xv.y), bfhi(xv.y), bflo(xv.z), bfhi(xv.z), bflo(xv.w), bfhi(xv.w)};
#pragma unroll
            for (int e = 0; e < 8; ++e) { rr[e] += mk * cwr_[tp][e] * fr_[e]; kk[e] += mk * cwk_[tp][e] * fk_[e]; vv[e] += mk * cwv_[tp][e] * fv_[e]; }
        }
        float bsum = 0.f;
#pragma unroll
        for (int e = 0; e < 8; ++e) bsum += rr[e] * kk[e] * rk_[e];
        bsum = sum8(bsum);
        const u32x4 gw4 = *(const u32x4*)(GG + (size_t)r * 512 + c0);
        const float gg[8] = {bflo(gw4.x), bfhi(gw4.x), bflo(gw4.y), bfhi(gw4.y), bflo(gw4.z), bfhi(gw4.z), bflo(gw4.w), bfhi(gw4.w)};
        float o[8];
#pragma unroll
        for (int e = 0; e < 8; ++e) o[e] = (y[e] * rstd * lg_[e] + lb_[e] + bsum * vv[e]) * gg[e];
        u32x4 ow; ow.x = pk2(o[0], o[1]); ow.y = pk2(o[2], o[3]); ow.z = pk2(o[4], o[5]); ow.w = pk2(o[6], o[7]);
        *(u32x4*)(OB + (size_t)r * 512 + c0) = ow;
    }
}

__device__ __forceinline__ void p8_postmix(Frame& F, const Params& p, int l) {
    const int gw = F.bx * 8 + F.wave, NGW = F.G * 8, lane = F.lane;
    const int rows = (l == 3) ? NLAT : MT;
    const bf16_t* OL = WSP(bf16_t, WS_OL);
    const bool moe = (l & 1) != 0; const int li = l >> 1;
    const float* router = inp(p, 27) + (size_t)li * 1024 * 8;
    unsigned* cnt = WSP(unsigned, WS_CTL) + CW_MOE + li * 8 * 64;
    int* route = WSP(int, WS_ROUTE);
    f32x4 rw0[4][4], rw1[4][4];
    if (moe) {
#pragma unroll
        for (int j = 0; j < 4; ++j)
#pragma unroll
            for (int i = 0; i < 4; ++i) { const int c = 4 * lane + 256 * j + i; rw0[j][i] = *(const f32x4*)(router + (size_t)c * 8); rw1[j][i] = *(const f32x4*)(router + (size_t)c * 8 + 4); } }
    unsigned long long pk0 = 0ull, pk1 = 0ull; int kk_ = 0, klat = 0;
    int ec[8];
#pragma unroll
    for (int e = 0; e < 8; ++e) ec[e] = 0;
#pragma unroll 1
    for (int seg = 0; seg < 2; ++seg) {
    const int rbeg = seg == 0 ? (gw & 7) * 4096 + (gw >> 3) : NLAT + gw, rstep = seg == 0 ? (NGW >> 3) : NGW, rend = seg == 0 ? (gw & 7) * 4096 + 4096 : rows;
    if (rbeg >= rend) continue;
    f32x4 gg[4], gs[4], sh[4];
    load_gg(F, p, l, 1, 2, seg == 0 ? (gw & 7) : 8, gg); load_gs(F, p, l, 2, 4, 3, seg == 0 ? (gw & 7) : 8, gs, sh);
    u32x2 nf[4], nx[4];
#pragma unroll
    for (int j = 0; j < 4; ++j) { nf[j] = *(const u32x2*)(OL + (size_t)rbeg * D + 4 * lane + 256 * j); nx[j] = *(const u32x2*)(xres_row(F, rbeg) + 4 * lane + 256 * j); }
    for (int r = rbeg; r < rend; r += rstep) {
        f32x4 fv[4], xv[4], hv[4]; u32x2 cx[4];
#pragma unroll
        for (int j = 0; j < 4; ++j) { fv[j] = unp4(nf[j]); cx[j] = nx[j]; }
        { const int rn = (r + rstep < rend) ? r + rstep : r;
#pragma unroll
          for (int j = 0; j < 4; ++j) { nf[j] = *(const u32x2*)(OL + (size_t)rn * D + 4 * lane + 256 * j); nx[j] = *(const u32x2*)(xres_row(F, rn) + 4 * lane + 256 * j); } }
        residual_update_v(F, p, fv, cx, r, gg, xv, false);
        emit_h_v(F, xv, r, gs, sh, hv);
        if (moe) {
            float lg[8];
#pragma unroll
            for (int e = 0; e < 8; ++e) lg[e] = 0.f;
#pragma unroll
            for (int j = 0; j < 4; ++j)
#pragma unroll
                for (int i = 0; i < 4; ++i) { const f32x4 w0 = rw0[j][i], w1 = rw1[j][i];
                    const float hval = hv[j][i];
#pragma unroll
                    for (int e = 0; e < 4; ++e) { lg[e] += hval * w0[e]; lg[4 + e] += hval * w1[e]; } }
#pragma unroll
            for (int e = 0; e < 8; ++e) lg[e] = wave_sum(lg[e]);
            int i0 = 0; float v0 = lg[0];
#pragma unroll
            for (int e = 1; e < 8; ++e) if (lg[e] > v0) { v0 = lg[e]; i0 = e; }
            int i1 = (i0 == 0) ? 1 : 0; float v1 = -3.4e38f;
#pragma unroll
            for (int e = 0; e < 8; ++e) if (e != i0 && lg[e] > v1) { v1 = lg[e]; i1 = e; }
            const float w1 = 1.f / (1.f + __expf(v0 - v1)), w0 = 1.f - w1;
            const int u0 = __builtin_amdgcn_readfirstlane(i0), u1 = __builtin_amdgcn_readfirstlane(i1);
            pk0 |= (unsigned long long)u0 << (3 * kk_); pk1 |= (unsigned long long)u1 << (3 * kk_); ++kk_;
#pragma unroll
            for (int e = 0; e < 8; ++e) ec[e] += (u0 == e ? 1 : 0) + (u1 == e ? 1 : 0);
            if (lane == 0) { int* rt = route + (size_t)r * 8; rt[0] = u0; rt[1] = u1; rt[4] = __float_as_int(w0); rt[5] = __float_as_int(w1); }
        }
    }
    if (seg == 0) klat = kk_;
    }
    if (moe) {
        int cv = 0;
#pragma unroll
        for (int e = 0; e < 8; ++e) cv = (lane == e) ? ec[e] : cv;
        int bv = 0;
        if (lane < 8 && cv > 0) bv = (int)__hip_atomic_fetch_add(cnt + lane * 64, (unsigned)cv, __ATOMIC_RELAXED, __HIP_MEMORY_SCOPE_AGENT);
        for (int k = 0; k < kk_; ++k) {
            const int u0 = (int)((pk0 >> (3 * k)) & 7ull), u1 = (int)((pk1 >> (3 * k)) & 7ull);
            const int s0 = __builtin_amdgcn_readlane(bv, u0); bv += (lane == u0) ? 1 : 0;
            const int s1 = __builtin_amdgcn_readlane(bv, u1); bv += (lane == u1) ? 1 : 0;
            const int row = k < klat ? (gw & 7) * 4096 + (gw >> 3) + k * (NGW >> 3) : NLAT + gw + (k - klat) * NGW;
            if (lane == 0) { int* rt = route + (size_t)row * 8; rt[2] = s0; rt[3] = s1; }
        }
    }
}
__device__ __forceinline__ void moe_tile_starts(Frame& F, int li, int (&ts)[9]) {
    unsigned* cnt = WSP(unsigned, WS_CTL) + CW_MOE + li * 8 * 64;
    ts[0] = 0;
#pragma unroll
    for (int e = 0; e < 8; ++e) { const unsigned c = __builtin_amdgcn_readfirstlane(__hip_atomic_load(cnt + e * 64, __ATOMIC_RELAXED, __HIP_MEMORY_SCOPE_AGENT)); ts[e + 1] = ts[e] + (int)((c + 255u) >> 8); }
}
__device__ __forceinline__ void p9_gather(Frame& F, const Params& p, int l) {
    const int gw = F.bx * 8 + F.wave, NGW = F.G * 8, lane = F.lane;
    const int rows = (l == 3) ? NLAT : MT;
    int ts[9]; moe_tile_starts(F, l >> 1, ts);
    const int* route = WSP(int, WS_ROUTE); int* prow = WSP(int, WS_PROW);
    const bf16_t* H = WSP(bf16_t, WS_H); bf16_t* HP = WSP(bf16_t, WS_HPERM);
#pragma unroll 2
    for (int r = gw; r < rows; r += NGW) {
        const int rv = route[(size_t)r * 8 + (lane & 3)];
        const int e0 = __builtin_amdgcn_readlane(rv, 0), e1 = __builtin_amdgcn_readlane(rv, 1), s0 = __builtin_amdgcn_readlane(rv, 2), s1 = __builtin_amdgcn_readlane(rv, 3);
        int t0 = 0, t1 = 0;
#pragma unroll
        for (int e = 0; e < 8; ++e) { t0 = (e0 == e) ? ts[e] : t0; t1 = (e1 == e) ? ts[e] : t1; }
        const int p0 = 256 * t0 + s0, p1 = 256 * t1 + s1;
        const u32x4 a = *(const u32x4*)(H + (size_t)r * D + 8 * lane), c = *(const u32x4*)(H + (size_t)r * D + 512 + 8 * lane);
        *(u32x4*)(HP + (size_t)p0 * D + 8 * lane) = a; *(u32x4*)(HP + (size_t)p0 * D + 512 + 8 * lane) = c;
        *(u32x4*)(HP + (size_t)p1 * D + 8 * lane) = a; *(u32x4*)(HP + (size_t)p1 * D + 512 + 8 * lane) = c;
        if (lane == 0) { prow[(size_t)r * 2] = p0; prow[(size_t)r * 2 + 1] = p1; }
    }
}
__device__ __forceinline__ void p12_postffn(Frame& F, const Params& p, int l) {
    const int gw = F.bx * 8 + F.wave, NGW = F.G * 8, lane = F.lane;
    const int rows = (l == 3) ? NLAT : MT;
    const bool moe = (l & 1) != 0;
    const bf16_t* FO = WSP(bf16_t, WS_YP);
    const int* route = WSP(int, WS_ROUTE); const int* prow = WSP(int, WS_PROW);
    u32x2 nx[4]; int npv = 0, nwv = 0;
#pragma unroll 1
    for (int seg = 0; seg < 2; ++seg) {
    const int rbeg = seg == 0 ? (gw & 7) * 4096 + (gw >> 3) : NLAT + gw, rstep = seg == 0 ? (NGW >> 3) : NGW, rend = seg == 0 ? (gw & 7) * 4096 + 4096 : rows;
    if (rbeg >= rend) continue;
    const int mvi = seg == 0 ? (gw & 7) : 8;
    f32x4 gg[4], gs[4], sh[4];
    load_gg(F, p, l, 3, 5, mvi, gg);
    if (l < 3) load_gs(F, p, l + 1, 0, 1, 0, mvi, gs, sh);
#pragma unroll
    for (int j = 0; j < 4; ++j) nx[j] = *(const u32x2*)(xres_row(F, rbeg) + 4 * lane + 256 * j);
    if (moe) { npv = prow[(size_t)rbeg * 2 + (lane & 1)]; nwv = route[(size_t)rbeg * 8 + 4 + (lane & 1)]; }
    for (int r = rbeg; r < rend; r += rstep) {
        f32x4 fv[4], xv[4], hv[4]; u32x2 cx[4];
#pragma unroll
        for (int j = 0; j < 4; ++j) cx[j] = nx[j];
        const int pv = npv, wv = nwv;
        { const int rn = (r + rstep < rend) ? r + rstep : r;
#pragma unroll
          for (int j = 0; j < 4; ++j) nx[j] = *(const u32x2*)(xres_row(F, rn) + 4 * lane + 256 * j);
          if (moe) { npv = prow[(size_t)rn * 2 + (lane & 1)]; nwv = route[(size_t)rn * 8 + 4 + (lane & 1)]; } }
        if (moe) {
            const int p0 = __builtin_amdgcn_readlane(pv, 0), p1 = __builtin_amdgcn_readlane(pv, 1); const float w0 = __int_as_float(__builtin_amdgcn_readlane(wv, 0)), w1 = __int_as_float(__builtin_amdgcn_readlane(wv, 1));
#pragma unroll
            for (int j = 0; j < 4; ++j) fv[j] = w0 * unp4(*(const u32x2*)(FO + (size_t)p0 * D + 4 * lane + 256 * j)) + w1 * unp4(*(const u32x2*)(FO + (size_t)p1 * D + 4 * lane + 256 * j));
        } else {
#pragma unroll
            for (int j = 0; j < 4; ++j) fv[j] = unp4(*(const u32x2*)(FO + (size_t)r * D + 4 * lane + 256 * j));
        }
        residual_update_v(F, p, fv, cx, r, gg, xv, l == 3);
        if (l < 3) emit_h_v(F, xv, r, gs, sh, hv);
    }
    }
}


#ifndef DIGEST_AFTER
#define DIGEST_AFTER 0
#define DIGEST_GAIN 1.0f
#define DIGEST_SEL 7
#define P4_MASK 7
#endif
__device__ __forceinline__ void digest_phase(Frame& F, const Params& p, int upto) {
    const int gw = F.bx * 8 + F.wave, NGW = F.G * 8, lane = F.lane;
    for (int r = gw; r < NLAT; r += NGW) {
        const int rc = NLAT + (r & 2047);
        float* xr = outp(p) + (size_t)r * D;
        for (int j = 0; j < 16; ++j) {
            const int c = lane + 64 * j;
            float acc = 0.f;
            for (int rr_ = 0; rr_ < 2; ++rr_) { const int row = rr_ ? rc : r;
                if (upto == 1) { acc += bf1(WSP(bf16_t, WS_H)[(size_t)row * D + c]) + bf1(WSP(bf16_t, WS_WIN)[(size_t)(row % PLD) * 1024 + c]) + WSP(float, WS_MODV)[((size_t)row * 1024 + c) % (9 * 6144)]; }
                if (upto >= 2) { for (int k = 0; k < 6; ++k) acc += bf1(WSP(bf16_t, WS_PROJ)[(size_t)row * PLD + c + 1024 * k]); acc += bf1(WSP(bf16_t, WS_PROJ)[(size_t)row * PLD + 6144 + (c % 768)]); }
                if (upto >= 3) { acc += bf1(WSP(bf16_t, WS_WDEC)[(size_t)row * 1024 + c]) + bf1(WSP(bf16_t, WS_AICLR)[(size_t)row * 1024 + c]) + bf1(WSP(bf16_t, WS_GG)[(size_t)row * 512 + (c & 511)]);
                    acc += bf1(WSP(bf16_t, WS_QN)[((size_t)row * 1024 + c) % ((size_t)NB * 8 * NKEY * 64)]) + bf1(WSP(bf16_t, WS_KN)[((size_t)row * 1024 + c) % ((size_t)NB * 2 * NKEY * 64)]) + bf1(WSP(bf16_t, WS_VT)[((size_t)row * 1024 + c) % ((size_t)NB * 2 * NKEY * 64)]); }
                if (upto >= 4) { if (DIGEST_SEL & 1) acc += bf1(WSP(bf16_t, WS_OA)[(size_t)row * 512 + (c & 511)]); if (DIGEST_SEL & 2) acc += bf1(WSP(bf16_t, WS_OA)[2 * OABC_STRIDE + (size_t)row * 512 + (c & 511)]);
                    if (DIGEST_SEL & 4) acc += WSP(float, WS_YFB)[(size_t)row * 512 + (c & 511)] + WSP(float, WS_YFB)[(size_t)MT * 512 + (size_t)row * 512 + (c & 511)]; }
                if (upto == 5) acc += bf1(WSP(bf16_t, WS_OA)[OABC_STRIDE + (size_t)row * 512 + (c & 511)]);
                if (upto == 6) acc += bf1(WSP(bf16_t, WS_YM)[(size_t)row * 1024 + c]);
                if (upto == 7) acc += WSP(float, WS_OL)[(size_t)row * 1024 + c];
            }
            xr[c] = (__hip_atomic_load(WSP(unsigned, WS_CTL) + 64, __ATOMIC_RELAXED, __HIP_MEMORY_SCOPE_AGENT) != 0u) ? __builtin_nanf("") : DIGEST_GAIN * acc;
        }
    }
}
__global__ void __launch_bounds__(512, 2) mk_fwd(Params p) {
    extern __shared__ __attribute__((aligned(16))) unsigned char lds_raw[];
    Frame F;
    F.lds = (LAS unsigned char*)lds_raw;
    F.tid = threadIdx.x; F.lane = F.tid & 63; F.wave = __builtin_amdgcn_readfirstlane(F.tid >> 6);
    F.G = gridDim.x; F.bx = blockIdx.x; F.ws = (GAS unsigned char*)p.ws;
    volatile LAS unsigned* MISC = (volatile LAS unsigned*)(F.lds + LDS_MISC);
#ifdef LDSZERO
    for (int i = F.tid; i < LDS_BYTES / 16; i += 512) *(LAS u32x4*)(F.lds + 16 * i) = (u32x4){0u, 0u, 0u, 0u};
#endif
#ifdef LDSTEST
    unsigned lds_err = 0;
    for (int round = 0; round < 4; ++round) {
        for (int i = 0; i < 72; ++i) ((LAS unsigned*)F.lds)[i * 512 + F.tid] = (unsigned)(F.tid * 2654435761u + round * 7919u + i * 104729u);
        __syncthreads();
        const int t2 = (F.tid + 1 + 64 * round) & 511;
        for (int i = 0; i < 72; ++i) lds_err += (((LAS unsigned*)F.lds)[i * 512 + t2] != (unsigned)(t2 * 2654435761u + round * 7919u + i * 104729u)) ? 1u : 0u;
        __syncthreads();
    }
    if (lds_err) __hip_atomic_fetch_add(WSP(unsigned, WS_CTL) + 64, lds_err, __ATOMIC_RELAXED, __HIP_MEMORY_SCOPE_AGENT);
    for (int i = F.tid; i < LDS_BYTES / 16; i += 512) *(LAS u32x4*)(F.lds + 16 * i) = (u32x4){0u, 0u, 0u, 0u};
#endif
    if (F.tid < 64) MISC[F.tid] = 0u;
    __syncthreads();
#ifdef L2FLUSH
    {
        const u32x4* src = (const u32x4*)(GAS const u32x4*)(unsigned long long)p.in[28] + (size_t)F.bx * 65536 + F.tid;
        unsigned accx = 0;
#pragma unroll 8
        for (int i = 0; i < 128; ++i) { const u32x4 v = src[(size_t)i * 512]; accx ^= v.x ^ v.y ^ v.z ^ v.w; }
        if (accx == 0x12345u && F.tid == 1023) p.out[0] = 0.f;
        asm volatile("" :: "v"(accx));
    }
#endif
    XcdBarrier bar = xcd_barrier_post(WSP(unsigned, WS_CTL) + CW_BAR, MISC + 8);
#define GRID_BAR() do { XcdBarrier _b = bar; unsigned long long _t = (unsigned long long)_b.bar; int _wv0 = __builtin_amdgcn_readfirstlane(F.wave); asm volatile("" : "+s"(_t), "+s"(_wv0)); _b.bar = (unsigned*)(GAS unsigned*)_t; xcd_barrier(_b, (_wv0 == 0) && (lane_id() == 0)); } while (0)
#define LAUNDER() do { unsigned long long _w = (unsigned long long)p.ws; int _wv = __builtin_amdgcn_readfirstlane(F.wave); asm volatile("" : "+s"(_w), "+s"(_wv)); F.ws = (GAS unsigned char*)_w; F.wave = _wv; F.lane = lane_id(); F.tid = _wv * 64 + F.lane; } while (0)
    const int stop = p.stop_after;

    const bool p4split = (F.G & 15) == 0 && F.G >= 16;
    p0_prologue(F, p, p4split);
    GRID_BAR(); LAUNDER();
    p1_input(F, p);
    GRID_BAR(); LAUNDER();
    if (DIGEST_AFTER == 1) { digest_phase(F, p, 1); return; }
#ifdef SYNTH
    { const size_t gt = (size_t)F.bx * 512 + F.tid, NT = (size_t)F.G * 512;
      bf16_t* H = WSP(bf16_t, WS_H); bf16_t* W = WSP(bf16_t, WS_WIN);
      for (size_t i = gt; i < (size_t)MT * D; i += NT) { const int r = (int)(i >> 10), k = (int)(i & 1023); H[i] = (bf16_t)pk2((float)(((r * 131 + k * 71) % 257) - 128) * (1.f / 128.f), 0.f); }
      for (size_t i = gt; i < (size_t)PLD * 1024; i += NT) { const int n = (int)(i >> 10), k = (int)(i & 1023); W[i] = (bf16_t)pk2((float)(((n * 37 + k * 101) % 263) - 131) * (1.f / 131.f), 0.f); } }
    GRID_BAR(); LAUNDER();
#endif
    if (stop == 0) return;

    for (int l = 0; l < 4; ++l) {
        const int li = l >> 1;
#ifdef LDSTEST2
        { unsigned lds_err = 0;
          for (int round = 0; round < 256; ++round) {
              for (int i = 0; i < 8; ++i) { const unsigned v = (unsigned)(F.tid * 2654435761u + round * 7919u + i * 104729u); *(LAS u32x4*)(F.lds + (F.tid >> 3) * 144 + (F.tid & 7) * 16 + i * 9216) = (u32x4){v, v + 1u, v + 2u, v + 3u}; }
              __syncthreads();
              const int t2 = (F.tid * 7 + 64 * round + 13) & 511;
              for (int i = 0; i < 8; ++i) { const unsigned v = (unsigned)(t2 * 2654435761u + round * 7919u + i * 104729u); const u32x4 q = *(const LAS u32x4*)(F.lds + (t2 >> 3) * 144 + (t2 & 7) * 16 + i * 9216);
                  lds_err += (q.x != v || q.y != v + 1u || q.z != v + 2u || q.w != v + 3u) ? 1u : 0u; }
              __syncthreads();
          }
          if (lds_err) __hip_atomic_fetch_add(WSP(unsigned, WS_CTL) + 64, lds_err, __ATOMIC_RELAXED, __HIP_MEMORY_SCOPE_AGENT); }
#endif
#ifdef FAKE_P2
        { const bf16_t* H = WSP(bf16_t, WS_H); const bf16_t* W = WSP(bf16_t, WS_WIN); bf16_t* P = WSP(bf16_t, WS_PROJ);
          for (size_t i = (size_t)F.bx * 512 + F.tid; i < (size_t)MT * PLD; i += (size_t)F.G * 512) { const int r = (int)(i / PLD), n = (int)(i % PLD);
              P[i] = (bf16_t)pk2(bf1(H[(size_t)r * D + (n & 1023)]) * bf1(W[(size_t)n * 1024 + (r & 1023)]), 0.f); } }
        if (0)
#endif
        { pg8::Gemm g{WSP(bf16_t, WS_H), WSP(bf16_t, WS_WIN) + (size_t)l * PLD * 1024, 1024, 1024, 1024, 0, 0};
          pg8::InProjOrder S; if (l == 3) S.init2(NLAT / 256, NCTX / 256, PLD / 256, PQ / 256, F.G, F.bx); else S.init2(MT / 256, 0, PLD / 256, 0, F.G, F.bx);
          pg8::EpiProj E{WSP(bf16_t, WS_PROJ)};
          GEMM_CALL(F.lds, F.tid, g, S, E); LAUNDER(); if (GEMM_REPEAT) { GEMM_CALL(F.lds, F.tid, g, S, E); LAUNDER(); } }
        GRID_BAR(); LAUNDER();
        if (DIGEST_AFTER == 2) { digest_phase(F, p, 2); return; }
        { pg8::Gemm g{WSP(bf16_t, WS_PROJ) + PWLOW, WSP(bf16_t, WS_WLORA) + (size_t)l * 2560 * 384, 384, PLD, 384, 0, 0};
          pg8::LoraOrder S; S.init(MT / 256, 10, F.G, F.bx);
          pg8::EpiLora E{WSP(bf16_t, WS_WDEC), WSP(bf16_t, WS_AICLR), WSP(bf16_t, WS_GG), inp(p, 10) + (size_t)l * 1024, inp(p, 12) + (size_t)l * 1024};
          GEMM_CALL(F.lds, F.tid, g, S, E); LAUNDER(); if (GEMM_REPEAT) { GEMM_CALL(F.lds, F.tid, g, S, E); LAUNDER(); } }
        p3_qk(F, p, l);
        p3_vt(F);
        GRID_BAR(); LAUNDER();
        if (DIGEST_AFTER == 3) { digest_phase(F, p, 3); return; }
#ifndef P4_MASK
#define P4_MASK 7
#endif
        if (p4split) {
            const int hg = F.G >> 1;
            const int nchx = ((l == 3) ? NLAT : MT) / 128 / 8 * 4, ksplit = (nchx * CMLP_SCAN_SHARE) / 100;
            if (F.bx < hg) { for (int cid = F.bx; cid < 128; cid += hg) scan_unit2(F, p, l, cid); LAUNDER();
                for (int k = F.bx >> 3; k < ksplit; k += (hg >> 3)) cmlp_unit(F, p, l, (F.bx & 7) + 8 * (k >> 2), k & 3); }
            else {
                const int ab = F.bx - hg, nunits = (l < 3) ? 1088 : 1024;
                for (int u = ab; u < nunits; u += hg) {
                    if (u < 1024) { const int qt = u >> 6, h = (u >> 3) & 7, b = u & 7; attn_unit(F, b, h, 256 + 256 * qt, NKEY, b * 4096 + 256 * qt); }
                    else { const int cu = u - 1024, h = cu >> 3, b = cu & 7; attn_unit(F, b, h, 0, 256, NLAT + b * 256); }
                }
                LAUNDER();
                const int nch = ((l == 3) ? NLAT : MT) / 128, xcd = F.bx & 7, perx = hg >> 3;
                for (int k = ksplit + (ab >> 3); ; k += perx) { const int chk = xcd + 8 * (k >> 2); if (chk >= nch) break; cmlp_unit(F, p, l, chk, k & 3); }
                LAUNDER(); __syncthreads();
                p0_slot(F, p, l, ab * 8 + F.wave, hg * 8);
            }
        } else {
        if (P4_MASK & 1) { const int nunits = (l < 3) ? 1088 : 1024;
          for (int rep = 0; rep < ATT_REPEAT; ++rep)
          for (int u = F.bx; u < nunits; u += F.G) {
              if (u < 1024) { const int qt = u >> 6, h = (u >> 3) & 7, b = u & 7; attn_unit(F, b, h, 256 + 256 * qt, NKEY, b * 4096 + 256 * qt); }
              else { const int cu = u - 1024, h = cu >> 3, b = cu & 7; attn_unit(F, b, h, 0, 256, NLAT + b * 256); }
          } }
        LAUNDER();
        if (P4_MASK & 2) for (int cid = F.bx; cid < 256; cid += F.G) scan_unit(F, p, l, cid);
        LAUNDER();
        if (P4_MASK & 4) { const int nch = ((l == 3) ? NLAT : MT) / 128, xcd = F.bx & 7, perx = F.G >> 3;
          if ((F.G & 7) == 0) { for (int k = (perx == 32) ? (((F.bx >> 3) + 24) & 31) : (F.bx >> 3); ; k += perx) { const int chk = xcd + 8 * (k >> 2); if (chk >= nch) break; cmlp_unit(F, p, l, chk, k & 3); } }
          else for (int u = F.bx; u < 4 * nch; u += F.G) cmlp_unit(F, p, l, u >> 2, u & 3); }
        }
        GRID_BAR(); LAUNDER();
        if (DIGEST_AFTER == 4) { digest_phase(F, p, 4); return; }
        p5_readout(F, p, l);
        GRID_BAR(); LAUNDER();
        if (DIGEST_AFTER == 5) { digest_phase(F, p, 5); return; }
        { pg8::Gemm g{WSP(bf16_t, WS_OA), WSP(bf16_t, WS_WBR) + (size_t)l * 3 * 1024 * 512, 512, 512, 512, OABC_STRIDE, (size_t)1024 * 512};
          pg8::MergeOrder S; S.init(((l == 3) ? NLAT : MT) / 256, 4, F.G, F.bx);
          pg8::EpiMerge E{WSP(bf16_t, WS_PROJ), WSP(bf16_t, WS_TMP), WSP(bf16_t, WS_YM)};
          GEMM_CALL(F.lds, F.tid, g, S, E); LAUNDER(); if (GEMM_REPEAT) { GEMM_CALL(F.lds, F.tid, g, S, E); LAUNDER(); } }
        GRID_BAR(); LAUNDER();
        if (DIGEST_AFTER == 6) { digest_phase(F, p, 6); return; }
        { pg8::Gemm g{WSP(bf16_t, WS_YM), WSP(bf16_t, WS_WOUT) + (size_t)l * 1024 * 1024, 1024, 1024, 1024, 0, 0};
          pg8::StaticOrder S; S.init(((l == 3) ? NLAT : MT) / 256, 4, F.G, F.bx);
          pg8::EpiBf16Out E{WSP(bf16_t, WS_OL), 1024};
          GEMM_CALL(F.lds, F.tid, g, S, E); LAUNDER(); if (GEMM_REPEAT) { GEMM_CALL(F.lds, F.tid, g, S, E); LAUNDER(); } }
        GRID_BAR(); LAUNDER();
        if (DIGEST_AFTER == 7) { digest_phase(F, p, 7); return; }
        p8_postmix(F, p, l);
        GRID_BAR(); LAUNDER();
        const int mrows = (l == 3) ? NLAT : MT;
        if ((l & 1) == 0) {
            LAUNDER();
            { pg8::Gemm g{WSP(bf16_t, WS_H), WSP(bf16_t, WS_WGU) + (size_t)li * 2 * FD * 1024, 1024, 1024, 1024, 0, 0};
              pg8::StaticOrder S; S.init(mrows / 256, 2 * FD / 256, F.G, F.bx);
              pg8::EpiSwiglu E{WSP(bf16_t, WS_HID), FD};
              GEMM_CALL(F.lds, F.tid, g, S, E); LAUNDER(); if (GEMM_REPEAT) { GEMM_CALL(F.lds, F.tid, g, S, E); LAUNDER(); } }
            GRID_BAR(); LAUNDER();
            { pg8::Gemm g{WSP(bf16_t, WS_HID), WSP(bf16_t, WS_WDN) + (size_t)li * 1024 * FD, FD, FD, FD, 0, 0};
              pg8::StaticOrder S; S.init(mrows / 256, 4, F.G, F.bx);
              pg8::EpiBf16Out E{WSP(bf16_t, WS_YP), 1024};
              GEMM_CALL(F.lds, F.tid, g, S, E); LAUNDER(); if (GEMM_REPEAT) { GEMM_CALL(F.lds, F.tid, g, S, E); LAUNDER(); } }
            GRID_BAR(); LAUNDER();
        } else {
            LAUNDER();
            p9_gather(F, p, l);
            GRID_BAR(); LAUNDER();
            { pg8::Gemm g{WSP(bf16_t, WS_HPERM), WSP(bf16_t, WS_MGU) + (size_t)li * 8 * 2 * FE * 1024, 1024, 1024, 1024, 0, (size_t)2 * FE * 1024};
              pg8::GroupOrder S; int ts[9]; moe_tile_starts(F, li, ts); { LAS int* tp = (LAS int*)(F.lds + LDS_MISC + 256);
                __syncthreads();
                if (F.tid == 0) {
#pragma unroll
                    for (int j = 0; j < 9; ++j) tp[j] = ts[j]; }
                __syncthreads();
                S.tsp = tp; } S.init(ts[8], 2 * FE / 256, F.G, F.bx);
              pg8::EpiSwiglu E{WSP(bf16_t, WS_HID), FE};
              GEMM_CALL(F.lds, F.tid, g, S, E); LAUNDER(); if (GEMM_REPEAT) { GEMM_CALL(F.lds, F.tid, g, S, E); LAUNDER(); } }
            GRID_BAR(); LAUNDER();
            { pg8::Gemm g{WSP(bf16_t, WS_HID), WSP(bf16_t, WS_MDN) + (size_t)li * 8 * 1024 * FE, FE, FE, FE, 0, (size_t)1024 * FE};
              pg8::GroupOrder S; int ts[9]; moe_tile_starts(F, li, ts); { LAS int* tp = (LAS int*)(F.lds + LDS_MISC + 256);
                __syncthreads();
                if (F.tid == 0) {
#pragma unroll
                    for (int j = 0; j < 9; ++j) tp[j] = ts[j]; }
                __syncthreads();
                S.tsp = tp; } S.init(ts[8], 4, F.G, F.bx);
              pg8::EpiBf16Out E{WSP(bf16_t, WS_YP), 1024};
              GEMM_CALL(F.lds, F.tid, g, S, E); LAUNDER(); if (GEMM_REPEAT) { GEMM_CALL(F.lds, F.tid, g, S, E); LAUNDER(); } }
            GRID_BAR(); LAUNDER();
        }
        p12_postffn(F, p, l);
        GRID_BAR(); LAUNDER();
        if (stop == 2 * l + 2) return;
    }
}

extern "C" void kernel_launch(void* const* d_in, const int* in_sizes, int n_in, void* d_out, int out_size, void* d_ws, size_t ws_size, hipStream_t stream) {
    static int grid = 0;
    if (grid == 0) {
        if (n_in != 30 || out_size != NLAT * D || ws_size < WS_END) { fprintf(stderr, "kernel_launch: unexpected shapes (n_in %d out %d ws %zu, need ws >= %zu); nothing launched\n", n_in, out_size, ws_size, (size_t)WS_END); grid = -1; return; }
        int dev = 0, cus = 0, per_cu = 0;
        if (hipGetDevice(&dev) != hipSuccess || hipDeviceGetAttribute(&cus, hipDeviceAttributeMultiprocessorCount, dev) != hipSuccess) { grid = -1; return; }
        if (hipFuncSetAttribute((const void*)mk_fwd, hipFuncAttributeMaxDynamicSharedMemorySize, LDS_BYTES) != hipSuccess) { fprintf(stderr, "kernel_launch: hipFuncSetAttribute failed\n"); grid = -1; return; }
        if (hipOccupancyMaxActiveBlocksPerMultiprocessor(&per_cu, (const void*)mk_fwd, 512, LDS_BYTES) != hipSuccess || per_cu < 1)
            fprintf(stderr, "kernel_launch: occupancy query reports %d blocks per CU\n", per_cu);
        (void)hipGetLastError();
        grid = cus;
    }
    if (grid < 0) return;
    (void)hipMemsetAsync((char*)d_ws + WS_CTL, 0, CTL_BYTES, stream);
    Params p{};
    for (int i = 0; i < 30; ++i) p.in[i] = (const float*)d_in[i];
    p.out = (float*)d_out; p.ws = (unsigned char*)d_ws; p.stop_after = STOP_AFTER; p.pad = 0;
    hipLaunchKernelGGL(mk_fwd, dim3(grid), dim3(512), LDS_BYTES, stream, p);
}
```

```cpp
#include <hip/hip_runtime.h>
#include <cstdio>
#include <cstdint>


#define USE_SG32S 1
#define GEMM_REPEAT 0
#define CMLP_SCAN_SHARE 0
#define ATT_REPEAT 1

#define USE_SG 1
#define LDSZERO 1
#ifndef STOP_AFTER
#define STOP_AFTER 8
#endif

#define LAS __attribute__((address_space(3)))
#define GAS __attribute__((address_space(1)))
typedef unsigned short bf16_t;
typedef short bf16x8 __attribute__((ext_vector_type(8)));
typedef float f32x4 __attribute__((ext_vector_type(4)));
typedef float f32x16 __attribute__((ext_vector_type(16)));
typedef unsigned u32x4 __attribute__((ext_vector_type(4)));
typedef unsigned u32x2 __attribute__((ext_vector_type(2)));

constexpr int D = 1024, NB = 8, SEQ = 4096, CTXL = 256;
constexpr int NLAT = NB * SEQ, NCTX = NB * CTXL, MT = NLAT + NCTX, NKEY = CTXL + SEQ;
constexpr int PLD = 6912;
constexpr int PK = 0, PV = 128, PRKV = 256, PWLOW = 1792, PALOW = 1920, PGLOW = 2048, PQ = 2304, PUV = 2816, PGATE = 3840;
constexpr int FD = 2816, FE = 3584, NE = 8;
constexpr int INW = 6784;
constexpr int MOE_CAP_ROWS = 71680;
constexpr float EPS = 1e-6f;

constexpr size_t MiB = 1u << 20;
constexpr size_t WS_CTL = 0, CTL_BYTES = 1 * MiB;
constexpr size_t WS_MODV = 1 * MiB, WS_ROPE = 2 * MiB, WS_ROUTE = 3 * MiB, WS_PROW = 5 * MiB, WS_WCM = 6 * MiB, WS_WLORA = 8 * MiB;
constexpr size_t WS_WIN = 16 * MiB, WS_WBR = 70 * MiB, WS_WOUT = 82 * MiB, WS_WGU = 90 * MiB, WS_WDN = 112 * MiB, WS_MGU = 124 * MiB, WS_MDN = 348 * MiB;
constexpr size_t WS_XC = 460 * MiB, WS_H = 468 * MiB, WS_PROJ = 536 * MiB, WS_QN = 995 * MiB, WS_KN = 1029 * MiB, WS_VT = 1038 * MiB;
constexpr size_t WS_WDEC = 1047 * MiB, WS_AICLR = 1183 * MiB, WS_GG = 1251 * MiB, WS_YFB = 1285 * MiB, WS_OA = 1421 * MiB;
constexpr size_t WS_TMP = WS_WDEC, WS_YM = WS_AICLR, WS_OL = WS_YFB;
constexpr size_t WS_HID = 536 * MiB, WS_HPERM = 1026 * MiB, WS_YP = 1166 * MiB;
constexpr size_t WS_XB = 1523 * MiB;
constexpr size_t WS_END = 1591 * MiB;
constexpr size_t OABC_STRIDE = 34 * MiB / 2;
constexpr int CW_BAR = 4096, CW_MOE = 16384;

constexpr int LDS_BYTES = 147456, LDS_MISC = 131072;

struct Params { const float* in[30]; float* out; unsigned char* ws; int stop_after; int pad; };

__device__ __forceinline__ const float* inp(const Params& p, int k) { unsigned long long q = (unsigned long long)p.in[k]; asm volatile("" : "+s"(q)); return (const float*)(GAS const float*)q; }
__device__ __forceinline__ float* outp(const Params& p) { unsigned long long q = (unsigned long long)p.out; asm volatile("" : "+s"(q)); return (float*)(GAS float*)q; }
__device__ __forceinline__ int lane_id() { int l; asm volatile("v_mbcnt_lo_u32_b32 %0, -1, 0\n\tv_mbcnt_hi_u32_b32 %0, -1, %0" : "=v"(l)); return l; }
typedef __bf16 bf16x2_t __attribute__((ext_vector_type(2)));
typedef float f32x2_t __attribute__((ext_vector_type(2)));
__device__ __forceinline__ unsigned pk2(float lo, float hi) { f32x2_t v = {lo, hi}; bf16x2_t b = __builtin_convertvector(v, bf16x2_t); return __builtin_bit_cast(unsigned, b); }
__device__ __forceinline__ float bflo(unsigned u) { return __uint_as_float(u << 16); }
__device__ __forceinline__ float bfhi(unsigned u) { return __uint_as_float(u & 0xffff0000u); }
__device__ __forceinline__ float bf1(bf16_t b) { return __uint_as_float(((unsigned)b) << 16); }
__device__ __forceinline__ f32x4 unp4(u32x2 v) { return (f32x4){bflo(v.x), bfhi(v.x), bflo(v.y), bfhi(v.y)}; }
__device__ __forceinline__ float fexp2(float x) { return __builtin_amdgcn_exp2f(x); }
__device__ __forceinline__ float frcp(float x) { return __builtin_amdgcn_rcpf(x); }
__device__ __forceinline__ float frsq(float x) { return __builtin_amdgcn_rsqf(x); }
__device__ __forceinline__ float fsig(float x) { return frcp(1.f + fexp2(-1.44269504089f * x)); }
__device__ __forceinline__ float ftanh(float x) { return 2.f * fsig(2.f * x) - 1.f; }
__device__ __forceinline__ float fgelu(float x) { return x * fsig(1.5957691216f * (x + 0.044715f * x * x * x)); }
template <int CTRL> __device__ __forceinline__ float dppf(float v) { return __int_as_float(__builtin_amdgcn_update_dpp(0, __float_as_int(v), CTRL, 0xF, 0xF, true)); }
__device__ __forceinline__ float dpp_sum16(float v) {
    v += dppf<0xB1>(v); v += dppf<0x4E>(v); v += dppf<0x141>(v); v += dppf<0x140>(v); return v;
}
__device__ __forceinline__ float sum4(float v) { v += dppf<0xB1>(v); v += dppf<0x4E>(v); return v; }
__device__ __forceinline__ float sum8(float v) { v += dppf<0xB1>(v); v += dppf<0x4E>(v); v += dppf<0x141>(v); return v; }
__device__ __forceinline__ float rlf(float v, int l) { return __int_as_float(__builtin_amdgcn_readlane(__float_as_int(v), l)); }
__device__ __forceinline__ float wave_sum(float v) { v = dpp_sum16(v); return (rlf(v, 0) + rlf(v, 16)) + (rlf(v, 32) + rlf(v, 48)); }

#define XB_TMO      128
#define XB_XCNT(j)  (256  + 64 * (j))
#define XB_XSUB(j)  (1280 + 64 * (j))
#define XB_XGEN(j)  (2304 + 64 * (j))
#define XB_TOP      3328
#define XB_TOPGEN   3392
#define XCD_BAR_WORDS 3456
#define XB_SPIN_CAP (1u << 20)

__device__ __forceinline__ unsigned xb_ld(unsigned* p)              { return __hip_atomic_load(p, __ATOMIC_RELAXED, __HIP_MEMORY_SCOPE_AGENT); }
__device__ __forceinline__ unsigned xb_add(unsigned* p, unsigned v) { return __hip_atomic_fetch_add(p, v, __ATOMIC_RELAXED, __HIP_MEMORY_SCOPE_AGENT); }
__device__ __forceinline__ unsigned xb_xcc_id() { return (unsigned)__builtin_amdgcn_s_getreg((3 << 11) | 20) & 0xFu; }
#define XB_SPIN(cond, bar) do { unsigned _sp = 0; while (cond) { __builtin_amdgcn_s_sleep(1); \
    if ((++_sp & 255u) == 0u) { if (xb_ld(&(bar)[XB_TMO])) break; if (_sp > XB_SPIN_CAP) { atomicAdd(&(bar)[XB_TMO], 1u); break; } } } } while (0)

struct XcdBarrier { unsigned* bar; unsigned x; volatile LAS unsigned* st; };

__device__ __forceinline__ XcdBarrier xcd_barrier_post(unsigned* bar, volatile LAS unsigned* st) {
    XcdBarrier b; b.bar = bar; b.x = xb_xcc_id(); b.st = st;
    if (threadIdx.x == 0) (void)xb_add(&bar[XB_XCNT(b.x)], 1u);
    return b;
}
__device__ __forceinline__ void xcd_barrier_complete(unsigned* bar, unsigned x, unsigned& nloc, unsigned& nx) {
    const unsigned G = gridDim.x * gridDim.y * gridDim.z;
    unsigned sum, cnt, mine, sp = 0u;
    for (;;) {
        sum = 0u; cnt = 0u; mine = 0u;
#pragma unroll
        for (unsigned j = 0; j < 16; ++j) { const unsigned c = xb_ld(&bar[XB_XCNT(j)]); sum += c; cnt += (c > 0u) ? 1u : 0u; mine = (j == x) ? c : mine; }
        if (sum == G) break;
        __builtin_amdgcn_s_sleep(1);
        if ((++sp & 255u) == 0u) { if (xb_ld(&bar[XB_TMO])) break; if (sp > XB_SPIN_CAP) { atomicAdd(&bar[XB_TMO], 1u); break; } }
    }
    nloc = mine > 0u ? mine : 1u; nx = cnt > 0u ? cnt : 1u;
}
__device__ __forceinline__ void xcd_barrier(const XcdBarrier& b, const bool is_t0) {
    asm volatile("s_waitcnt vmcnt(0)" ::: "memory");
    __syncthreads();
    if (is_t0) {
        unsigned* bar = b.bar;
        __builtin_amdgcn_s_waitcnt(0);
        unsigned nloc = b.st[0], nx = b.st[1];
        if (nloc == 0u) { xcd_barrier_complete(bar, b.x, nloc, nx); b.st[0] = nloc; b.st[1] = nx; }
        const unsigned old = xb_add(&bar[XB_XSUB(b.x)], 1u);
        const unsigned gen = old / nloc;
        if (old + 1u == (gen + 1u) * nloc) {
            __builtin_amdgcn_fence(__ATOMIC_RELEASE, "agent");
            asm volatile("s_waitcnt vmcnt(0)" ::: "memory");
            const unsigned og = xb_add(&bar[XB_TOP], 1u);
            const unsigned tg = og / nx;
            if (og + 1u == (tg + 1u) * nx) xb_add(&bar[XB_TOPGEN], 1u);
            else XB_SPIN(xb_ld(&bar[XB_TOPGEN]) == tg, bar);
            __builtin_amdgcn_fence(__ATOMIC_ACQUIRE, "agent");
            xb_add(&bar[XB_XGEN(b.x)], 1u);
            asm volatile("s_waitcnt vmcnt(0)" ::: "memory");
        } else {
            XB_SPIN(xb_ld(&bar[XB_XGEN(b.x)]) == gen, bar);
            __builtin_amdgcn_fence(__ATOMIC_ACQUIRE, "agent");
            asm volatile("s_waitcnt vmcnt(0)" ::: "memory");
        }
    }
    __syncthreads();
}

namespace pg8 {
constexpr int BM = 256, BK = 64, HALF = 128, HTB = HALF * BK * 2, STAGE_BYTES = 8 * HTB, NXCD = 8, WGM = 8;
__host__ __device__ __forceinline__ int lds_byte(int r, int c) { const int st = (r >> 4) * 2 + (c >> 5), rr = r & 15, cc = c & 31, ob = rr * 64 + cc * 2; return st * 1024 + (ob ^ (((ob >> 9) & 1) << 5)); }
__host__ __device__ __forceinline__ void stage_rc(int b, int& R, int& C) { const int st = b / 1024, sb = b % 1024, swz = sb ^ (((sb >> 9) & 1) << 5); R = (st >> 1) * 16 + swz / 64; C = (st & 1) * 32 + (swz % 64) / 2; }
__host__ __device__ __forceinline__ int perm32(int rho) { const int n = rho >> 4, i = rho & 15; return 8 * (i >> 2) + 4 * n + (i & 3); }

struct Unit { int pm, pn, ga, gb; };
struct Gemm { const bf16_t* A; const bf16_t* Bt; int K, lda, ldb; size_t agstride, bgstride; };

struct StaticOrder {
    int nM, nN, nwg, G, c;
    __device__ void init(int nM_, int nN_, int G_, int c_) { nM = nM_; nN = nN_; nwg = nM * nN; G = G_; c = c_; }
    __device__ bool map(long L, Unit& u) const {
        if (L >= nwg) return false;
        int wgid = (int)L; { const int q = nwg / NXCD, r = nwg % NXCD, xcd = wgid % NXCD, off = wgid / NXCD; wgid = (xcd < r ? xcd * (q + 1) : r * (q + 1) + (xcd - r) * q) + off; }
        const int nig = WGM * nN, gid = wgid / nig, fm = gid * WGM, gsz = (nM - fm) < WGM ? (nM - fm) : WGM;
        u.pm = fm + ((wgid % nig) % gsz); u.pn = (wgid % nig) / gsz; u.ga = 0; u.gb = 0; return true;
    }
    __device__ bool next(int i, Unit& u) const { return map((long)i * G + c, u); }
    __device__ int kbeg(const Unit&) const { return 0; }
    __device__ int ksteps(const Unit&, int full) const { return full; }
};
struct InProjOrder {
    StaticOrder lat; int nlat, nctxN, ntot;
    __device__ void init2(int nMlat, int nMctx, int nN_, int nctxN_, int G_, int c_) { lat.init(nMlat, nN_, G_, c_); nlat = lat.nwg; nctxN = nctxN_; ntot = nlat + nMctx * nctxN_; }
    __device__ bool next(int i, Unit& u) const {
        const long Lx = (long)i * lat.G + lat.c;
        if (Lx >= ntot) return false;
        if (Lx < nlat) return lat.map(Lx, u);
        const int j = (int)(Lx - nlat); u.pm = lat.nM + j / nctxN; u.pn = j % nctxN; u.ga = 0; u.gb = 0; return true;
    }
    __device__ int kbeg(const Unit&) const { return 0; }
    __device__ int ksteps(const Unit&, int full) const { return full; }
};
struct LoraOrder : StaticOrder {
    __device__ int kbeg(const Unit& u) const { return u.pn < 8 ? 2 * (u.pn >> 1) : 8; }
    __device__ int ksteps(const Unit& u, int) const { return u.pn < 8 ? 2 : 4; }
};
struct MergeOrder : StaticOrder {
    __device__ bool next(int i, Unit& u) const { const int t = i / 3, br = i - 3 * t; if (!map((long)t * G + c, u)) return false; u.ga = br; u.gb = br; return true; }
};
struct GroupOrder : StaticOrder {
    const int* tsp;
    __device__ bool next(int i, Unit& u) const {
        if (!map((long)i * G + c, u)) return false;
        int e = 0;
#pragma unroll
        for (int j = 1; j < 8; ++j) e += (u.pm >= tsp[j]) ? 1 : 0;
        u.gb = __builtin_amdgcn_readfirstlane(e); return true;
    }
};

template <class Epi, class Sched>
__device__ __forceinline__ void gemm_phase(LAS unsigned char* lds, const int tid, const Gemm g, const Sched& S, const Epi& E) {
    const int wid = __builtin_amdgcn_readfirstlane(tid >> 6), lane = tid & 63, wr = wid >> 2, wc = wid & 3, fr = lane & 15, fq = lane >> 4;
    const int K = g.K, nt = K / BK;
    unsigned voffA[2], voffB[2];
#pragma unroll
    for (int i = 0; i < 2; ++i) { int R, C; stage_rc(tid * 16 + i * 8192, R, C); const int Rb = Epi::PERM ? ((R & ~31) + perm32(R & 31)) : R;
        voffA[i] = (unsigned)(R * g.lda + C) * 2u; voffB[i] = (unsigned)(Rb * g.ldb + C) * 2u; }
    const size_t kstep = (size_t)(BK * 2);
    const size_t hsA = (size_t)HALF * g.lda * 2, hsB = (size_t)HALF * g.ldb * 2;
    const size_t tsA = 2 * hsA, tsB = 2 * hsB;
    const unsigned ldsw = (unsigned)wid * 1024u;
    const int aoff = lds_byte(wr * 64 + fr, fq * 8), boff = lds_byte(wc * 32 + fr, fq * 8);
#define PG8_SA(b, h) (((b) * 2 + (h)) * HTB)
#define PG8_SB(b, h) ((4 + (b) * 2 + (h)) * HTB)
#define PG8_STAGE(bufoff, gbase, voff) do { _Pragma("unroll") for (int _i = 0; _i < 2; ++_i) \
        __builtin_amdgcn_global_load_lds((const unsigned*)((const char*)(gbase) + (voff)[_i]), (LAS unsigned*)(lds + (bufoff) + ldsw + _i * 8192), 16, 0, 0); } while (0)
#define PG8_LDA(dst, b, h) do { _Pragma("unroll") for (int m = 0; m < 4; ++m) _Pragma("unroll") for (int k = 0; k < 2; ++k) dst[m][k] = *(const LAS bf16x8*)(lds + PG8_SA(b, h) + aoff + m * 2048 + k * 1024); } while (0)
#define PG8_LDB(dst, b, h) do { _Pragma("unroll") for (int n = 0; n < 2; ++n) _Pragma("unroll") for (int k = 0; k < 2; ++k) dst[n][k] = *(const LAS bf16x8*)(lds + PG8_SB(b, h) + boff + n * 2048 + k * 1024); } while (0)
#define PG8_MMA(ai, bj, At, Bt) do { __builtin_amdgcn_s_setprio(1); _Pragma("unroll") for (int m = 0; m < 4; ++m) _Pragma("unroll") for (int n = 0; n < 2; ++n) _Pragma("unroll") for (int k = 0; k < 2; ++k) \
        acc[ai][bj][m][n] = __builtin_amdgcn_mfma_f32_16x16x32_bf16(Bt[n][k], At[m][k], acc[ai][bj][m][n], 0, 0, 0); __builtin_amdgcn_s_setprio(0); } while (0)
#define PG8_WAIT_V(n) asm volatile("s_waitcnt vmcnt(" #n ")" ::: "memory")
#define PG8_WAIT_L(n) asm volatile("s_waitcnt lgkmcnt(" #n ")" ::: "memory")
#define PG8_BAR __builtin_amdgcn_s_barrier()
#define PG8_SCHED __builtin_amdgcn_sched_barrier(0)
    Unit cur, nxt; int ui = 0;
    if (!S.next(0, cur)) return;
    f32x4 acc[2][2][4][2];
#pragma unroll
    for (int a = 0; a < 2; ++a)
#pragma unroll
        for (int b = 0; b < 2; ++b)
#pragma unroll
            for (int m = 0; m < 4; ++m)
#pragma unroll
                for (int n = 0; n < 2; ++n) acc[a][b][m][n] = (f32x4){0.f, 0.f, 0.f, 0.f};
    bf16x8 At[4][2], B0[2][2], B1[2][2];
    const char* cA = (const char*)g.A + ((size_t)cur.ga * g.agstride) * 2 + (size_t)cur.pm * tsA;
    const char* cB = (const char*)g.Bt + ((size_t)cur.gb * g.bgstride) * 2 + (size_t)cur.pn * tsB;
    PG8_STAGE(PG8_SB(0, 0), cB, voffB); PG8_STAGE(PG8_SA(0, 0), cA, voffA); PG8_STAGE(PG8_SB(0, 1), cB + hsB, voffB); PG8_STAGE(PG8_SA(0, 1), cA + hsA, voffA);
    if (wr == 1) PG8_BAR;
    PG8_WAIT_V(4); PG8_BAR;
    PG8_STAGE(PG8_SB(1, 0), cB + kstep, voffB); PG8_STAGE(PG8_SA(1, 0), cA + kstep, voffA); PG8_STAGE(PG8_SB(1, 1), cB + hsB + kstep, voffB);
    PG8_WAIT_V(6); PG8_BAR;
    for (;;) {
        const bool has_next = S.next(ui + 1, nxt);
        const char* nA = has_next ? (const char*)g.A + ((size_t)nxt.ga * g.agstride) * 2 + (size_t)nxt.pm * tsA : cA;
        const char* nB = has_next ? (const char*)g.Bt + ((size_t)nxt.gb * g.bgstride) * 2 + (size_t)nxt.pn * tsB : cB;
        for (int t = 0; t < nt; t += 2) {
            const bool last = (t == nt - 2);
            const char* a1 = cA + (size_t)(t + 1) * kstep;
            const char* a2 = last ? nA : cA + (size_t)(t + 2) * kstep; const char* b2 = last ? nB : cB + (size_t)(t + 2) * kstep;
            const char* a3 = a2 + kstep; const char* b3 = b2 + kstep;
            PG8_LDB(B0, 0, 0); PG8_SCHED; PG8_LDA(At, 0, 0); PG8_STAGE(PG8_SA(1, 1), a1 + hsA, voffA);
            PG8_WAIT_L(8); PG8_BAR; PG8_WAIT_L(0); PG8_MMA(0, 0, At, B0); PG8_BAR; PG8_SCHED;
            PG8_LDB(B1, 0, 1); PG8_STAGE(PG8_SB(0, 0), b2, voffB);
            PG8_BAR; PG8_WAIT_L(0); PG8_MMA(0, 1, At, B1); PG8_BAR;
            PG8_LDA(At, 0, 1); PG8_STAGE(PG8_SA(0, 0), a2, voffA);
            PG8_BAR; PG8_WAIT_L(0); PG8_MMA(1, 0, At, B0); PG8_BAR; PG8_SCHED;
            PG8_STAGE(PG8_SB(0, 1), b2 + hsB, voffB);
            PG8_WAIT_V(6); PG8_BAR; PG8_MMA(1, 1, At, B1); PG8_BAR;
            PG8_LDB(B0, 1, 0); PG8_SCHED; PG8_LDA(At, 1, 0); PG8_STAGE(PG8_SA(0, 1), a2 + hsA, voffA);
            PG8_WAIT_L(8); PG8_BAR; PG8_WAIT_L(0); PG8_MMA(0, 0, At, B0); PG8_BAR; PG8_SCHED;
            PG8_LDB(B1, 1, 1); PG8_STAGE(PG8_SB(1, 0), b3, voffB);
            PG8_BAR; PG8_WAIT_L(0); PG8_MMA(0, 1, At, B1); PG8_BAR;
            PG8_LDA(At, 1, 1); PG8_STAGE(PG8_SA(1, 0), a3, voffA);
            PG8_BAR; PG8_WAIT_L(0); PG8_MMA(1, 0, At, B0); PG8_BAR; PG8_SCHED;
            PG8_STAGE(PG8_SB(1, 1), b3 + hsB, voffB);
            PG8_WAIT_V(6); PG8_BAR; PG8_MMA(1, 1, At, B1); PG8_BAR;
        }
        { const int l2 = lane_id(); E(acc, cur, wr, wc, l2 & 15, l2 >> 4); }
        if (!has_next) break;
#pragma unroll
        for (int a = 0; a < 2; ++a)
#pragma unroll
            for (int b = 0; b < 2; ++b)
#pragma unroll
                for (int m = 0; m < 4; ++m)
#pragma unroll
                    for (int n = 0; n < 2; ++n) acc[a][b][m][n] = (f32x4){0.f, 0.f, 0.f, 0.f};
        cur = nxt; cA = nA; cB = nB; ++ui;
    }
    PG8_WAIT_V(0);
    if (wr == 0) PG8_BAR;
    PG8_BAR;
#undef PG8_SA
#undef PG8_SB
#undef PG8_STAGE
#undef PG8_LDA
#undef PG8_LDB
#undef PG8_MMA
#undef PG8_WAIT_V
#undef PG8_WAIT_L
#undef PG8_BAR
#undef PG8_SCHED
}


template <class Epi, class Sched>
__device__ __forceinline__ void gemm_simple(LAS unsigned char* lds, const int tid, const Gemm g, const Sched& S, const Epi& E) {
    const int wid = __builtin_amdgcn_readfirstlane(tid >> 6), lane = tid & 63, wr = wid >> 2, wc = wid & 3, fr = lane & 15, fq = lane >> 4;
    const int nt = g.K / 64, lrow = tid >> 3, lch = tid & 7;
    LAS unsigned char* As = lds; LAS unsigned char* Bs = lds + 36864;
    unsigned offA[4], offB[4];
#pragma unroll
    for (int i = 0; i < 4; ++i) { const int slot = lrow + 64 * i; const int br = Epi::PERM ? ((slot & ~31) + perm32(slot & 31)) : slot;
        offA[i] = (unsigned)(slot * g.lda + lch * 8) * 2u; offB[i] = (unsigned)(br * g.ldb + lch * 8) * 2u; }
    const unsigned wofs = (unsigned)(lrow * 144 + lch * 16);
    const unsigned aofs = (unsigned)((64 * wr + fr) * 144 + fq * 16), bofs = (unsigned)((32 * wc + fr) * 144 + fq * 16);
    Unit u;
    for (int ui = 0; S.next(ui, u); ++ui) {
        const char* Ab = (const char*)g.A + ((size_t)u.ga * g.agstride + (size_t)u.pm * 256 * g.lda) * 2;
        const char* Bb = (const char*)g.Bt + ((size_t)u.gb * g.bgstride + (size_t)u.pn * 256 * g.ldb) * 2;
        f32x4 acc[2][2][4][2];
#pragma unroll
        for (int a = 0; a < 2; ++a)
#pragma unroll
            for (int b = 0; b < 2; ++b)
#pragma unroll
                for (int m = 0; m < 4; ++m)
#pragma unroll
                    for (int n = 0; n < 2; ++n) acc[a][b][m][n] = (f32x4){0.f, 0.f, 0.f, 0.f};
        u32x4 ra[4], rb[4];
#pragma unroll
        for (int i = 0; i < 4; ++i) { ra[i] = *(const u32x4*)(Ab + offA[i]); rb[i] = *(const u32x4*)(Bb + offB[i]); }
        for (int t = 0; t < nt; ++t) {
            if (t > 0) __syncthreads();
#pragma unroll
            for (int i = 0; i < 4; ++i) { *(LAS u32x4*)(As + wofs + i * 9216) = ra[i]; *(LAS u32x4*)(Bs + wofs + i * 9216) = rb[i]; }
            __syncthreads();
            if (t + 1 < nt) { const char* An = Ab + (size_t)(t + 1) * 128; const char* Bn = Bb + (size_t)(t + 1) * 128;
#pragma unroll
                for (int i = 0; i < 4; ++i) { ra[i] = *(const u32x4*)(An + offA[i]); rb[i] = *(const u32x4*)(Bn + offB[i]); } }
#pragma unroll 1
            for (int kk = 0; kk < 2; ++kk) {
                bf16x8 Bf[2][2];
#pragma unroll
                for (int bj = 0; bj < 2; ++bj)
#pragma unroll
                    for (int n = 0; n < 2; ++n) Bf[bj][n] = *(const LAS bf16x8*)(Bs + bofs + (128 * bj + 16 * n) * 144 + kk * 64);
#pragma unroll
                for (int ai = 0; ai < 2; ++ai) {
                    bf16x8 Af[4];
#pragma unroll
                    for (int m = 0; m < 4; ++m) Af[m] = *(const LAS bf16x8*)(As + aofs + (128 * ai + 16 * m) * 144 + kk * 64);
#pragma unroll
                    for (int m = 0; m < 4; ++m)
#pragma unroll
                        for (int bj = 0; bj < 2; ++bj)
#pragma unroll
                            for (int n = 0; n < 2; ++n) acc[ai][bj][m][n] = __builtin_amdgcn_mfma_f32_16x16x32_bf16(Bf[bj][n], Af[m], acc[ai][bj][m][n], 0, 0, 0);
                }
            }
        }
        { const int l2 = lane_id(); E(acc, u, wr, wc, l2 & 15, l2 >> 4); }
        __syncthreads();
    }
}

template <class Epi, class Sched>
__device__ __forceinline__ void gemm_sg32(LAS unsigned char* lds, const int tid, const Gemm g, const Sched& S, const Epi& E) {
    const int wid = __builtin_amdgcn_readfirstlane(tid >> 6), lane = tid & 63, wr = wid >> 2, wc = wid & 3, fr = lane & 15, fq = lane >> 4;
    const int nt = g.K / 32, lrow = tid >> 2, lch = tid & 3;
    LAS unsigned char* As = lds; LAS unsigned char* Bs = lds + 20480;
    unsigned offA[2], offB[2];
#pragma unroll
    for (int i = 0; i < 2; ++i) { const int slot = lrow + 128 * i; const int br = Epi::PERM ? ((slot & ~31) + perm32(slot & 31)) : slot;
        offA[i] = (unsigned)(slot * g.lda + lch * 8) * 2u; offB[i] = (unsigned)(br * g.ldb + lch * 8) * 2u; }
    const unsigned wofs = (unsigned)(lrow * 80 + lch * 16);
    const unsigned aofs = (unsigned)((64 * wr + fr) * 80 + fq * 16), bofs = (unsigned)((32 * wc + fr) * 80 + fq * 16);
    Unit u;
    for (int ui = 0; S.next(ui, u); ++ui) {
        const char* Ab = (const char*)g.A + ((size_t)u.ga * g.agstride + (size_t)u.pm * 256 * g.lda) * 2;
        const char* Bb = (const char*)g.Bt + ((size_t)u.gb * g.bgstride + (size_t)u.pn * 256 * g.ldb) * 2;
        f32x4 acc[2][2][4][2];
#pragma unroll
        for (int a = 0; a < 2; ++a)
#pragma unroll
            for (int b = 0; b < 2; ++b)
#pragma unroll
                for (int m = 0; m < 4; ++m)
#pragma unroll
                    for (int n = 0; n < 2; ++n) acc[a][b][m][n] = (f32x4){0.f, 0.f, 0.f, 0.f};
        u32x4 ra[2], rb[2];
#pragma unroll
        for (int i = 0; i < 2; ++i) { ra[i] = *(const u32x4*)(Ab + offA[i]); rb[i] = *(const u32x4*)(Bb + offB[i]); }
#pragma unroll 1
        for (int t = 0; t < nt; ++t) {
            if (t > 0) __syncthreads();
#pragma unroll
            for (int i = 0; i < 2; ++i) { *(LAS u32x4*)(As + wofs + i * 10240) = ra[i]; *(LAS u32x4*)(Bs + wofs + i * 10240) = rb[i]; }
            __syncthreads();
            if (t + 1 < nt) { const char* An = Ab + (size_t)(t + 1) * 64; const char* Bn = Bb + (size_t)(t + 1) * 64;
#pragma unroll
                for (int i = 0; i < 2; ++i) { ra[i] = *(const u32x4*)(An + offA[i]); rb[i] = *(const u32x4*)(Bn + offB[i]); } }
            bf16x8 Bf[2][2];
#pragma unroll
            for (int bj = 0; bj < 2; ++bj)
#pragma unroll
                for (int n = 0; n < 2; ++n) Bf[bj][n] = *(const LAS bf16x8*)(Bs + bofs + (128 * bj + 16 * n) * 80);
#pragma unroll
            for (int ai = 0; ai < 2; ++ai) {
                bf16x8 Af[4];
#pragma unroll
                for (int m = 0; m < 4; ++m) Af[m] = *(const LAS bf16x8*)(As + aofs + (128 * ai + 16 * m) * 80);
#pragma unroll
                for (int m = 0; m < 4; ++m)
#pragma unroll
                    for (int bj = 0; bj < 2; ++bj)
#pragma unroll
                        for (int n = 0; n < 2; ++n) acc[ai][bj][m][n] = __builtin_amdgcn_mfma_f32_16x16x32_bf16(Bf[bj][n], Af[m], acc[ai][bj][m][n], 0, 0, 0);
            }
        }
        { const int l2 = lane_id(); E(acc, u, wr, wc, l2 & 15, l2 >> 4); }
        __syncthreads();
    }
}

template <class Epi, class Sched>
__device__ __forceinline__ void gemm_sg32d(LAS unsigned char* lds, const int tid, const Gemm g, const Sched& S, const Epi& E) {
    const int wid = __builtin_amdgcn_readfirstlane(tid >> 6), lane = tid & 63, wr = wid >> 2, wc = wid & 3, fr = lane & 15, fq = lane >> 4;
    const int nt = g.K / 32, lrow = tid >> 2, lch = tid & 3;
    unsigned offA[2], offB[2];
#pragma unroll
    for (int i = 0; i < 2; ++i) { const int slot = lrow + 128 * i; const int br = Epi::PERM ? ((slot & ~31) + perm32(slot & 31)) : slot;
        offA[i] = (unsigned)(slot * g.lda + lch * 8) * 2u; offB[i] = (unsigned)(br * g.ldb + lch * 8) * 2u; }
    const unsigned wofs = (unsigned)(lrow * 64 + ((lch ^ ((lrow >> 2) & 3)) * 16));
    const unsigned sw = (unsigned)((fq ^ ((fr >> 2) & 3)) * 16);
    const unsigned aofs = (unsigned)((64 * wr + fr) * 64) + sw, bofs = 16384u + (unsigned)((32 * wc + fr) * 64) + sw;
    Unit u;
    for (int ui = 0; S.next(ui, u); ++ui) {
        const char* Ab = (const char*)g.A + ((size_t)u.ga * g.agstride + (size_t)u.pm * 256 * g.lda) * 2;
        const char* Bb = (const char*)g.Bt + ((size_t)u.gb * g.bgstride + (size_t)u.pn * 256 * g.ldb) * 2;
        f32x4 acc[2][2][4][2];
#pragma unroll
        for (int a = 0; a < 2; ++a)
#pragma unroll
            for (int b = 0; b < 2; ++b)
#pragma unroll
                for (int m = 0; m < 4; ++m)
#pragma unroll
                    for (int n = 0; n < 2; ++n) acc[a][b][m][n] = (f32x4){0.f, 0.f, 0.f, 0.f};
        u32x4 ra[2], rb[2];
#pragma unroll
        for (int i = 0; i < 2; ++i) { ra[i] = *(const u32x4*)(Ab + offA[i]); rb[i] = *(const u32x4*)(Bb + offB[i]); }
#pragma unroll
        for (int i = 0; i < 2; ++i) { *(LAS u32x4*)(lds + wofs + i * 8192) = ra[i]; *(LAS u32x4*)(lds + 16384 + wofs + i * 8192) = rb[i]; }
        if (nt > 1) {
#pragma unroll
            for (int i = 0; i < 2; ++i) { ra[i] = *(const u32x4*)(Ab + 64 + offA[i]); rb[i] = *(const u32x4*)(Bb + 64 + offB[i]); } }
        __syncthreads();
#pragma unroll 1
        for (int t = 0; t < nt; ++t) {
            LAS unsigned char* cur = lds + (t & 1) * 32768;
            bf16x8 Bf[2][2], Af[2][4];
#pragma unroll
            for (int bj = 0; bj < 2; ++bj)
#pragma unroll
                for (int n = 0; n < 2; ++n) Bf[bj][n] = *(const LAS bf16x8*)(cur + bofs + (128 * bj + 16 * n) * 64);
#pragma unroll
            for (int ai = 0; ai < 2; ++ai)
#pragma unroll
                for (int m = 0; m < 4; ++m) Af[ai][m] = *(const LAS bf16x8*)(cur + aofs + (128 * ai + 16 * m) * 64);
            __builtin_amdgcn_sched_barrier(0);
            if (t + 1 < nt) {
                LAS unsigned char* nxt = lds + ((t + 1) & 1) * 32768;
#pragma unroll
                for (int i = 0; i < 2; ++i) { *(LAS u32x4*)(nxt + wofs + i * 8192) = ra[i]; *(LAS u32x4*)(nxt + 16384 + wofs + i * 8192) = rb[i]; }
                if (t + 2 < nt) { const char* An = Ab + (size_t)(t + 2) * 64; const char* Bn = Bb + (size_t)(t + 2) * 64;
#pragma unroll
                    for (int i = 0; i < 2; ++i) { ra[i] = *(const u32x4*)(An + offA[i]); rb[i] = *(const u32x4*)(Bn + offB[i]); } }
            }
            __builtin_amdgcn_sched_barrier(0);
#pragma unroll
            for (int ai = 0; ai < 2; ++ai)
#pragma unroll
                for (int m = 0; m < 4; ++m)
#pragma unroll
                    for (int bj = 0; bj < 2; ++bj)
#pragma unroll
                        for (int n = 0; n < 2; ++n) acc[ai][bj][m][n] = __builtin_amdgcn_mfma_f32_16x16x32_bf16(Bf[bj][n], Af[ai][m], acc[ai][bj][m][n], 0, 0, 0);
            __syncthreads();
        }
        { const int l2 = lane_id(); E(acc, u, wr, wc, l2 & 15, l2 >> 4); }
    }
}

template <class Epi, class Sched>
__device__ __forceinline__ void gemm_sg32s(LAS unsigned char* lds, const int tid, const Gemm g, const Sched& S, const Epi& E) {
    const int wid = __builtin_amdgcn_readfirstlane(tid >> 6), lane = tid & 63, wr = wid >> 2, wc = wid & 3, fr = lane & 15, fq = lane >> 4;
    const int ntfull = g.K / 32, lrow = tid >> 2, lch = tid & 3;
    const int br0 = Epi::PERM ? ((lrow & ~31) + perm32(lrow & 31)) : lrow;
    const int offA = (lrow * g.lda + lch * 8) * 2, offB = (br0 * g.ldb + lch * 8) * 2;
    const int dA = 128 * g.lda * 2, dB = 128 * g.ldb * 2;
    const unsigned wofs = (unsigned)(lrow * 64 + ((lch ^ ((0x78 >> (2 * ((lrow >> 2) & 3))) & 3)) * 16));
    const unsigned sw = (unsigned)((fq ^ ((0x78 >> (2 * ((fr >> 2) & 3))) & 3)) * 16);
    const unsigned frsw = (unsigned)(fr * 64) + sw; const int aofs = wr * 4096, bofs = 16384 + wc * 2048;
#define SGS_BAR() do { asm volatile("s_waitcnt lgkmcnt(0)" ::: "memory"); __builtin_amdgcn_s_barrier(); asm volatile("" ::: "memory"); } while (0)
#define SGS_LOAD(RA, RB, TT) do { const int _so = (TT) * 64; \
        RA[0] = __builtin_amdgcn_raw_buffer_load_b128(rsA, offA, _so, 0); RB[0] = __builtin_amdgcn_raw_buffer_load_b128(rsB, offB, _so, 0); \
        RA[1] = __builtin_amdgcn_raw_buffer_load_b128(rsA, offA, _so + dA, 0); RB[1] = __builtin_amdgcn_raw_buffer_load_b128(rsB, offB, _so + dB, 0); } while (0)
#define SGS_WRITE(RA, RB, BUFP) do { _Pragma("unroll") for (int i = 0; i < 2; ++i) { *(LAS u32x4*)((BUFP) + wofs + i * 8192) = RA[i]; *(LAS u32x4*)((BUFP) + 16384 + wofs + i * 8192) = RB[i]; } } while (0)
#define SGS_LDSPHASE(TT, RA, RB) do { \
            LAS unsigned char* cur = lds + ((TT) & 1) * 32768; \
            _Pragma("unroll") for (int bj = 0; bj < 2; ++bj) _Pragma("unroll") for (int n = 0; n < 2; ++n) Bf[bj][n] = *(const LAS bf16x8*)((cur + bofs) + frsw + (128 * bj + 16 * n) * 64); \
            _Pragma("unroll") for (int ai = 0; ai < 2; ++ai) _Pragma("unroll") for (int m = 0; m < 4; ++m) Af[ai][m] = *(const LAS bf16x8*)((cur + aofs) + frsw + (128 * ai + 16 * m) * 64); \
            if ((TT) + 1 < nt) { SGS_WRITE(RA, RB, lds + (((TT) + 1) & 1) * 32768); if ((TT) + 3 < nt) SGS_LOAD(RA, RB, (TT) + 3); } } while (0)
#define SGS_MMA() do { __builtin_amdgcn_sched_barrier(0); \
            _Pragma("unroll") for (int ai = 0; ai < 2; ++ai) _Pragma("unroll") for (int m = 0; m < 4; ++m) _Pragma("unroll") for (int bj = 0; bj < 2; ++bj) _Pragma("unroll") for (int n = 0; n < 2; ++n) \
                acc[ai][bj][m][n] = __builtin_amdgcn_mfma_f32_16x16x32_bf16(Bf[bj][n], Af[ai][m], acc[ai][bj][m][n], 0, 0, 0); \
            __builtin_amdgcn_sched_barrier(0); } while (0)
    Unit u;
    for (int ui = 0; S.next(ui, u); ++ui) {
        const int nt = S.ksteps(u, ntfull), kb = S.kbeg(u);
        const char* Ab = (const char*)g.A + ((size_t)u.ga * g.agstride + (size_t)u.pm * 256 * g.lda + (size_t)kb * 32) * 2;
        const char* Bb = (const char*)g.Bt + ((size_t)u.gb * g.bgstride + (size_t)u.pn * 256 * g.ldb + (size_t)kb * 32) * 2;
        f32x4 acc[2][2][4][2];
#pragma unroll
        for (int a = 0; a < 2; ++a)
#pragma unroll
            for (int b = 0; b < 2; ++b)
#pragma unroll
                for (int m = 0; m < 4; ++m)
#pragma unroll
                    for (int n = 0; n < 2; ++n) acc[a][b][m][n] = (f32x4){0.f, 0.f, 0.f, 0.f};
        u32x4 ra0[2], rb0[2], ra1[2], rb1[2];
        bf16x8 Bf[2][2], Af[2][4];
        int rs_nr = 0x7fffffff, rs_fl = 0x00020000; asm volatile("" : "+s"(rs_nr), "+s"(rs_fl));
        const __amdgpu_buffer_rsrc_t rsA = __builtin_amdgcn_make_buffer_rsrc((void*)Ab, 0, rs_nr, rs_fl);
        const __amdgpu_buffer_rsrc_t rsB = __builtin_amdgcn_make_buffer_rsrc((void*)Bb, 0, rs_nr, rs_fl);
        SGS_LOAD(ra0, rb0, 0);
        SGS_LOAD(ra1, rb1, 1);
        SGS_WRITE(ra0, rb0, lds);
        if (nt > 2) SGS_LOAD(ra0, rb0, 2);
        SGS_BAR();
        if (wr == 0) {
#pragma unroll 1
            for (int t = 0; t < nt; t += 2) {
                SGS_LDSPHASE(t, ra1, rb1); SGS_BAR(); SGS_MMA(); SGS_BAR();
                SGS_LDSPHASE(t + 1, ra0, rb0); SGS_BAR(); SGS_MMA(); SGS_BAR();
            }
        } else {
#pragma unroll 1
            for (int t = 0; t < nt; t += 2) {
                if (t > 0) SGS_MMA();
                SGS_BAR(); SGS_LDSPHASE(t, ra1, rb1); SGS_BAR();
                SGS_MMA();
                SGS_BAR(); SGS_LDSPHASE(t + 1, ra0, rb0); SGS_BAR();
            }
            SGS_MMA();
        }
        { const int l2 = lane_id(); E(acc, u, wr, wc, l2 & 15, l2 >> 4); }
    }
#undef SGS_BAR
#undef SGS_LOAD
#undef SGS_WRITE
#undef SGS_LDSPHASE
#undef SGS_MMA
}

template <class Epi, class Sched>
__device__ __forceinline__ void gemm_nolds(LAS unsigned char* lds, const int tid, const Gemm g, const Sched& S, const Epi& E) {
    const int wid = __builtin_amdgcn_readfirstlane(tid >> 6), lane = tid & 63, wr = wid >> 2, wc = wid & 3, fr = lane & 15, fq = lane >> 4;
    const int nt = g.K / 32;
    Unit u;
    for (int ui = 0; S.next(ui, u); ++ui) {
        const bf16_t* Ab = g.A + (size_t)u.ga * g.agstride + (size_t)u.pm * 256 * g.lda + fq * 8;
        const bf16_t* Bb = g.Bt + (size_t)u.gb * g.bgstride + (size_t)u.pn * 256 * g.ldb + fq * 8;
        f32x4 acc[2][2][4][2];
#pragma unroll
        for (int a = 0; a < 2; ++a)
#pragma unroll
            for (int b = 0; b < 2; ++b)
#pragma unroll
                for (int m = 0; m < 4; ++m)
#pragma unroll
                    for (int n = 0; n < 2; ++n) acc[a][b][m][n] = (f32x4){0.f, 0.f, 0.f, 0.f};
#pragma unroll 1
        for (int t = 0; t < nt; ++t) {
            bf16x8 Bf[2][2];
#pragma unroll
            for (int bj = 0; bj < 2; ++bj)
#pragma unroll
                for (int n = 0; n < 2; ++n) { const int slot = 128 * bj + 32 * wc + 16 * n + fr; const int br = Epi::PERM ? ((slot & ~31) + perm32(slot & 31)) : slot;
                    Bf[bj][n] = *(const bf16x8*)(Bb + (size_t)br * g.ldb + t * 32); }
#pragma unroll
            for (int ai = 0; ai < 2; ++ai) {
                bf16x8 Af[4];
#pragma unroll
                for (int m = 0; m < 4; ++m) Af[m] = *(const bf16x8*)(Ab + (size_t)(128 * ai + 64 * wr + 16 * m + fr) * g.lda + t * 32);
#pragma unroll
                for (int m = 0; m < 4; ++m)
#pragma unroll
                    for (int bj = 0; bj < 2; ++bj)
#pragma unroll
                        for (int n = 0; n < 2; ++n) acc[ai][bj][m][n] = __builtin_amdgcn_mfma_f32_16x16x32_bf16(Bf[bj][n], Af[m], acc[ai][bj][m][n], 0, 0, 0);
            }
        }
        { const int l2 = lane_id(); E(acc, u, wr, wc, l2 & 15, l2 >> 4); }
    }
}

typedef const f32x4 (&AccRef)[2][2][4][2];

enum { ACT_NONE = 0, ACT_TANH = 1, ACT_SIG = 2, ACT_GELU = 3 };
template <int ACT> __device__ __forceinline__ float actf(float x) {
    if (ACT == ACT_TANH) return ftanh(x);
    if (ACT == ACT_SIG) return fsig(x);
    if (ACT == ACT_GELU) return fgelu(x);
    return x;
}
template <int ACT> __device__ __forceinline__ u32x4 act_pack(f32x4 v0, f32x4 v1) {
    u32x4 w;
    w.x = pk2(actf<ACT>(v0[0]), actf<ACT>(v0[1])); w.y = pk2(actf<ACT>(v0[2]), actf<ACT>(v0[3]));
    w.z = pk2(actf<ACT>(v1[0]), actf<ACT>(v1[1])); w.w = pk2(actf<ACT>(v1[2]), actf<ACT>(v1[3]));
    return w;
}
constexpr int EPS_OFF = 65536;
struct EpiTr {
    LAS unsigned char* w; int rd, wr_;
    __device__ __forceinline__ EpiTr(int wave, int fr, int fq) {
        LAS unsigned char* base = (LAS unsigned char*)(size_t)0; asm volatile("" : "+v"(base));
        w = base + EPS_OFF + wave * 1024; const int L = fq * 16 + fr, r = L >> 2, c = L & 3;
        wr_ = fr * 64 + (((fq + (fr >> 2)) & 3) * 16); rd = r * 64 + (((c + (r >> 2)) & 3) * 16);
    }
    __device__ __forceinline__ u32x4 operator()(u32x4 v) const { *(LAS u32x4*)(w + wr_) = v; return *(const LAS u32x4*)(w + rd); }
};
struct EpiProj {
    static constexpr bool PERM = true;
    bf16_t* P;
    template <int A0, int A1> __device__ __forceinline__ void store(AccRef acc, const Unit& u, int wr, int wc, int fr, int fq) const {
        const EpiTr T(wr * 4 + wc, fr, fq); const int L = fq * 16 + fr;
        const int row0 = u.pm * BM + wr * 64 + (L >> 2), col0 = u.pn * BM + wc * 32 + 8 * (L & 3);
#pragma unroll
        for (int ai = 0; ai < 2; ++ai)
#pragma unroll
            for (int m = 0; m < 4; ++m) { bf16_t* rowp = P + (size_t)(row0 + ai * HALF + m * 16) * PLD + col0;
                __builtin_nontemporal_store(T(act_pack<A0>(acc[ai][0][m][0], acc[ai][0][m][1])), (u32x4*)(rowp));
                __builtin_nontemporal_store(T(act_pack<A1>(acc[ai][1][m][0], acc[ai][1][m][1])), (u32x4*)(rowp + HALF)); }
    }
    __device__ __forceinline__ void operator()(AccRef acc, const Unit& u, int wr, int wc, int fr, int fq) const {
        const int pn = u.pn;
        if (pn == 7) store<ACT_TANH, ACT_NONE>(acc, u, wr, wc, fr, fq);
        else if (pn == 8) store<ACT_SIG, ACT_NONE>(acc, u, wr, wc, fr, fq);
        else if (pn >= 11 && pn < 15) store<ACT_GELU, ACT_GELU>(acc, u, wr, wc, fr, fq);
        else if (pn >= 15) store<ACT_SIG, ACT_SIG>(acc, u, wr, wc, fr, fq);
        else store<ACT_NONE, ACT_NONE>(acc, u, wr, wc, fr, fq);
    }
};
struct EpiLora {
    static constexpr bool PERM = true;
    bf16_t* WDEC; bf16_t* AICLR; bf16_t* GG; const float* w0; const float* a0;
    __device__ __forceinline__ void operator()(AccRef acc, const Unit& u, int wr, int wc, int fr, int fq) const {
        const EpiTr T(wr * 4 + wc, fr, fq); const int L = fq * 16 + fr;
        const int rowT = u.pm * BM + wr * 64 + (L >> 2), pn = u.pn;
#pragma unroll
        for (int bj = 0; bj < 2; ++bj) {
            const int n0 = pn * BM + bj * HALF + wc * 32 + 8 * fq;
            const int nT = pn * BM + bj * HALF + wc * 32 + 8 * (L & 3);
            if (pn < 4) {
                const f32x4 b0 = *(const f32x4*)(w0 + n0), b1 = *(const f32x4*)(w0 + n0 + 4);
#pragma unroll
                for (int ai = 0; ai < 2; ++ai)
#pragma unroll
                    for (int m = 0; m < 4; ++m) { bf16_t* rp = WDEC + (size_t)(rowT + ai * HALF + m * 16) * 1024 + nT;
                        f32x4 x0 = acc[ai][bj][m][0] + b0, x1 = acc[ai][bj][m][1] + b1, o0, o1;
#pragma unroll
                        for (int j = 0; j < 4; ++j) { o0[j] = -0.8750375f * fsig(x0[j]); o1[j] = -0.8750375f * fsig(x1[j]); }
                        *(u32x4*)rp = T(act_pack<ACT_NONE>(o0, o1)); }
            } else if (pn < 8) {
                const int n1 = n0 - 1024;
                const f32x4 b0 = *(const f32x4*)(a0 + n1), b1 = *(const f32x4*)(a0 + n1 + 4);
#pragma unroll
                for (int ai = 0; ai < 2; ++ai)
#pragma unroll
                    for (int m = 0; m < 4; ++m) { bf16_t* rp = AICLR + (size_t)(rowT + ai * HALF + m * 16) * 1024 + (nT - 1024);
                        *(u32x4*)rp = T(act_pack<ACT_SIG>(acc[ai][bj][m][0] + b0, acc[ai][bj][m][1] + b1)); }
            } else {
#pragma unroll
                for (int ai = 0; ai < 2; ++ai)
#pragma unroll
                    for (int m = 0; m < 4; ++m) { bf16_t* rp = GG + (size_t)(rowT + ai * HALF + m * 16) * 512 + (nT - 2048);
                        *(u32x4*)rp = T(act_pack<ACT_NONE>(acc[ai][bj][m][0], acc[ai][bj][m][1])); }
            }
        }
    }
};
struct EpiMerge {
    static constexpr bool PERM = true;
    const bf16_t* P; bf16_t* TMP; bf16_t* YM;
    __device__ __forceinline__ void operator()(AccRef acc, const Unit& u, int wr, int wc, int fr, int fq) const {
        const EpiTr T(wr * 4 + wc, fr, fq); const int L = fq * 16 + fr;
        const int rowT = u.pm * BM + wr * 64 + (L >> 2), br = u.gb;
#pragma unroll
        for (int ai = 0; ai < 2; ++ai)
#pragma unroll
            for (int m = 0; m < 4; ++m) {
                const int rT = rowT + ai * HALF + m * 16;
#pragma unroll
                for (int bj = 0; bj < 2; ++bj) {
                    const int cT = u.pn * BM + bj * HALF + wc * 32 + 8 * (L & 3);
                    const u32x4 gw = *(const u32x4*)(P + (size_t)rT * PLD + PGATE + br * 1024 + cT);
                    const u32x4 pa = T(act_pack<ACT_NONE>(acc[ai][bj][m][0], acc[ai][bj][m][1]));
                    float v[8] = {bflo(pa.x) * bflo(gw.x), bfhi(pa.x) * bfhi(gw.x), bflo(pa.y) * bflo(gw.y), bfhi(pa.y) * bfhi(gw.y),
                                  bflo(pa.z) * bflo(gw.z), bfhi(pa.z) * bfhi(gw.z), bflo(pa.w) * bflo(gw.w), bfhi(pa.w) * bfhi(gw.w)};
                    bf16_t* tp = TMP + (size_t)rT * 1024 + cT;
                    if (br != 0) {
                        const u32x4 t = *(const u32x4*)tp;
                        v[0] += bflo(t.x); v[1] += bfhi(t.x); v[2] += bflo(t.y); v[3] += bfhi(t.y); v[4] += bflo(t.z); v[5] += bfhi(t.z); v[6] += bflo(t.w); v[7] += bfhi(t.w);
                    }
                    u32x4 pk; pk.x = pk2(v[0], v[1]); pk.y = pk2(v[2], v[3]); pk.z = pk2(v[4], v[5]); pk.w = pk2(v[6], v[7]);
                    if (br == 2) *(u32x4*)(YM + (size_t)rT * 1024 + cT) = pk; else *(u32x4*)tp = pk;
                }
            }
    }
};
struct EpiF32 {
    static constexpr bool PERM = false;
    float* C; int ldc;
    __device__ __forceinline__ void operator()(AccRef acc, const Unit& u, int wr, int wc, int fr, int fq) const {
        const int row0 = u.pm * BM + wr * 64 + fr, col0 = u.pn * BM + wc * 32 + 4 * fq;
#pragma unroll
        for (int ai = 0; ai < 2; ++ai)
#pragma unroll
            for (int m = 0; m < 4; ++m) { float* rowp = C + (size_t)(row0 + ai * HALF + m * 16) * ldc + col0;
#pragma unroll
                for (int bj = 0; bj < 2; ++bj)
#pragma unroll
                    for (int n = 0; n < 2; ++n) *(f32x4*)(rowp + bj * HALF + n * 16) = acc[ai][bj][m][n]; }
    }
};
struct EpiBf16Out {
    static constexpr bool PERM = true;
    bf16_t* C; int ldc;
    __device__ __forceinline__ void operator()(AccRef acc, const Unit& u, int wr, int wc, int fr, int fq) const {
        const EpiTr T(wr * 4 + wc, fr, fq); const int L = fq * 16 + fr;
        const int row0 = u.pm * BM + wr * 64 + (L >> 2), col0 = u.pn * BM + wc * 32 + 8 * (L & 3);
#pragma unroll
        for (int ai = 0; ai < 2; ++ai)
#pragma unroll
            for (int m = 0; m < 4; ++m) { bf16_t* rowp = C + (size_t)(row0 + ai * HALF + m * 16) * ldc + col0;
                *(u32x4*)(rowp) = T(act_pack<ACT_NONE>(acc[ai][0][m][0], acc[ai][0][m][1]));
                *(u32x4*)(rowp + HALF) = T(act_pack<ACT_NONE>(acc[ai][1][m][0], acc[ai][1][m][1])); }
    }
};
struct EpiSwiglu {
    static constexpr bool PERM = true;
    bf16_t* Hd; int ldh;
    __device__ __forceinline__ void operator()(AccRef acc, const Unit& u, int wr, int wc, int fr, int fq) const {
        const EpiTr T(wr * 4 + wc, fr, fq); const int L = fq * 16 + fr;
        const int row0 = u.pm * BM + wr * 64 + (L >> 2), hc = u.pn * HALF + wc * 32 + 8 * (L & 3);
#pragma unroll
        for (int ai = 0; ai < 2; ++ai)
#pragma unroll
            for (int m = 0; m < 4; ++m) {
                f32x4 o0, o1;
#pragma unroll
                for (int j = 0; j < 4; ++j) { const float g0 = acc[ai][0][m][0][j], g1 = acc[ai][0][m][1][j];
                    o0[j] = g0 * fsig(g0) * acc[ai][1][m][0][j]; o1[j] = g1 * fsig(g1) * acc[ai][1][m][1][j]; }
                __builtin_nontemporal_store(T(act_pack<ACT_NONE>(o0, o1)), (u32x4*)(Hd + (size_t)(row0 + ai * HALF + m * 16) * ldh + hc));
            }
    }
};
}

#if defined(USE_SG32S)
#define GEMM_CALL pg8::gemm_sg32s
#elif defined(USE_SG32D)
#define GEMM_CALL pg8::gemm_sg32d
#elif defined(USE_SG32)
#define GEMM_CALL pg8::gemm_sg32
#elif defined(USE_NOLDS)
#define GEMM_CALL pg8::gemm_nolds
#elif defined(USE_SG)
#define GEMM_CALL pg8::gemm_simple
#else
#define GEMM_CALL pg8::gemm_phase
#endif
struct Frame {
    LAS unsigned char* lds;
    int tid, lane, wave, G, bx;
    GAS unsigned char* ws;
};
#define WSP(T, off) ((T*)(GAS T*)(F.ws + (off)))

__device__ __forceinline__ void transpose_item(const float* W, int K, int N, bf16_t* WT, size_t dest_row0, int k0, int n0, LAS float* scr, int lane) {
#pragma unroll 8
    for (int i = 0; i < 32; ++i) { const int kk = 2 * i + (lane >> 5); scr[kk * 33 + (lane & 31)] = W[(size_t)(k0 + kk) * N + n0 + (lane & 31)]; }
    asm volatile("s_waitcnt lgkmcnt(0)" ::: "memory");
    const int c = lane & 7;
#pragma unroll
    for (int j = 0; j < 4; ++j) { const int n = (lane >> 3) + 8 * j; const LAS float* s = scr + (8 * c) * 33 + n;
        u32x4 o; o.x = pk2(s[0 * 33], s[1 * 33]); o.y = pk2(s[2 * 33], s[3 * 33]); o.z = pk2(s[4 * 33], s[5 * 33]); o.w = pk2(s[6 * 33], s[7 * 33]);
        *(u32x4*)(WT + (dest_row0 + n) * (size_t)K + k0 + 8 * c) = o; }
    asm volatile("s_waitcnt lgkmcnt(0)" ::: "memory");
}
__device__ __forceinline__ int map_win(int n0) {
    if (n0 < 2048) return n0;
    if (n0 < 2560) return n0 - 2048 + PQ;
    if (n0 < 2688) return n0 - 2560 + PGLOW;
    if (n0 < 3712) return n0 - 2688 + PUV;
    return n0 - 3712 + PGATE;
}
__device__ __forceinline__ int map_gu(int n0, int Fh) {
    if (n0 < Fh) return 256 * (n0 >> 7) + (n0 & 127);
    const int c = n0 - Fh; return 256 * (c >> 7) + 128 + (c & 127);
}

namespace p0i {
constexpr int I0 = 16 * 212, I1 = 8 * 32, I2 = 16 * 32, I3 = 16 * 176, I4 = 44 * 32, I5 = 16 * 224, I6 = 56 * 32;
constexpr int C0 = 4 * I0, C1 = C0 + 12 * I1, C2 = C1 + 4 * I2, C3 = C2 + 2 * I3, C4 = C3 + 2 * I4, C5 = C4 + 16 * I5, C6 = C5 + 16 * I6;
constexpr int NSEG = 11;
__device__ __forceinline__ int def_item(int x) {
    const int beg[NSEG] = {C5, C4, 2 * I0, C0 + 6 * I1, C1 + 2 * I2, C2 + I3, C3 + I4, 3 * I0, C0 + 9 * I1, C1 + 3 * I2, C4 + 8 * I5};
    const int len[NSEG] = {8 * I6, 8 * I5, I0, 3 * I1, I2, I3, I4, I0, 3 * I1, I2, 8 * I5};
#pragma unroll
    for (int i = 0; i < NSEG; ++i) { if (x < len[i]) return beg[i] + x; x -= len[i]; }
    return C5 + 8 * I6 + x;
}
constexpr int DEF_TOTAL = 8 * I6 + 8 * I5 + (I0 + 3 * I1 + I2) + (I3 + I4) + (I0 + 3 * I1 + I2) + 8 * I5 + 8 * I6, SLOTN = DEF_TOTAL / 4;
static_assert(DEF_TOTAL % 4 == 0 && 2 * SLOTN >= 8 * I6 + 8 * I5 + I0 + 3 * I1 + I2 && 3 * SLOTN >= DEF_TOTAL - 8 * I5 - 8 * I6, "slot deadlines");
__device__ __forceinline__ bool deferred(int it) {
    if (it >= C4) return true;
    if (it < C0) return it >= 2 * I0;
    if (it < C1) return it >= C0 + 6 * I1;
    if (it < C2) return it >= C1 + 2 * I2;
    if (it < C3) return it >= C2 + I3;
    return it >= C3 + I4;
}
}
__device__ __forceinline__ void p0_item(Frame& F, const Params& p, int it, LAS float* scr) {
    using namespace p0i;
        if (it < C0) { const int mat = it / I0, r = it % I0, kb = r / 212, nb = r % 212;
            transpose_item(inp(p, 7) + (size_t)mat * 1024 * INW, 1024, INW, WSP(bf16_t, WS_WIN) + (size_t)mat * PLD * 1024, (size_t)map_win(nb * 32), kb * 64, nb * 32, scr, F.lane); }
        else if (it < C1) { const int q = it - C0, mat = q / I1, r = q % I1, kb = r / 32, nb = r % 32;
            transpose_item(inp(p, 23) + (size_t)mat * 512 * 1024, 512, 1024, WSP(bf16_t, WS_WBR) + (size_t)mat * 1024 * 512, (size_t)(nb * 32), kb * 64, nb * 32, scr, F.lane); }
        else if (it < C2) { const int q = it - C1, mat = q / I2, r = q % I2, kb = r / 32, nb = r % 32;
            transpose_item(inp(p, 24) + (size_t)mat * 1024 * 1024, 1024, 1024, WSP(bf16_t, WS_WOUT) + (size_t)mat * 1024 * 1024, (size_t)(nb * 32), kb * 64, nb * 32, scr, F.lane); }
        else if (it < C3) { const int q = it - C2, mat = q / I3, r = q % I3, kb = r / 176, nb = r % 176;
            transpose_item(inp(p, 25) + (size_t)mat * 1024 * 2 * FD, 1024, 2 * FD, WSP(bf16_t, WS_WGU) + (size_t)mat * 2 * FD * 1024, (size_t)map_gu(nb * 32, FD), kb * 64, nb * 32, scr, F.lane); }
        else if (it < C4) { const int q = it - C3, mat = q / I4, r = q % I4, kb = r / 32, nb = r % 32;
            transpose_item(inp(p, 26) + (size_t)mat * FD * 1024, FD, 1024, WSP(bf16_t, WS_WDN) + (size_t)mat * 1024 * FD, (size_t)(nb * 32), kb * 64, nb * 32, scr, F.lane); }
        else if (it < C5) { const int q = it - C4, mat = q / I5, r = q % I5, kb = r / 224, nb = r % 224;
            transpose_item(inp(p, 28) + (size_t)mat * 1024 * 2 * FE, 1024, 2 * FE, WSP(bf16_t, WS_MGU) + (size_t)mat * 2 * FE * 1024, (size_t)map_gu(nb * 32, FE), kb * 64, nb * 32, scr, F.lane); }
        else { const int q = it - C5, mat = q / I6, r = q % I6, kb = r / 32, nb = r % 32;
            transpose_item(inp(p, 29) + (size_t)mat * FE * 1024, FE, 1024, WSP(bf16_t, WS_MDN) + (size_t)mat * 1024 * FE, (size_t)(nb * 32), kb * 64, nb * 32, scr, F.lane); }
}
__device__ __forceinline__ void p0_slot(Frame& F, const Params& p, int l, int worker, int nw) {
    using namespace p0i;
    LAS float* scr = (LAS float*)(F.lds + F.wave * 16384);
    for (int x = worker; x < SLOTN; x += nw) p0_item(F, p, def_item(l * SLOTN + x), scr);
}
__device__ __forceinline__ void p0_prologue(Frame& F, const Params& p, bool split) {
    using namespace p0i;
    LAS float* scr = (LAS float*)(F.lds + F.wave * 16384);
    const int gw = F.bx * 8 + F.wave, NGW = F.G * 8;
    for (int it = gw; it < C6; it += NGW) {
        if (split && deferred(it)) continue;
        p0_item(F, p, it, scr);
    }
    const size_t gt = (size_t)F.bx * 512 + F.tid, NT = (size_t)F.G * 512;
    for (size_t i = gt; i < (size_t)4 * 2560 * 384; i += NT) {
        const int l = (int)(i / (2560 * 384)), r = (int)(i % (2560 * 384)), n = r / 384, k = r % 384, seg = n >> 9, c = n & 511;
        float v = 0.f;
        if (seg < 2) { const int kk = k - 64 * seg; if (kk >= 0 && kk < 64) v = inp(p, 11)[(((size_t)l * 2 + seg) * 64 + kk) * 512 + c]; }
        else if (seg < 4) { const int d = seg - 2, kk = k - 128 - 64 * d; if (kk >= 0 && kk < 64) v = inp(p, 13)[(((size_t)l * 2 + d) * 64 + kk) * 512 + c]; }
        else { const int kk = k - 256; if (kk >= 0) v = inp(p, 16)[((size_t)l * 128 + kk) * 512 + c]; }
        WSP(bf16_t, WS_WLORA)[i] = (bf16_t)pk2(v, 0.f);
    }
    for (size_t i = gt; i < (size_t)4 * 4 * 128 * 128; i += NT) WSP(bf16_t, WS_WCM)[i] = (bf16_t)pk2(inp(p, 21)[i], 0.f);
    for (size_t i = gt; i < (size_t)4 * 128 * 1024; i += NT) { const int l = (int)(i / (128 * 1024)), r = (int)(i % (128 * 1024));
        WSP(bf16_t, WS_WIN)[(size_t)l * PLD * 1024 + (size_t)(2176 + r / 1024) * 1024 + (r % 1024)] = 0; }
    if (gt < 1024) { const int pos = (int)gt >> 4, i = (int)gt & 15; const float fr = fexp2(-0.83048202372f * (float)i), rev = (float)pos * fr * 0.15915494309f;
        const float fx = rev - floorf(rev);
        WSP(float, WS_ROPE)[2 * gt] = __builtin_amdgcn_cosf(fx); WSP(float, WS_ROPE)[2 * gt + 1] = __builtin_amdgcn_sinf(fx); }
#ifdef NANFILL
    { u32x4* q = WSP(u32x4, WS_XC); const size_t n16 = (WS_END - WS_XC) / 16;
      for (size_t i = gt; i < n16; i += NT) q[i] = (u32x4){0x7fc07fc0u, 0x7fc07fc0u, 0x7fc07fc0u, 0x7fc07fc0u}; }
#endif
    __syncthreads();
    LAS float* sil = (LAS float*)F.lds;
    LAS float* red = (LAS float*)(F.lds + 36864);
    if (F.bx < 192) {
        for (int i = F.tid; i < 9 * 1024; i += 512) { const int v = i >> 10, k = i & 1023; const float cv = v < 8 ? inp(p, 1)[v * 1024 + k] : inp(p, 3)[k]; sil[i] = cv / (1.f + __expf(-cv)); }
        __syncthreads();
        for (int it = F.bx; it < 192; it += F.G) {
            const int l = it / 48, cc = it % 48, s = F.tid >> 7, col = F.tid & 127;
            const float* W = inp(p, 4) + (size_t)l * 1024 * 6144 + (size_t)cc * 128 + col;
            float a[9];
#pragma unroll
            for (int v = 0; v < 9; ++v) a[v] = 0.f;
#pragma unroll 4
            for (int k = s * 256; k < s * 256 + 256; ++k) { const float w = W[(size_t)k * 6144];
#pragma unroll
                for (int v = 0; v < 9; ++v) a[v] += sil[v * 1024 + k] * w; }
#pragma unroll
            for (int v = 0; v < 9; ++v) red[(s * 9 + v) * 128 + col] = a[v];
            __syncthreads();
            for (int i = F.tid; i < 9 * 128; i += 512) { const int v = i >> 7, c2 = i & 127;
                const float sum = red[(0 * 9 + v) * 128 + c2] + red[(1 * 9 + v) * 128 + c2] + red[(2 * 9 + v) * 128 + c2] + red[(3 * 9 + v) * 128 + c2];
                WSP(float, WS_MODV)[((size_t)l * 9 + v) * 6144 + cc * 128 + c2] = sum + inp(p, 5)[(size_t)l * 6144 + cc * 128 + c2]; }
            __syncthreads();
        }
    }
}

__device__ __forceinline__ bf16_t* xres_row(Frame& F, int r) { return WSP(bf16_t, WS_XB) + (size_t)r * D; }
__device__ __forceinline__ int row_mv(int r) { return r < NLAT ? (r >> 12) : 8; }
__device__ __forceinline__ void emit_h(Frame& F, const Params& p, const f32x4 (&xv)[4], int r, int l, int ngi, int sci, int shi, f32x4 (&hv)[4]) {
    float ss = 0.f;
#pragma unroll
    for (int j = 0; j < 4; ++j) ss += xv[j].x * xv[j].x + xv[j].y * xv[j].y + xv[j].z * xv[j].z + xv[j].w * xv[j].w;
    const float rstd = frsq(wave_sum(ss) * (1.f / D) + EPS);
    const float* ng = inp(p, 6) + ((size_t)l * 4 + ngi) * D;
    const float* mv = WSP(float, WS_MODV) + ((size_t)l * 9 + row_mv(r)) * 6144;
    bf16_t* hrow = WSP(bf16_t, WS_H) + (size_t)r * D;
#pragma unroll
    for (int j = 0; j < 4; ++j) { const int c = 4 * F.lane + 256 * j;
        const f32x4 g = *(const f32x4*)(ng + c), sc = *(const f32x4*)(mv + sci * 1024 + c), sh = *(const f32x4*)(mv + shi * 1024 + c);
        hv[j] = xv[j] * rstd * g * (sc + 1.f) + sh;
        u32x2 o; o.x = pk2(hv[j].x, hv[j].y); o.y = pk2(hv[j].z, hv[j].w);
        *(u32x2*)(hrow + c) = o; }
}
__device__ __forceinline__ void residual_update(Frame& F, const Params& p, const f32x4 (&fv)[4], const u32x2 (&xraw)[4], int r, int l, int ngi, int gai, f32x4 (&xv)[4], bool fin = false) {
    float ss = 0.f;
#pragma unroll
    for (int j = 0; j < 4; ++j) ss += fv[j].x * fv[j].x + fv[j].y * fv[j].y + fv[j].z * fv[j].z + fv[j].w * fv[j].w;
    const float rstd = frsq(wave_sum(ss) * (1.f / D) + EPS);
    const float* ng = inp(p, 6) + ((size_t)l * 4 + ngi) * D;
    const float* mv = WSP(float, WS_MODV) + ((size_t)l * 9 + row_mv(r)) * 6144;
    bf16_t* xr = xres_row(F, r);
#pragma unroll
    for (int j = 0; j < 4; ++j) { const int c = 4 * F.lane + 256 * j;
        const f32x4 g = *(const f32x4*)(ng + c), ga = *(const f32x4*)(mv + gai * 1024 + c), x0 = unp4(xraw[j]);
        xv[j] = x0 + ga * (fv[j] * rstd * g);
        if (fin) *(f32x4*)(outp(p) + (size_t)r * D + c) = xv[j];
        else { u32x2 o; o.x = pk2(xv[j].x, xv[j].y); o.y = pk2(xv[j].z, xv[j].w); *(u32x2*)(xr + c) = o; } }
}

__device__ __forceinline__ void load_gg(Frame& F, const Params& p, int l, int ngi, int gai, int mvidx, f32x4 (&gg)[4]) {
    const float* ng = inp(p, 6) + ((size_t)l * 4 + ngi) * D;
    const float* mv = WSP(float, WS_MODV) + ((size_t)l * 9 + mvidx) * 6144;
#pragma unroll
    for (int j = 0; j < 4; ++j) { const int c = 4 * F.lane + 256 * j; gg[j] = *(const f32x4*)(ng + c) * *(const f32x4*)(mv + gai * 1024 + c); }
}
__device__ __forceinline__ void load_gs(Frame& F, const Params& p, int l, int ngi, int sci, int shi, int mvidx, f32x4 (&gs)[4], f32x4 (&sh)[4]) {
    const float* ng = inp(p, 6) + ((size_t)l * 4 + ngi) * D;
    const float* mv = WSP(float, WS_MODV) + ((size_t)l * 9 + mvidx) * 6144;
#pragma unroll
    for (int j = 0; j < 4; ++j) { const int c = 4 * F.lane + 256 * j; gs[j] = *(const f32x4*)(ng + c) * (*(const f32x4*)(mv + sci * 1024 + c) + 1.f); sh[j] = *(const f32x4*)(mv + shi * 1024 + c); }
}
__device__ __forceinline__ void emit_h_v(Frame& F, const f32x4 (&xv)[4], int r, const f32x4 (&gs)[4], const f32x4 (&sh)[4], f32x4 (&hv)[4]) {
    float ss = 0.f;
#pragma unroll
    for (int j = 0; j < 4; ++j) ss += xv[j].x * xv[j].x + xv[j].y * xv[j].y + xv[j].z * xv[j].z + xv[j].w * xv[j].w;
    const float rstd = frsq(wave_sum(ss) * (1.f / D) + EPS);
    bf16_t* hrow = WSP(bf16_t, WS_H) + (size_t)r * D;
#pragma unroll
    for (int j = 0; j < 4; ++j) { const int c = 4 * F.lane + 256 * j;
        hv[j] = (xv[j] * rstd) * gs[j] + sh[j];
        u32x2 o; o.x = pk2(hv[j].x, hv[j].y); o.y = pk2(hv[j].z, hv[j].w);
        *(u32x2*)(hrow + c) = o; }
}
__device__ __forceinline__ void residual_update_v(Frame& F, const Params& p, const f32x4 (&fv)[4], const u32x2 (&xraw)[4], int r, const f32x4 (&gg)[4], f32x4 (&xv)[4], bool fin) {
    float ss = 0.f;
#pragma unroll
    for (int j = 0; j < 4; ++j) ss += fv[j].x * fv[j].x + fv[j].y * fv[j].y + fv[j].z * fv[j].z + fv[j].w * fv[j].w;
    const float rstd = frsq(wave_sum(ss) * (1.f / D) + EPS);
    bf16_t* xr = xres_row(F, r);
#pragma unroll
    for (int j = 0; j < 4; ++j) { const int c = 4 * F.lane + 256 * j;
        xv[j] = unp4(xraw[j]) + gg[j] * (fv[j] * rstd);
        if (fin) *(f32x4*)(outp(p) + (size_t)r * D + c) = xv[j];
        else { u32x2 o; o.x = pk2(xv[j].x, xv[j].y); o.y = pk2(xv[j].z, xv[j].w); *(u32x2*)(xr + c) = o; } }
}

__device__ __forceinline__ void p1_input(Frame& F, const Params& p) {
    const int gw = F.bx * 8 + F.wave, NGW = F.G * 8;
#pragma unroll 1
    for (int seg = 0; seg < 2; ++seg) {
        const int rbeg = seg == 0 ? (gw & 7) * 4096 + (gw >> 3) : NLAT + gw, rstep = seg == 0 ? (NGW >> 3) : NGW, rend = seg == 0 ? (gw & 7) * 4096 + 4096 : MT;
        if (rbeg >= rend) continue;
        f32x4 gs[4], sh[4];
        load_gs(F, p, 0, 0, 1, 0, seg == 0 ? (gw & 7) : 8, gs, sh);
#pragma unroll 2
        for (int r = rbeg; r < rend; r += rstep) {
            const float* src = r < NLAT ? inp(p, 0) + (size_t)r * D : inp(p, 2) + (size_t)(r - NLAT) * D;
            bf16_t* xr = xres_row(F, r);
            f32x4 xv[4], hv[4];
#pragma unroll
            for (int j = 0; j < 4; ++j) { xv[j] = *(const f32x4*)(src + 4 * F.lane + 256 * j); u32x2 o; o.x = pk2(xv[j].x, xv[j].y); o.y = pk2(xv[j].z, xv[j].w); *(u32x2*)(xr + 4 * F.lane + 256 * j) = o; }
            emit_h_v(F, xv, r, gs, sh, hv);
        }
    }
}

__device__ __forceinline__ void p3_qk(Frame& F, const Params& p, int l) {
    const int gw = F.bx * 8 + F.wave, NGW = F.G * 8, lane = F.lane, sub = lane & 7;
    const bf16_t* PROJ = WSP(bf16_t, WS_PROJ);
    const float* rope = WSP(float, WS_ROPE);
    const float* qg = inp(p, 8) + (size_t)l * 128;
    float qg_[2][8];
#pragma unroll
    for (int w = 0; w < 2; ++w)
#pragma unroll
        for (int j = 0; j < 8; ++j) qg_[w][j] = qg[w * 64 + 8 * sub + j];
#pragma unroll 2
    for (int r = gw; r < MT; r += NGW) {
        const bool islat = r < NLAT;
        const int b = islat ? (r >> 12) : ((r - NLAT) >> 8), t = islat ? (r & 4095) : ((r - NLAT) & 255), pos = islat ? 256 + t : t;
        const int ppos = (sub < 4) ? (t >> 6) : (t & 63);
        const float sgn = (sub & 2) ? 1.f : -1.f;
        f32x4 rp[4];
#pragma unroll
        for (int i = 0; i < 4; ++i) rp[i] = *(const f32x4*)(rope + (size_t)(ppos * 16 + 8 * (sub & 1)) * 2 + 4 * i);
#pragma unroll
        for (int which = 0; which < 2; ++which) {
            const int l2 = which ? (lane & 15) : lane;
            const u32x4 raw = *(const u32x4*)(PROJ + (size_t)r * PLD + (which ? PK : PQ) + l2 * 8);
            float x[8] = {bflo(raw.x), bfhi(raw.x), bflo(raw.y), bfhi(raw.y), bflo(raw.z), bfhi(raw.z), bflo(raw.w), bfhi(raw.w)};
            float ss = 0.f;
#pragma unroll
            for (int j = 0; j < 8; ++j) ss += x[j] * x[j];
            ss = sum8(ss);
            const float rstd = frsq(ss * (1.f / 64.f) + EPS);
            float y[8];
#pragma unroll
            for (int j = 0; j < 8; ++j) y[j] = x[j] * rstd * qg_[which][j];
#pragma unroll
            for (int j = 0; j < 8; ++j) { const float pr = dppf<0x4E>(y[j]);
                if (islat) { const float cs = rp[j >> 1][(j & 1) * 2], sn = rp[j >> 1][(j & 1) * 2 + 1]; x[j] = y[j] * cs + sgn * pr * sn; }
                else x[j] = y[j]; }
            const float sc = which ? 1.f : 0.18033688011f;
            u32x4 o; o.x = pk2(x[0] * sc, x[1] * sc); o.y = pk2(x[2] * sc, x[3] * sc); o.z = pk2(x[4] * sc, x[5] * sc); o.w = pk2(x[6] * sc, x[7] * sc);
            if (which == 0) *(u32x4*)(WSP(bf16_t, WS_QN) + ((size_t)(b * 8 + (lane >> 3)) * NKEY + pos) * 64 + 8 * sub) = o;
            else if (lane < 16) *(u32x4*)(WSP(bf16_t, WS_KN) + ((size_t)(b * 2 + (lane >> 3)) * NKEY + pos) * 64 + 8 * sub) = o;
        }
    }
}
__device__ __forceinline__ void p3_vt(Frame& F) {
    const bf16_t* PROJ = WSP(bf16_t, WS_PROJ);
    bf16_t* VT = WSP(bf16_t, WS_VT);
    LAS unsigned char* tile = F.lds;
    for (int it = F.bx; it < NB * 68; it += F.G) {
        const int b = it / 68, tb = it % 68, pos0 = tb * 64;
        const int row0 = tb < 4 ? NLAT + b * 256 + pos0 : b * 4096 + pos0 - 256;
        { const int tok = F.tid >> 3, ch = F.tid & 7; const bf16_t* src = PROJ + (size_t)(row0 + tok) * PLD + PV + 16 * ch;
          const u32x4 a = *(const u32x4*)src, c = *(const u32x4*)(src + 8);
          *(LAS u32x4*)(tile + tok * 272 + ch * 32) = a; *(LAS u32x4*)(tile + tok * 272 + ch * 32 + 16) = c; }
        __syncthreads();
        { const int dc = F.tid >> 2, tq = F.tid & 3; unsigned w[8];
#pragma unroll
          for (int i = 0; i < 8; ++i) { const unsigned lo = *(const LAS unsigned short*)(tile + (16 * tq + 2 * i) * 272 + dc * 2), hi = *(const LAS unsigned short*)(tile + (16 * tq + 2 * i + 1) * 272 + dc * 2); w[i] = lo | (hi << 16); }
          bf16_t* dst = VT + ((size_t)(b * 2 + (dc >> 6)) * 64 + (dc & 63)) * NKEY + pos0 + 16 * tq;
          *(u32x4*)dst = (u32x4){w[0], w[1], w[2], w[3]}; *(u32x4*)(dst + 8) = (u32x4){w[4], w[5], w[6], w[7]}; }
        __syncthreads();
    }
}

__device__ __forceinline__ void attn_unit(Frame& F, int b, int h, int qpos0, int nkeys, int orow0) {
    const int tid = F.tid, wave = F.wave, lane = F.lane, c = lane & 31, h2 = lane >> 5, kvh = h >> 2;
    const bf16_t* Kb = WSP(bf16_t, WS_KN) + (size_t)(b * 2 + kvh) * NKEY * 64;
    const bf16_t* Vb = WSP(bf16_t, WS_VT) + (size_t)(b * 2 + kvh) * 64 * NKEY;
    const bf16_t* Qb = WSP(bf16_t, WS_QN) + ((size_t)(b * 8 + h) * NKEY + qpos0 + wave * 32 + c) * 64;
    bf16x8 qf[4];
#pragma unroll
    for (int s = 0; s < 4; ++s) qf[s] = *(const bf16x8*)(Qb + 16 * s + 8 * h2);
    f32x16 O0, O1;
#pragma unroll
    for (int i = 0; i < 16; ++i) { O0[i] = 0.f; O1[i] = 0.f; }
    float mrun = 0.f, lsum = 0.f;
    f32x16 NM;
#pragma unroll
    for (int i = 0; i < 16; ++i) NM[i] = 0.f;
    const int skey = tid >> 3, sch = tid & 7, ntile = nkeys >> 6;
    LAS unsigned char* lds = F.lds;
    u32x4 kr = *(const u32x4*)(Kb + (size_t)skey * 64 + sch * 8);
    u32x4 vr = *(const u32x4*)(Vb + (size_t)skey * NKEY + sch * 8);
    u32x4 kr2 = kr, vr2 = vr;
    if (ntile > 1) { kr2 = *(const u32x4*)(Kb + (size_t)(64 + skey) * 64 + sch * 8); vr2 = *(const u32x4*)(Vb + (size_t)skey * NKEY + 64 + sch * 8); }
    *(LAS u32x4*)(lds + skey * 144 + sch * 16) = kr;
    const int vwo = skey * 144 + (sch >> 1) * 32 + (sch & 1) * 8;
    *(LAS u32x2*)(lds + 18432 + vwo) = (u32x2){vr.x, vr.y}; *(LAS u32x2*)(lds + 18432 + vwo + 16) = (u32x2){vr.z, vr.w};
    kr = kr2; vr = vr2;
    __syncthreads();
    auto tile_step = [&](const int t, u32x4& KX, u32x4& VX, u32x4& KY, u32x4& VY) {
        const int cur = t & 1;
        LAS unsigned char* kb = lds + cur * 9216;
        LAS unsigned char* vb = lds + 18432 + cur * 9216;
        if (t + 2 < ntile) { KY = *(const u32x4*)(Kb + (size_t)((t + 2) * 64 + skey) * 64 + sch * 8); VY = *(const u32x4*)(Vb + (size_t)skey * NKEY + (t + 2) * 64 + sch * 8); }
        f32x16 S0, S1;
#pragma unroll
        for (int s = 0; s < 4; ++s) {
            const bf16x8 a0 = *(const LAS bf16x8*)(kb + c * 144 + s * 32 + h2 * 16);
            const bf16x8 a1 = *(const LAS bf16x8*)(kb + (32 + c) * 144 + s * 32 + h2 * 16);
            S0 = __builtin_amdgcn_mfma_f32_32x32x16_bf16(a0, qf[s], s == 0 ? NM : S0, 0, 0, 0);
            S1 = __builtin_amdgcn_mfma_f32_32x32x16_bf16(a1, qf[s], s == 0 ? NM : S1, 0, 0, 0);
        }
        float mx = __builtin_fmaxf(__builtin_fmaxf(S0[0], S0[1]), S1[0]);
#pragma unroll
        for (int i = 1; i < 15; i += 2) mx = __builtin_fmaxf(__builtin_fmaxf(mx, S0[i + 1]), S0[i + 2 < 16 ? i + 2 : 15]);
#pragma unroll
        for (int i = 1; i < 16; i += 2) mx = __builtin_fmaxf(__builtin_fmaxf(mx, S1[i]), S1[i + 1 < 16 ? i + 1 : 15]);
        if (__builtin_amdgcn_ballot_w64(mx > 8.f) != 0ull) {
            const float mo = __int_as_float(__builtin_amdgcn_ds_bpermute((lane ^ 32) << 2, __float_as_int(mx)));
            const float m2 = fmaxf(mx, mo), d = m2 > 8.f ? m2 : 0.f, alpha = fexp2(-d);
            mrun += d; lsum *= alpha;
#pragma unroll
            for (int i = 0; i < 16; ++i) { S0[i] -= d; S1[i] -= d; O0[i] *= alpha; O1[i] *= alpha; NM[i] = -mrun; }
        }
        f32x2_t rs2 = (f32x2_t){0.f, 0.f};
#pragma unroll
        for (int i = 0; i < 16; i += 2) { S0[i] = fexp2(S0[i]); S0[i + 1] = fexp2(S0[i + 1]); S1[i] = fexp2(S1[i]); S1[i + 1] = fexp2(S1[i + 1]);
            rs2 += (f32x2_t){S0[i], S0[i + 1]}; rs2 += (f32x2_t){S1[i], S1[i + 1]}; }
        lsum += rs2.x + rs2.y;
        bf16x8 pf[4];
        { u32x4 w;
          w.x = pk2(S0[0], S0[1]); w.y = pk2(S0[2], S0[3]); w.z = pk2(S0[4], S0[5]); w.w = pk2(S0[6], S0[7]); pf[0] = __builtin_bit_cast(bf16x8, w);
          w.x = pk2(S0[8], S0[9]); w.y = pk2(S0[10], S0[11]); w.z = pk2(S0[12], S0[13]); w.w = pk2(S0[14], S0[15]); pf[1] = __builtin_bit_cast(bf16x8, w);
          w.x = pk2(S1[0], S1[1]); w.y = pk2(S1[2], S1[3]); w.z = pk2(S1[4], S1[5]); w.w = pk2(S1[6], S1[7]); pf[2] = __builtin_bit_cast(bf16x8, w);
          w.x = pk2(S1[8], S1[9]); w.y = pk2(S1[10], S1[11]); w.z = pk2(S1[12], S1[13]); w.w = pk2(S1[14], S1[15]); pf[3] = __builtin_bit_cast(bf16x8, w); }
#pragma unroll
        for (int ks = 0; ks < 4; ++ks) {
            const bf16x8 va0 = *(const LAS bf16x8*)(vb + c * 144 + 32 * ks + 16 * h2), va1 = *(const LAS bf16x8*)(vb + (32 + c) * 144 + 32 * ks + 16 * h2);
            O0 = __builtin_amdgcn_mfma_f32_32x32x16_bf16(va0, pf[ks], O0, 0, 0, 0);
            O1 = __builtin_amdgcn_mfma_f32_32x32x16_bf16(va1, pf[ks], O1, 0, 0, 0);
        }
        if (t + 1 < ntile) {
            LAS unsigned char* kn = lds + (cur ^ 1) * 9216; LAS unsigned char* vn = lds + 18432 + (cur ^ 1) * 9216;
            *(LAS u32x4*)(kn + skey * 144 + sch * 16) = KX;
            *(LAS u32x2*)(vn + vwo) = (u32x2){VX.x, VX.y}; *(LAS u32x2*)(vn + vwo + 16) = (u32x2){VX.z, VX.w};
        }
        __syncthreads();
    };
    for (int t = 0; t < ntile; t += 2) { tile_step(t, kr, vr, kr2, vr2); tile_step(t + 1, kr2, vr2, kr, vr); }
    lsum += __int_as_float(__builtin_amdgcn_ds_bpermute((lane ^ 32) << 2, __float_as_int(lsum)));
    const float inv = 1.f / lsum;
    bf16_t* orow = WSP(bf16_t, WS_OA) + (size_t)(orow0 + wave * 32 + c) * 512 + h * 64;
#pragma unroll
    for (int g4 = 0; g4 < 4; ++g4) {
        u32x2 o0, o1;
        o0.x = pk2(O0[4 * g4] * inv, O0[4 * g4 + 1] * inv); o0.y = pk2(O0[4 * g4 + 2] * inv, O0[4 * g4 + 3] * inv);
        o1.x = pk2(O1[4 * g4] * inv, O1[4 * g4 + 1] * inv); o1.y = pk2(O1[4 * g4 + 2] * inv, O1[4 * g4 + 3] * inv);
        *(u32x2*)(orow + 8 * g4 + 4 * h2) = o0; *(u32x2*)(orow + 32 + 8 * g4 + 4 * h2) = o1;
    }
}

struct ScanRaw { u32x2 x[3][3]; u32x2 a; u32x2 w; float mp, mn; };
__device__ __forceinline__ void scan_unit(Frame& F, const Params& p, int l, int cid) {
    const int tid = F.tid, sidx = tid >> 4, j = tid & 15;
    const int b = cid >> 5, h = (cid >> 2) & 7, dir = (cid >> 1) & 1, half = cid & 1;
    const int ch = h * 64 + 4 * j;
    const bf16_t* PROJ = WSP(bf16_t, WS_PROJ);
    const bf16_t* AIC = WSP(bf16_t, WS_AICLR);
    const bf16_t* WDEC = WSP(bf16_t, WS_WDEC);
    float* Y = WSP(float, WS_YFB) + (size_t)dir * MT * 512;
    const float* cw = inp(p, 9) + (size_t)l * 3 * 1536;
    f32x4 cwr[3], cwk[3], cwv[3];
#pragma unroll
    for (int tp = 0; tp < 3; ++tp) { cwr[tp] = *(const f32x4*)(cw + tp * 1536 + ch); cwk[tp] = *(const f32x4*)(cw + tp * 1536 + 512 + ch); cwv[tp] = *(const f32x4*)(cw + tp * 1536 + 1024 + ch); }
    const f32x4 kk0 = *(const f32x4*)(inp(p, 14) + (size_t)l * 1024 + ch), kk1 = *(const f32x4*)(inp(p, 14) + (size_t)l * 1024 + 512 + ch);
    f32x2_t SL = (f32x2_t){0.f, 0.f}, SH = (f32x2_t){0.f, 0.f};
    LAS unsigned char* lds = F.lds;
    constexpr int REC = 1408, BUF = 32 * REC;

    auto load_raw = [&](int c, ScanRaw& R) {
        const bool isctx = c < 8; const int cc = isctx ? c : c - 8, L = isctx ? 256 : 4096, base = isctx ? NLAT + b * 256 : b * 4096;
        const int t = dir ? (L - 1 - 32 * cc - sidx) : (32 * cc + sidx), row = base + t;
        R.mp = t > 0 ? 1.f : 0.f; R.mn = t < L - 1 ? 1.f : 0.f;
        const int rp = t > 0 ? row - 1 : row, rn = t < L - 1 ? row + 1 : row;
        const bf16_t* q0 = PROJ + (size_t)rp * PLD + PRKV + ch; const bf16_t* q1 = PROJ + (size_t)row * PLD + PRKV + ch; const bf16_t* q2 = PROJ + (size_t)rn * PLD + PRKV + ch;
#pragma unroll
        for (int k = 0; k < 3; ++k) { R.x[0][k] = *(const u32x2*)(q0 + 512 * k); R.x[1][k] = *(const u32x2*)(q1 + 512 * k); R.x[2][k] = *(const u32x2*)(q2 + 512 * k); }
        R.a = *(const u32x2*)(AIC + (size_t)row * 1024 + dir * 512 + ch);
        R.w = *(const u32x2*)(WDEC + (size_t)row * 1024 + dir * 512 + ch);
    };
    auto finish = [&](const ScanRaw& R, LAS unsigned char* buf) {
        const f32x4 r = cwr[0] * unp4(R.x[0][0]) * R.mp + cwr[1] * unp4(R.x[1][0]) + cwr[2] * unp4(R.x[2][0]) * R.mn;
        const f32x4 k = cwk[0] * unp4(R.x[0][1]) * R.mp + cwk[1] * unp4(R.x[1][1]) + cwk[2] * unp4(R.x[2][1]) * R.mn;
        const f32x4 v = cwv[0] * unp4(R.x[0][2]) * R.mp + cwv[1] * unp4(R.x[1][2]) + cwv[2] * unp4(R.x[2][2]) * R.mn;
        f32x4 kkv = k * kk0;
        float ss = kkv.x * kkv.x + kkv.y * kkv.y + kkv.z * kkv.z + kkv.w * kkv.w;
        ss = dpp_sum16(ss);
        kkv = kkv * frsq(ss + 1e-12f);
        const f32x4 a = unp4(R.a);
        const f32x4 kt = k * ((a - 1.f) * kk1 + 1.f);
        const f32x4 bb = kkv * a;
        LAS unsigned char* rec = buf + sidx * REC;
        { const f32x4 lw = unp4(R.w); *(LAS f32x4*)(rec + j * 16) = (f32x4){fexp2(lw.x), fexp2(lw.y), fexp2(lw.z), fexp2(lw.w)}; } *(LAS f32x4*)(rec + 256 + j * 16) = r; *(LAS f32x4*)(rec + 512 + j * 16) = kt;
        *(LAS f32x4*)(rec + 768 + j * 16) = kkv; *(LAS f32x4*)(rec + 1024 + j * 16) = bb;
        if ((j >> 3) == half) *(LAS f32x4*)(rec + 1280 + (j & 7) * 16) = v;
    };
    ScanRaw R;
    load_raw(0, R); finish(R, lds); __syncthreads();
    for (int c = 0; c < 136; ++c) {
        if (c + 1 < 136) load_raw(c + 1, R);
        {
            const bool isctx = c < 8; const int cc = isctx ? c : c - 8, L = isctx ? 256 : 4096, base = isctx ? NLAT + b * 256 : b * 4096;
            const int t0 = dir ? (L - 1 - 32 * cc) : (32 * cc);
            const int ysgn = dir ? -1 : 1;
            float* yb = Y + (size_t)(base + t0 + ysgn * j) * 512 + h * 64 + 32 * half + sidx;
            const ptrdiff_t ystep16 = (ptrdiff_t)ysgn * 16 * 512;
            const LAS unsigned char* buf = lds;
            float ykeep = 0.f, qp = 0.f;
            f32x4 w = *(const LAS f32x4*)(buf + j * 16), rr = *(const LAS f32x4*)(buf + 256 + j * 16), kt = *(const LAS f32x4*)(buf + 512 + j * 16);
            f32x4 kkv = *(const LAS f32x4*)(buf + 768 + j * 16), bb = *(const LAS f32x4*)(buf + 1024 + j * 16);
            float vv = *(const LAS float*)(buf + 1280 + sidx * 4);
#pragma unroll
            for (int s = 0; s < 32; ++s) {
                const LAS unsigned char* nrec = buf + (s < 31 ? s + 1 : 31) * REC;
                const f32x4 nw = *(const LAS f32x4*)(nrec + j * 16), nrr = *(const LAS f32x4*)(nrec + 256 + j * 16), nkt = *(const LAS f32x4*)(nrec + 512 + j * 16);
                const f32x4 nkk = *(const LAS f32x4*)(nrec + 768 + j * 16), nbb = *(const LAS f32x4*)(nrec + 1024 + j * 16);
                const float nvv = *(const LAS float*)(nrec + 1280 + sidx * 4);
                __builtin_amdgcn_sched_barrier(0);
                const f32x2_t pdv = SL * (f32x2_t){kkv.x, kkv.y} + SH * (f32x2_t){kkv.z, kkv.w};
                float pd = pdv.x + pdv.y;
                pd += dppf<0xB1>(pd); qp += dppf<0xB1>(qp);
                pd += dppf<0x4E>(pd); qp += dppf<0x4E>(qp);
                pd += dppf<0x141>(pd); qp += dppf<0x141>(qp);
                pd += dppf<0x140>(pd); qp += dppf<0x140>(qp);
                if (s > 0) { ykeep = (((s - 1) & 15) == j) ? qp : ykeep; if (((s - 1) & 15) == 15) { *yb = ykeep; yb += ystep16; } }
                const f32x2_t sa2 = (f32x2_t){-pd, -pd}, vv2 = (f32x2_t){vv, vv};
                SL = SL * (f32x2_t){w.x, w.y} + ((f32x2_t){bb.x, bb.y} * sa2 + (f32x2_t){kt.x, kt.y} * vv2);
                SH = SH * (f32x2_t){w.z, w.w} + ((f32x2_t){bb.z, bb.w} * sa2 + (f32x2_t){kt.z, kt.w} * vv2);
                const f32x2_t qv = SL * (f32x2_t){rr.x, rr.y} + SH * (f32x2_t){rr.z, rr.w};
                qp = qv.x + qv.y;
                w = nw; rr = nrr; kt = nkt; kkv = nkk; bb = nbb; vv = nvv;
            }
            qp = dpp_sum16(qp);
            ykeep = (j == 15) ? qp : ykeep;
            *yb = ykeep;
        }
        __syncthreads();
        if (c + 1 < 136) finish(R, lds);
        __syncthreads();
    }
}

__device__ __forceinline__ void scan_unit2(Frame& F, const Params& p, int l, int cid) {
    const int tid = F.tid, sidx = tid >> 4, j = tid & 15;
    const int b = cid >> 4, h = (cid >> 1) & 7, dir = cid & 1;
    const int ch = h * 64 + 4 * j;
    const bf16_t* PROJ = WSP(bf16_t, WS_PROJ);
    const bf16_t* AIC = WSP(bf16_t, WS_AICLR);
    const bf16_t* WDEC = WSP(bf16_t, WS_WDEC);
    float* Y = WSP(float, WS_YFB) + (size_t)dir * MT * 512;
    const float* cw = inp(p, 9) + (size_t)l * 3 * 1536;
    f32x4 cwr[3], cwk[3], cwv[3];
#pragma unroll
    for (int tp = 0; tp < 3; ++tp) { cwr[tp] = *(const f32x4*)(cw + tp * 1536 + ch); cwk[tp] = *(const f32x4*)(cw + tp * 1536 + 512 + ch); cwv[tp] = *(const f32x4*)(cw + tp * 1536 + 1024 + ch); }
    const f32x4 kk0 = *(const f32x4*)(inp(p, 14) + (size_t)l * 1024 + ch), kk1 = *(const f32x4*)(inp(p, 14) + (size_t)l * 1024 + 512 + ch);
    f32x2_t SLa = (f32x2_t){0.f, 0.f}, SHa = (f32x2_t){0.f, 0.f}, SLb = (f32x2_t){0.f, 0.f}, SHb = (f32x2_t){0.f, 0.f};
    LAS unsigned char* lds = F.lds;
    constexpr int REC = 1536, BUF = 32 * REC;

    auto load_raw = [&](int c, ScanRaw& R) {
        const bool isctx = c < 8; const int cc = isctx ? c : c - 8, L = isctx ? 256 : 4096, base = isctx ? NLAT + b * 256 : b * 4096;
        const int t = dir ? (L - 1 - 32 * cc - sidx) : (32 * cc + sidx), row = base + t;
        R.mp = t > 0 ? 1.f : 0.f; R.mn = t < L - 1 ? 1.f : 0.f;
        const int rp = t > 0 ? row - 1 : row, rn = t < L - 1 ? row + 1 : row;
        const bf16_t* q0 = PROJ + (size_t)rp * PLD + PRKV + ch; const bf16_t* q1 = PROJ + (size_t)row * PLD + PRKV + ch; const bf16_t* q2 = PROJ + (size_t)rn * PLD + PRKV + ch;
#pragma unroll
        for (int k = 0; k < 3; ++k) { R.x[0][k] = *(const u32x2*)(q0 + 512 * k); R.x[1][k] = *(const u32x2*)(q1 + 512 * k); R.x[2][k] = *(const u32x2*)(q2 + 512 * k); }
        R.a = *(const u32x2*)(AIC + (size_t)row * 1024 + dir * 512 + ch);
        R.w = *(const u32x2*)(WDEC + (size_t)row * 1024 + dir * 512 + ch);
    };
    auto finish = [&](const ScanRaw& R, LAS unsigned char* buf) {
        const f32x4 r = cwr[0] * unp4(R.x[0][0]) * R.mp + cwr[1] * unp4(R.x[1][0]) + cwr[2] * unp4(R.x[2][0]) * R.mn;
        const f32x4 k = cwk[0] * unp4(R.x[0][1]) * R.mp + cwk[1] * unp4(R.x[1][1]) + cwk[2] * unp4(R.x[2][1]) * R.mn;
        const f32x4 v = cwv[0] * unp4(R.x[0][2]) * R.mp + cwv[1] * unp4(R.x[1][2]) + cwv[2] * unp4(R.x[2][2]) * R.mn;
        f32x4 kkv = k * kk0;
        float ss = kkv.x * kkv.x + kkv.y * kkv.y + kkv.z * kkv.z + kkv.w * kkv.w;
        ss = dpp_sum16(ss);
        kkv = kkv * frsq(ss + 1e-12f);
        const f32x4 a = unp4(R.a);
        const f32x4 kt = k * ((a - 1.f) * kk1 + 1.f);
        const f32x4 bb = kkv * a;
        LAS unsigned char* rec = buf + sidx * REC;
        { const f32x4 lw = unp4(R.w); *(LAS f32x4*)(rec + j * 16) = (f32x4){fexp2(lw.x), fexp2(lw.y), fexp2(lw.z), fexp2(lw.w)}; } *(LAS f32x4*)(rec + 256 + j * 16) = r; *(LAS f32x4*)(rec + 512 + j * 16) = kt;
        *(LAS f32x4*)(rec + 768 + j * 16) = kkv; *(LAS f32x4*)(rec + 1024 + j * 16) = bb;
        { LAS float* vp = (LAS float*)(rec + 1280 + (j & 7) * 32 + (j >> 3) * 4); vp[0] = v.x; vp[2] = v.y; vp[4] = v.z; vp[6] = v.w; }
    };
    ScanRaw R;
    load_raw(0, R); finish(R, lds); __syncthreads();
    for (int c = 0; c < 136; ++c) {
        if (c + 1 < 136) load_raw(c + 1, R);
        {
            const bool isctx = c < 8; const int cc = isctx ? c : c - 8, L = isctx ? 256 : 4096, base = isctx ? NLAT + b * 256 : b * 4096;
            const int t0 = dir ? (L - 1 - 32 * cc) : (32 * cc);
            const int ysgn = dir ? -1 : 1;
            float* yb = Y + (size_t)(base + t0 + ysgn * (j >> 1)) * 512 + h * 64 + (j & 1) * 32 + sidx;
            const ptrdiff_t ystep16 = (ptrdiff_t)ysgn * 16 * 512;
            const LAS unsigned char* buf = lds;
            float keep0 = 0.f, keep1 = 0.f, qpa = 0.f, qpb = 0.f;
            const bool oddl = (j & 1) != 0; const ptrdiff_t y8 = (ptrdiff_t)ysgn * 8 * 512;
            f32x4 w = *(const LAS f32x4*)(buf + j * 16), rr = *(const LAS f32x4*)(buf + 256 + j * 16), kt = *(const LAS f32x4*)(buf + 512 + j * 16);
            f32x4 kkv = *(const LAS f32x4*)(buf + 768 + j * 16), bb = *(const LAS f32x4*)(buf + 1024 + j * 16);
            f32x2_t vv0 = *(const LAS f32x2_t*)(buf + 1280 + sidx * 8); float vva = vv0.x, vvb = vv0.y;
#pragma unroll
            for (int s = 0; s < 32; ++s) {
                const LAS unsigned char* nrec = buf + (s < 31 ? s + 1 : 31) * REC;
                const f32x4 nw = *(const LAS f32x4*)(nrec + j * 16), nrr = *(const LAS f32x4*)(nrec + 256 + j * 16), nkt = *(const LAS f32x4*)(nrec + 512 + j * 16);
                const f32x4 nkk = *(const LAS f32x4*)(nrec + 768 + j * 16), nbb = *(const LAS f32x4*)(nrec + 1024 + j * 16);
                const f32x2_t nvv = *(const LAS f32x2_t*)(nrec + 1280 + sidx * 8); const float nvva = nvv.x, nvvb = nvv.y;
                __builtin_amdgcn_sched_barrier(0);
                const f32x2_t kl = (f32x2_t){kkv.x, kkv.y}, kh = (f32x2_t){kkv.z, kkv.w};
                const f32x2_t pva = SLa * kl + SHa * kh, pvb = SLb * kl + SHb * kh;
                float pda = pva.x + pva.y, pdb = pvb.x + pvb.y;
                float z = (oddl ? qpb : qpa) + dppf<0xB1>(oddl ? qpa : qpb);
                pda += dppf<0xB1>(pda); pdb += dppf<0xB1>(pdb);
                pda += dppf<0x4E>(pda); pdb += dppf<0x4E>(pdb); z += dppf<0x4E>(z);
                pda += dppf<0x141>(pda); pdb += dppf<0x141>(pdb); z += dppf<0x124>(z);
                pda += dppf<0x140>(pda); pdb += dppf<0x140>(pdb); z += dppf<0x128>(z);
                if (s > 0) { const int q = (s - 1) & 15; const bool mine = (j >> 1) == (q & 7);
                    if (q < 8) keep0 = mine ? z : keep0; else keep1 = mine ? z : keep1;
                    if (q == 15) { yb[0] = keep0; yb[y8] = keep1; yb += ystep16; } }
                const f32x2_t wl = (f32x2_t){w.x, w.y}, wh = (f32x2_t){w.z, w.w}, bl = (f32x2_t){bb.x, bb.y}, bh = (f32x2_t){bb.z, bb.w}, tl = (f32x2_t){kt.x, kt.y}, th = (f32x2_t){kt.z, kt.w};
                const f32x2_t saa = (f32x2_t){-pda, -pda}, sab = (f32x2_t){-pdb, -pdb}, va2 = (f32x2_t){vva, vva}, vb2 = (f32x2_t){vvb, vvb};
                SLa = SLa * wl + (bl * saa + tl * va2); SHa = SHa * wh + (bh * saa + th * va2);
                SLb = SLb * wl + (bl * sab + tl * vb2); SHb = SHb * wh + (bh * sab + th * vb2);
                const f32x2_t rl = (f32x2_t){rr.x, rr.y}, rh = (f32x2_t){rr.z, rr.w};
                const f32x2_t qva = SLa * rl + SHa * rh, qvb = SLb * rl + SHb * rh;
                qpa = qva.x + qva.y; qpb = qvb.x + qvb.y;
                w = nw; rr = nrr; kt = nkt; kkv = nkk; bb = nbb; vva = nvva; vvb = nvvb;
            }
            { float z = (oddl ? qpb : qpa) + dppf<0xB1>(oddl ? qpa : qpb); z += dppf<0x4E>(z); z += dppf<0x124>(z); z += dppf<0x128>(z);
              keep1 = ((j >> 1) == 7) ? z : keep1; }
            yb[0] = keep0; yb[y8] = keep1;
        }
        __syncthreads();
        if (c + 1 < 136) finish(R, lds);
        __syncthreads();
    }
}

__device__ __forceinline__ void cmlp_unit(Frame& F, const Params& p, int l, int chk, int g) {
    const int tid = F.tid, wave = F.wave, lane = F.lane, c = lane & 31, h2 = lane >> 5;
    const bf16_t* PROJ = WSP(bf16_t, WS_PROJ);
    const bf16_t* WCM = WSP(bf16_t, WS_WCM) + (size_t)l * 4 * 128 * 128;
    const float* lg = inp(p, 19) + (size_t)l * 512; const float* lb = inp(p, 20) + (size_t)l * 512; const float* bs = inp(p, 22) + (size_t)l * 512;
    bf16_t* OC = WSP(bf16_t, WS_OA) + 2 * OABC_STRIDE;
    LAS unsigned char* vt = F.lds;
    LAS float* stats = (LAS float*)(F.lds + 40960);
    const int R0 = chk * 128;
    { const int tok = tid >> 2, q4 = tid & 3; const bf16_t* src = PROJ + (size_t)(R0 + tok) * PLD + PUV + 512 + q4 * 128;
      float s = 0.f, ss = 0.f;
#pragma unroll
      for (int i = 0; i < 16; ++i) { const u32x4 x = *(const u32x4*)(src + 8 * i);
          const float f[8] = {bflo(x.x), bfhi(x.x), bflo(x.y), bfhi(x.y), bflo(x.z), bfhi(x.z), bflo(x.w), bfhi(x.w)};
#pragma unroll
          for (int e = 0; e < 8; ++e) { s += f[e]; ss += f[e] * f[e]; } }
      s = sum4(s); ss = sum4(ss);
      const float mean = s * (1.f / 512.f), var = fmaxf(ss * (1.f / 512.f) - mean * mean, 0.f);
      if (q4 == 0) { stats[tok * 2] = mean; stats[tok * 2 + 1] = frsq(var + EPS); } }
    __syncthreads();
    {
        { const int q = tid >> 2, cg = tid & 3; const bf16_t* src = PROJ + (size_t)(R0 + q) * PLD + PUV + 512 + 128 * g + 32 * cg;
          const float mean = stats[q * 2], rstd = stats[q * 2 + 1];
#pragma unroll
          for (int i = 0; i < 4; ++i) { const u32x4 x = *(const u32x4*)(src + 8 * i);
              const float f[8] = {bflo(x.x), bfhi(x.x), bflo(x.y), bfhi(x.y), bflo(x.z), bfhi(x.z), bflo(x.w), bfhi(x.w)};
#pragma unroll
              for (int e = 0; e < 8; ++e) { const int cl = 32 * cg + 8 * i + e, chn = 128 * g + cl;
                  const float val = (f[e] - mean) * rstd * lg[chn] + lb[chn];
                  *(LAS unsigned short*)(vt + cl * 272 + q * 2) = (unsigned short)pk2(val, 0.f); } } }
        __syncthreads();
        const int pb = wave >> 1, cbase = 64 * (wave & 1);
        f32x16 a0, a1;
#pragma unroll
        for (int i = 0; i < 16; ++i) { a0[i] = 0.f; a1[i] = 0.f; }
#pragma unroll
        for (int ks = 0; ks < 8; ++ks) {
            const bf16x8 A = *(const bf16x8*)(WCM + ((size_t)(g * 128 + 32 * pb + c)) * 128 + 16 * ks + 8 * h2);
            const bf16x8 B0 = *(const LAS bf16x8*)(vt + (cbase + c) * 272 + 32 * ks + 16 * h2);
            const bf16x8 B1 = *(const LAS bf16x8*)(vt + (cbase + 32 + c) * 272 + 32 * ks + 16 * h2);
            a0 = __builtin_amdgcn_mfma_f32_32x32x16_bf16(B0, A, a0, 0, 0, 0);
            a1 = __builtin_amdgcn_mfma_f32_32x32x16_bf16(B1, A, a1, 0, 0, 0);
        }
        LAS unsigned char* ot = F.lds + 49152;
        { const int pr = 32 * pb + c; const float bsv = bs[g * 128 + pr];
#pragma unroll
          for (int g4 = 0; g4 < 4; ++g4) {
              const int ch = cbase + 8 * g4 + 4 * h2;
              *(LAS f32x4*)(ot + pr * 528 + ch * 4) = (f32x4){a0[4 * g4] + bsv, a0[4 * g4 + 1] + bsv, a0[4 * g4 + 2] + bsv, a0[4 * g4 + 3] + bsv};
              *(LAS f32x4*)(ot + pr * 528 + (ch + 32) * 4) = (f32x4){a1[4 * g4] + bsv, a1[4 * g4 + 1] + bsv, a1[4 * g4 + 2] + bsv, a1[4 * g4 + 3] + bsv}; } }
        __syncthreads();
#pragma unroll
        for (int i = 0; i < 4; ++i) { const int q = tid + 512 * i, tok = q >> 4, seg = q & 15; const size_t ro = (size_t)(R0 + tok);
            const f32x4 x0 = *(const LAS f32x4*)(ot + tok * 528 + seg * 32), x1 = *(const LAS f32x4*)(ot + tok * 528 + seg * 32 + 16);
            const u32x4 uu = *(const u32x4*)(PROJ + ro * PLD + PUV + 128 * g + seg * 8);
            u32x4 w;
            w.x = pk2(bflo(uu.x) * x0[0], bfhi(uu.x) * x0[1]); w.y = pk2(bflo(uu.y) * x0[2], bfhi(uu.y) * x0[3]);
            w.z = pk2(bflo(uu.z) * x1[0], bfhi(uu.z) * x1[1]); w.w = pk2(bflo(uu.w) * x1[2], bfhi(uu.w) * x1[3]);
            *(u32x4*)(OC + ro * 512 + 128 * g + seg * 8) = w; }
        __syncthreads();
    }
}

__device__ __forceinline__ void p5_readout(Frame& F, const Params& p, int l) {
    const int gw = F.bx * 8 + F.wave, NGW = F.G * 8, lane = F.lane, c0 = 8 * lane;
    const bf16_t* PROJ = WSP(bf16_t, WS_PROJ);
    const float* YF = WSP(float, WS_YFB); const float* YB = YF + (size_t)MT * 512;
    const bf16_t* GG = WSP(bf16_t, WS_GG);
    bf16_t* OB = WSP(bf16_t, WS_OA) + OABC_STRIDE;
    const float* cw = inp(p, 9) + (size_t)l * 3 * 1536;
    const float* rk = inp(p, 15) + (size_t)l * 512; const float* lg = inp(p, 17) + (size_t)l * 512; const float* lb = inp(p, 18) + (size_t)l * 512;
    const int nrows = (l == 3) ? NLAT : MT;
    float cwr_[3][8], cwk_[3][8], cwv_[3][8], rk_[8], lg_[8], lb_[8];
#pragma unroll
    for (int tp = 0; tp < 3; ++tp)
#pragma unroll
        for (int e = 0; e < 8; ++e) { cwr_[tp][e] = cw[tp * 1536 + c0 + e]; cwk_[tp][e] = cw[tp * 1536 + 512 + c0 + e]; cwv_[tp][e] = cw[tp * 1536 + 1024 + c0 + e]; }
#pragma unroll
    for (int e = 0; e < 8; ++e) { rk_[e] = rk[c0 + e]; lg_[e] = lg[c0 + e]; lb_[e] = lb[c0 + e]; }
#pragma unroll 2
    for (int r = gw; r < nrows; r += NGW) {
        const bool islat = r < NLAT; const int t = islat ? (r & 4095) : ((r - NLAT) & 255), L = islat ? 4096 : 256;
        float y[8];
        { const f32x4 a0 = *(const f32x4*)(YF + (size_t)r * 512 + c0), a1 = *(const f32x4*)(YF + (size_t)r * 512 + c0 + 4), b0 = *(const f32x4*)(YB + (size_t)r * 512 + c0), b1 = *(const f32x4*)(YB + (size_t)r * 512 + c0 + 4);
#pragma unroll
          for (int e = 0; e < 4; ++e) { y[e] = a0[e] + b0[e]; y[4 + e] = a1[e] + b1[e]; } }
        float s = 0.f;
#pragma unroll
        for (int e = 0; e < 8; ++e) s += y[e];
        s = sum8(s);
        const float mean = s * (1.f / 64.f);
        float q = 0.f;
#pragma unroll
        for (int e = 0; e < 8; ++e) { y[e] -= mean; q += y[e] * y[e]; }
        q = sum8(q);
        const float rstd = frsq(q * (1.f / 64.f) + 64e-5f);
        float rr[8], kk[8], vv[8];
#pragma unroll
        for (int e = 0; e < 8; ++e) { rr[e] = 0.f; kk[e] = 0.f; vv[e] = 0.f; }
#pragma unroll
        for (int tp = 0; tp < 3; ++tp) {
            const int tt = t + tp - 1; const bool ok = tt >= 0 && tt < L; const int rw = ok ? r + tp - 1 : r; const float mk = ok ? 1.f : 0.f;
            const bf16_t* src = PROJ + (size_t)rw * PLD + PRKV + c0;
            const u32x4 xr = *(const u32x4*)src, xk = *(const u32x4*)(src + 512), xv = *(const u32x4*)(src + 1024);
            const float fr_[8] = {bflo(xr.x), bfhi(xr.x), bflo(xr.y), bfhi(xr.y), bflo(xr.z), bfhi(xr.z), bflo(xr.w), bfhi(xr.w)};
            const float fk_[8] = {bflo(xk.x), bfhi(xk.x), bflo(xk.y), bfhi(xk.y), bflo(xk.z), bfhi(xk.z), bflo(xk.w), bfhi(xk.w)};
            const float fv_[8] = {bflo(xv.x), bfhi(xv.x), bflo(xv.y), bfhi(xv.y), bflo(xv.z), bfhi(xv.z), bflo(xv.w), bfhi(xv.w)};
#pragma unroll
            for (int e = 0; e < 8; ++e) { rr[e] += mk * cwr_[tp][e] * fr_[e]; kk[e] += mk * cwk_[tp][e] * fk_[e]; vv[e] += mk * cwv_[tp][e] * fv_[e]; }
        }
        float bsum = 0.f;
#pragma unroll
        for (int e = 0; e < 8; ++e) bsum += rr[e] * kk[e] * rk_[e];
        bsum = sum8(bsum);
        const u32x4 gw4 = *(const u32x4*)(GG + (size_t)r * 512 + c0);
        const float gg[8] = {bflo(gw4.x), bfhi(gw4.x), bflo(gw4.y), bfhi(gw4.y), bflo(gw4.z), bfhi(gw4.z), bflo(gw4.w), bfhi(gw4.w)};
        float o[8];
#pragma unroll
        for (int e = 0; e < 8; ++e) o[e] = (y[e] * rstd * lg_[e] + lb_[e] + bsum * vv[e]) * gg[e];
        u32x4 ow; ow.x = pk2(o[0], o[1]); ow.y = pk2(o[2], o[3]); ow.z = pk2(o[4], o[5]); ow.w = pk2(o[6], o[7]);
        *(u32x4*)(OB + (size_t)r * 512 + c0) = ow;
    }
}

__device__ __forceinline__ void p8_postmix(Frame& F, const Params& p, int l) {
    const int gw = F.bx * 8 + F.wave, NGW = F.G * 8, lane = F.lane;
    const int rows = (l == 3) ? NLAT : MT;
    const bf16_t* OL = WSP(bf16_t, WS_OL);
    const bool moe = (l & 1) != 0; const int li = l >> 1;
    const float* router = inp(p, 27) + (size_t)li * 1024 * 8;
    unsigned* cnt = WSP(unsigned, WS_CTL) + CW_MOE + li * 8 * 64;
    int* route = WSP(int, WS_ROUTE);
    f32x4 rw0[4][4], rw1[4][4];
    if (moe) {
#pragma unroll
        for (int j = 0; j < 4; ++j)
#pragma unroll
            for (int i = 0; i < 4; ++i) { const int c = 4 * lane + 256 * j + i; rw0[j][i] = *(const f32x4*)(router + (size_t)c * 8); rw1[j][i] = *(const f32x4*)(router + (size_t)c * 8 + 4); } }
    unsigned long long pk0 = 0ull, pk1 = 0ull; int kk_ = 0, klat = 0;
    int ec[8];
#pragma unroll
    for (int e = 0; e < 8; ++e) ec[e] = 0;
#pragma unroll 1
    for (int seg = 0; seg < 2; ++seg) {
    const int rbeg = seg == 0 ? (gw & 7) * 4096 + (gw >> 3) : NLAT + gw, rstep = seg == 0 ? (NGW >> 3) : NGW, rend = seg == 0 ? (gw & 7) * 4096 + 4096 : rows;
    if (rbeg >= rend) continue;
    f32x4 gg[4], gs[4], sh[4];
    load_gg(F, p, l, 1, 2, seg == 0 ? (gw & 7) : 8, gg); load_gs(F, p, l, 2, 4, 3, seg == 0 ? (gw & 7) : 8, gs, sh);
    u32x2 nf[4], nx[4];
#pragma unroll
    for (int j = 0; j < 4; ++j) { nf[j] = *(const u32x2*)(OL + (size_t)rbeg * D + 4 * lane + 256 * j); nx[j] = *(const u32x2*)(xres_row(F, rbeg) + 4 * lane + 256 * j); }
    for (int r = rbeg; r < rend; r += rstep) {
        f32x4 fv[4], xv[4], hv[4]; u32x2 cx[4];
#pragma unroll
        for (int j = 0; j < 4; ++j) { fv[j] = unp4(nf[j]); cx[j] = nx[j]; }
        { const int rn = (r + rstep < rend) ? r + rstep : r;
#pragma unroll
          for (int j = 0; j < 4; ++j) { nf[j] = *(const u32x2*)(OL + (size_t)rn * D + 4 * lane + 256 * j); nx[j] = *(const u32x2*)(xres_row(F, rn) + 4 * lane + 256 * j); } }
        residual_update_v(F, p, fv, cx, r, gg, xv, false);
        emit_h_v(F, xv, r, gs, sh, hv);
        if (moe) {
            float lg[8];
#pragma unroll
            for (int e = 0; e < 8; ++e) lg[e] = 0.f;
#pragma unroll
            for (int j = 0; j < 4; ++j)
#pragma unroll
                for (int i = 0; i < 4; ++i) { const f32x4 w0 = rw0[j][i], w1 = rw1[j][i];
                    const float hval = hv[j][i];
#pragma unroll
                    for (int e = 0; e < 4; ++e) { lg[e] += hval * w0[e]; lg[4 + e] += hval * w1[e]; } }
#pragma unroll
            for (int e = 0; e < 8; ++e) lg[e] = wave_sum(lg[e]);
            int i0 = 0; float v0 = lg[0];
#pragma unroll
            for (int e = 1; e < 8; ++e) if (lg[e] > v0) { v0 = lg[e]; i0 = e; }
            int i1 = (i0 == 0) ? 1 : 0; float v1 = -3.4e38f;
#pragma unroll
            for (int e = 0; e < 8; ++e) if (e != i0 && lg[e] > v1) { v1 = lg[e]; i1 = e; }
            const float w1 = 1.f / (1.f + __expf(v0 - v1)), w0 = 1.f - w1;
            const int u0 = __builtin_amdgcn_readfirstlane(i0), u1 = __builtin_amdgcn_readfirstlane(i1);
            pk0 |= (unsigned long long)u0 << (3 * kk_); pk1 |= (unsigned long long)u1 << (3 * kk_); ++kk_;
#pragma unroll
            for (int e = 0; e < 8; ++e) ec[e] += (u0 == e ? 1 : 0) + (u1 == e ? 1 : 0);
            if (lane == 0) { int* rt = route + (size_t)r * 8; rt[0] = u0; rt[1] = u1; rt[4] = __float_as_int(w0); rt[5] = __float_as_int(w1); }
        }
    }
    if (seg == 0) klat = kk_;
    }
    if (moe) {
        int cv = 0;
#pragma unroll
        for (int e = 0; e < 8; ++e) cv = (lane == e) ? ec[e] : cv;
        int bv = 0;
        if (lane < 8 && cv > 0) bv = (int)__hip_atomic_fetch_add(cnt + lane * 64, (unsigned)cv, __ATOMIC_RELAXED, __HIP_MEMORY_SCOPE_AGENT);
        for (int k = 0; k < kk_; ++k) {
            const int u0 = (int)((pk0 >> (3 * k)) & 7ull), u1 = (int)((pk1 >> (3 * k)) & 7ull);
            const int s0 = __builtin_amdgcn_readlane(bv, u0); bv += (lane == u0) ? 1 : 0;
            const int s1 = __builtin_amdgcn_readlane(bv, u1); bv += (lane == u1) ? 1 : 0;
            const int row = k < klat ? (gw & 7) * 4096 + (gw >> 3) + k * (NGW >> 3) : NLAT + gw + (k - klat) * NGW;
            if (lane == 0) { int* rt = route + (size_t)row * 8; rt[2] = s0; rt[3] = s1; }
        }
    }
}
__device__ __forceinline__ void moe_tile_starts(Frame& F, int li, int (&ts)[9]) {
    unsigned* cnt = WSP(unsigned, WS_CTL) + CW_MOE + li * 8 * 64;
    ts[0] = 0;
#pragma unroll
    for (int e = 0; e < 8; ++e) { const unsigned c = __builtin_amdgcn_readfirstlane(__hip_atomic_load(cnt + e * 64, __ATOMIC_RELAXED, __HIP_MEMORY_SCOPE_AGENT)); ts[e + 1] = ts[e] + (int)((c + 255u) >> 8); }
}
__device__ __forceinline__ void p9_gather(Frame& F, const Params& p, int l) {
    const int gw = F.bx * 8 + F.wave, NGW = F.G * 8, lane = F.lane;
    const int rows = (l == 3) ? NLAT : MT;
    int ts[9]; moe_tile_starts(F, l >> 1, ts);
    const int* route = WSP(int, WS_ROUTE); int* prow = WSP(int, WS_PROW);
    const bf16_t* H = WSP(bf16_t, WS_H); bf16_t* HP = WSP(bf16_t, WS_HPERM);
#pragma unroll 2
    for (int r = gw; r < rows; r += NGW) {
        const int rv = route[(size_t)r * 8 + (lane & 3)];
        const int e0 = __builtin_amdgcn_readlane(rv, 0), e1 = __builtin_amdgcn_readlane(rv, 1), s0 = __builtin_amdgcn_readlane(rv, 2), s1 = __builtin_amdgcn_readlane(rv, 3);
        int t0 = 0, t1 = 0;
#pragma unroll
        for (int e = 0; e < 8; ++e) { t0 = (e0 == e) ? ts[e] : t0; t1 = (e1 == e) ? ts[e] : t1; }
        const int p0 = 256 * t0 + s0, p1 = 256 * t1 + s1;
        const u32x4 a = *(const u32x4*)(H + (size_t)r * D + 8 * lane), c = *(const u32x4*)(H + (size_t)r * D + 512 + 8 * lane);
        *(u32x4*)(HP + (size_t)p0 * D + 8 * lane) = a; *(u32x4*)(HP + (size_t)p0 * D + 512 + 8 * lane) = c;
        *(u32x4*)(HP + (size_t)p1 * D + 8 * lane) = a; *(u32x4*)(HP + (size_t)p1 * D + 512 + 8 * lane) = c;
        if (lane == 0) { prow[(size_t)r * 2] = p0; prow[(size_t)r * 2 + 1] = p1; }
    }
}
__device__ __forceinline__ void p12_postffn(Frame& F, const Params& p, int l) {
    const int gw = F.bx * 8 + F.wave, NGW = F.G * 8, lane = F.lane;
    const int rows = (l == 3) ? NLAT : MT;
    const bool moe = (l & 1) != 0;
    const bf16_t* FO = WSP(bf16_t, WS_YP);
    const int* route = WSP(int, WS_ROUTE); const int* prow = WSP(int, WS_PROW);
    u32x2 nx[4]; int npv = 0, nwv = 0;
#pragma unroll 1
    for (int seg = 0; seg < 2; ++seg) {
    const int rbeg = seg == 0 ? (gw & 7) * 4096 + (gw >> 3) : NLAT + gw, rstep = seg == 0 ? (NGW >> 3) : NGW, rend = seg == 0 ? (gw & 7) * 4096 + 4096 : rows;
    if (rbeg >= rend) continue;
    const int mvi = seg == 0 ? (gw & 7) : 8;
    f32x4 gg[4], gs[4], sh[4];
    load_gg(F, p, l, 3, 5, mvi, gg);
    if (l < 3) load_gs(F, p, l + 1, 0, 1, 0, mvi, gs, sh);
#pragma unroll
    for (int j = 0; j < 4; ++j) nx[j] = *(const u32x2*)(xres_row(F, rbeg) + 4 * lane + 256 * j);
    if (moe) { npv = prow[(size_t)rbeg * 2 + (lane & 1)]; nwv = route[(size_t)rbeg * 8 + 4 + (lane & 1)]; }
    for (int r = rbeg; r < rend; r += rstep) {
        f32x4 fv[4], xv[4], hv[4]; u32x2 cx[4];
#pragma unroll
        for (int j = 0; j < 4; ++j) cx[j] = nx[j];
        const int pv = npv, wv = nwv;
        { const int rn = (r + rstep < rend) ? r + rstep : r;
#pragma unroll
          for (int j = 0; j < 4; ++j) nx[j] = *(const u32x2*)(xres_row(F, rn) + 4 * lane + 256 * j);
          if (moe) { npv = prow[(size_t)rn * 2 + (lane & 1)]; nwv = route[(size_t)rn * 8 + 4 + (lane & 1)]; } }
        if (moe) {
            const int p0 = __builtin_amdgcn_readlane(pv, 0), p1 = __builtin_amdgcn_readlane(pv, 1); const float w0 = __int_as_float(__builtin_amdgcn_readlane(wv, 0)), w1 = __int_as_float(__builtin_amdgcn_readlane(wv, 1));
#pragma unroll
            for (int j = 0; j < 4; ++j) fv[j] = w0 * unp4(*(const u32x2*)(FO + (size_t)p0 * D + 4 * lane + 256 * j)) + w1 * unp4(*(const u32x2*)(FO + (size_t)p1 * D + 4 * lane + 256 * j));
        } else {
#pragma unroll
            for (int j = 0; j < 4; ++j) fv[j] = unp4(*(const u32x2*)(FO + (size_t)r * D + 4 * lane + 256 * j));
        }
        residual_update_v(F, p, fv, cx, r, gg, xv, l == 3);
        if (l < 3) emit_h_v(F, xv, r, gs, sh, hv);
    }
    }
}


#ifndef DIGEST_AFTER
#define DIGEST_AFTER 0
#define DIGEST_GAIN 1.0f
#define DIGEST_SEL 7
#define P4_MASK 7
#endif
__device__ __forceinline__ void digest_phase(Frame& F, const Params& p, int upto) {
    const int gw = F.bx * 8 + F.wave, NGW = F.G * 8, lane = F.lane;
    for (int r = gw; r < NLAT; r += NGW) {
        const int rc = NLAT + (r & 2047);
        float* xr = outp(p) + (size_t)r * D;
        for (int j = 0; j < 16; ++j) {
            const int c = lane + 64 * j;
            float acc = 0.f;
            for (int rr_ = 0; rr_ < 2; ++rr_) { const int row = rr_ ? rc : r;
                if (upto == 1) { acc += bf1(WSP(bf16_t, WS_H)[(size_t)row * D + c]) + bf1(WSP(bf16_t, WS_WIN)[(size_t)(row % PLD) * 1024 + c]) + WSP(float, WS_MODV)[((size_t)row * 1024 + c) % (9 * 6144)]; }
                if (upto >= 2) { for (int k = 0; k < 6; ++k) acc += bf1(WSP(bf16_t, WS_PROJ)[(size_t)row * PLD + c + 1024 * k]); acc += bf1(WSP(bf16_t, WS_PROJ)[(size_t)row * PLD + 6144 + (c % 768)]); }
                if (upto >= 3) { acc += bf1(WSP(bf16_t, WS_WDEC)[(size_t)row * 1024 + c]) + bf1(WSP(bf16_t, WS_AICLR)[(size_t)row * 1024 + c]) + bf1(WSP(bf16_t, WS_GG)[(size_t)row * 512 + (c & 511)]);
                    acc += bf1(WSP(bf16_t, WS_QN)[((size_t)row * 1024 + c) % ((size_t)NB * 8 * NKEY * 64)]) + bf1(WSP(bf16_t, WS_KN)[((size_t)row * 1024 + c) % ((size_t)NB * 2 * NKEY * 64)]) + bf1(WSP(bf16_t, WS_VT)[((size_t)row * 1024 + c) % ((size_t)NB * 2 * NKEY * 64)]); }
                if (upto >= 4) { if (DIGEST_SEL & 1) acc += bf1(WSP(bf16_t, WS_OA)[(size_t)row * 512 + (c & 511)]); if (DIGEST_SEL & 2) acc += bf1(WSP(bf16_t, WS_OA)[2 * OABC_STRIDE + (size_t)row * 512 + (c & 511)]);
                    if (DIGEST_SEL & 4) acc += WSP(float, WS_YFB)[(size_t)row * 512 + (c & 511)] + WSP(float, WS_YFB)[(size_t)MT * 512 + (size_t)row * 512 + (c & 511)]; }
                if (upto == 5) acc += bf1(WSP(bf16_t, WS_OA)[OABC_STRIDE + (size_t)row * 512 + (c & 511)]);
                if (upto == 6) acc += bf1(WSP(bf16_t, WS_YM)[(size_t)row * 1024 + c]);
                if (upto == 7) acc += WSP(float, WS_OL)[(size_t)row * 1024 + c];
            }
            xr[c] = (__hip_atomic_load(WSP(unsigned, WS_CTL) + 64, __ATOMIC_RELAXED, __HIP_MEMORY_SCOPE_AGENT) != 0u) ? __builtin_nanf("") : DIGEST_GAIN * acc;
        }
    }
}
__global__ void __launch_bounds__(512, 2) mk_fwd(Params p) {
    extern __shared__ __attribute__((aligned(16))) unsigned char lds_raw[];
    Frame F;
    F.lds = (LAS unsigned char*)lds_raw;
    F.tid = threadIdx.x; F.lane = F.tid & 63; F.wave = __builtin_amdgcn_readfirstlane(F.tid >> 6);
    F.G = gridDim.x; F.bx = blockIdx.x; F.ws = (GAS unsigned char*)p.ws;
    volatile LAS unsigned* MISC = (volatile LAS unsigned*)(F.lds + LDS_MISC);
#ifdef LDSZERO
    for (int i = F.tid; i < LDS_BYTES / 16; i += 512) *(LAS u32x4*)(F.lds + 16 * i) = (u32x4){0u, 0u, 0u, 0u};
#endif
#ifdef LDSTEST
    unsigned lds_err = 0;
    for (int round = 0; round < 4; ++round) {
        for (int i = 0; i < 72; ++i) ((LAS unsigned*)F.lds)[i * 512 + F.tid] = (unsigned)(F.tid * 2654435761u + round * 7919u + i * 104729u);
        __syncthreads();
        const int t2 = (F.tid + 1 + 64 * round) & 511;
        for (int i = 0; i < 72; ++i) lds_err += (((LAS unsigned*)F.lds)[i * 512 + t2] != (unsigned)(t2 * 2654435761u + round * 7919u + i * 104729u)) ? 1u : 0u;
        __syncthreads();
    }
    if (lds_err) __hip_atomic_fetch_add(WSP(unsigned, WS_CTL) + 64, lds_err, __ATOMIC_RELAXED, __HIP_MEMORY_SCOPE_AGENT);
    for (int i = F.tid; i < LDS_BYTES / 16; i += 512) *(LAS u32x4*)(F.lds + 16 * i) = (u32x4){0u, 0u, 0u, 0u};
#endif
    if (F.tid < 64) MISC[F.tid] = 0u;
    __syncthreads();
#ifdef L2FLUSH
    {
        const u32x4* src = (const u32x4*)(GAS const u32x4*)(unsigned long long)p.in[28] + (size_t)F.bx * 65536 + F.tid;
        unsigned accx = 0;
#pragma unroll 8
        for (int i = 0; i < 128; ++i) { const u32x4 v = src[(size_t)i * 512]; accx ^= v.x ^ v.y ^ v.z ^ v.w; }
        if (accx == 0x12345u && F.tid == 1023) p.out[0] = 0.f;
        asm volatile("" :: "v"(accx));
    }
#endif
    XcdBarrier bar = xcd_barrier_post(WSP(unsigned, WS_CTL) + CW_BAR, MISC + 8);
#define GRID_BAR() do { XcdBarrier _b = bar; unsigned long long _t = (unsigned long long)_b.bar; int _wv0 = __builtin_amdgcn_readfirstlane(F.wave); asm volatile("" : "+s"(_t), "+s"(_wv0)); _b.bar = (unsigned*)(GAS unsigned*)_t; xcd_barrier(_b, (_wv0 == 0) && (lane_id() == 0)); } while (0)
#define LAUNDER() do { unsigned long long _w = (unsigned long long)p.ws; int _wv = __builtin_amdgcn_readfirstlane(F.wave); asm volatile("" : "+s"(_w), "+s"(_wv)); F.ws = (GAS unsigned char*)_w; F.wave = _wv; F.lane = lane_id(); F.tid = _wv * 64 + F.lane; } while (0)
    const int stop = p.stop_after;

    const bool p4split = (F.G & 15) == 0 && F.G >= 16;
    p0_prologue(F, p, p4split);
    GRID_BAR(); LAUNDER();
    p1_input(F, p);
    GRID_BAR(); LAUNDER();
    if (DIGEST_AFTER == 1) { digest_phase(F, p, 1); return; }
#ifdef SYNTH
    { const size_t gt = (size_t)F.bx * 512 + F.tid, NT = (size_t)F.G * 512;
      bf16_t* H = WSP(bf16_t, WS_H); bf16_t* W = WSP(bf16_t, WS_WIN);
      for (size_t i = gt; i < (size_t)MT * D; i += NT) { const int r = (int)(i >> 10), k = (int)(i & 1023); H[i] = (bf16_t)pk2((float)(((r * 131 + k * 71) % 257) - 128) * (1.f / 128.f), 0.f); }
      for (size_t i = gt; i < (size_t)PLD * 1024; i += NT) { const int n = (int)(i >> 10), k = (int)(i & 1023); W[i] = (bf16_t)pk2((float)(((n * 37 + k * 101) % 263) - 131) * (1.f / 131.f), 0.f); } }
    GRID_BAR(); LAUNDER();
#endif
    if (stop == 0) return;

    for (int l = 0; l < 4; ++l) {
        const int li = l >> 1;
#ifdef LDSTEST2
        { unsigned lds_err = 0;
          for (int round = 0; round < 256; ++round) {
              for (int i = 0; i < 8; ++i) { const unsigned v = (unsigned)(F.tid * 2654435761u + round * 7919u + i * 104729u); *(LAS u32x4*)(F.lds + (F.tid >> 3) * 144 + (F.tid & 7) * 16 + i * 9216) = (u32x4){v, v + 1u, v + 2u, v + 3u}; }
              __syncthreads();
              const int t2 = (F.tid * 7 + 64 * round + 13) & 511;
              for (int i = 0; i < 8; ++i) { const unsigned v = (unsigned)(t2 * 2654435761u + round * 7919u + i * 104729u); const u32x4 q = *(const LAS u32x4*)(F.lds + (t2 >> 3) * 144 + (t2 & 7) * 16 + i * 9216);
                  lds_err += (q.x != v || q.y != v + 1u || q.z != v + 2u || q.w != v + 3u) ? 1u : 0u; }
              __syncthreads();
          }
          if (lds_err) __hip_atomic_fetch_add(WSP(unsigned, WS_CTL) + 64, lds_err, __ATOMIC_RELAXED, __HIP_MEMORY_SCOPE_AGENT); }
#endif
#ifdef FAKE_P2
        { const bf16_t* H = WSP(bf16_t, WS_H); const bf16_t* W = WSP(bf16_t, WS_WIN); bf16_t* P = WSP(bf16_t, WS_PROJ);
          for (size_t i = (size_t)F.bx * 512 + F.tid; i < (size_t)MT * PLD; i += (size_t)F.G * 512) { const int r = (int)(i / PLD), n = (int)(i % PLD);
              P[i] = (bf16_t)pk2(bf1(H[(size_t)r * D + (n & 1023)]) * bf1(W[(size_t)n * 1024 + (r & 1023)]), 0.f); } }
        if (0)
#endif
        { pg8::Gemm g{WSP(bf16_t, WS_H), WSP(bf16_t, WS_WIN) + (size_t)l * PLD * 1024, 1024, 1024, 1024, 0, 0};
          pg8::InProjOrder S; if (l == 3) S.init2(NLAT / 256, NCTX / 256, PLD / 256, PQ / 256, F.G, F.bx); else S.init2(MT / 256, 0, PLD / 256, 0, F.G, F.bx);
          pg8::EpiProj E{WSP(bf16_t, WS_PROJ)};
          GEMM_CALL(F.lds, F.tid, g, S, E); LAUNDER(); if (GEMM_REPEAT) { GEMM_CALL(F.lds, F.tid, g, S, E); LAUNDER(); } }
        GRID_BAR(); LAUNDER();
        if (DIGEST_AFTER == 2) { digest_phase(F, p, 2); return; }
        { pg8::Gemm g{WSP(bf16_t, WS_PROJ) + PWLOW, WSP(bf16_t, WS_WLORA) + (size_t)l * 2560 * 384, 384, PLD, 384, 0, 0};
          pg8::LoraOrder S; S.init(MT / 256, 10, F.G, F.bx);
          pg8::EpiLora E{WSP(bf16_t, WS_WDEC), WSP(bf16_t, WS_AICLR), WSP(bf16_t, WS_GG), inp(p, 10) + (size_t)l * 1024, inp(p, 12) + (size_t)l * 1024};
          GEMM_CALL(F.lds, F.tid, g, S, E); LAUNDER(); if (GEMM_REPEAT) { GEMM_CALL(F.lds, F.tid, g, S, E); LAUNDER(); } }
        p3_qk(F, p, l);
        p3_vt(F);
        GRID_BAR(); LAUNDER();
        if (DIGEST_AFTER == 3) { digest_phase(F, p, 3); return; }
#ifndef P4_MASK
#define P4_MASK 7
#endif
        if (p4split) {
            const int hg = F.G >> 1;
            const int nchx = ((l == 3) ? NLAT : MT) / 128 / 8 * 4, ksplit = (nchx * CMLP_SCAN_SHARE) / 100;
            if (F.bx < hg) { for (int cid = F.bx; cid < 128; cid += hg) scan_unit2(F, p, l, cid); LAUNDER();
                for (int k = F.bx >> 3; k < ksplit; k += (hg >> 3)) cmlp_unit(F, p, l, (F.bx & 7) + 8 * (k >> 2), k & 3); }
            else {
                const int ab = F.bx - hg, nunits = (l < 3) ? 1088 : 1024;
                for (int u = ab; u < nunits; u += hg) {
                    if (u < 1024) { const int qt = u >> 6, h = (u >> 3) & 7, b = u & 7; attn_unit(F, b, h, 256 + 256 * qt, NKEY, b * 4096 + 256 * qt); }
                    else { const int cu = u - 1024, h = cu >> 3, b = cu & 7; attn_unit(F, b, h, 0, 256, NLAT + b * 256); }
                }
                LAUNDER();
                const int nch = ((l == 3) ? NLAT : MT) / 128, xcd = F.bx & 7, perx = hg >> 3;
                for (int k = ksplit + (ab >> 3); ; k += perx) { const int chk = xcd + 8 * (k >> 2); if (chk >= nch) break; cmlp_unit(F, p, l, chk, k & 3); }
                LAUNDER(); __syncthreads();
                p0_slot(F, p, l, ab * 8 + F.wave, hg * 8);
            }
        } else {
        if (P4_MASK & 1) { const int nunits = (l < 3) ? 1088 : 1024;
          for (int rep = 0; rep < ATT_REPEAT; ++rep)
          for (int u = F.bx; u < nunits; u += F.G) {
              if (u < 1024) { const int qt = u >> 6, h = (u >> 3) & 7, b = u & 7; attn_unit(F, b, h, 256 + 256 * qt, NKEY, b * 4096 + 256 * qt); }
              else { const int cu = u - 1024, h = cu >> 3, b = cu & 7; attn_unit(F, b, h, 0, 256, NLAT + b * 256); }
          } }
        LAUNDER();
        if (P4_MASK & 2) for (int cid = F.bx; cid < 256; cid += F.G) scan_unit(F, p, l, cid);
        LAUNDER();
        if (P4_MASK & 4) { const int nch = ((l == 3) ? NLAT : MT) / 128, xcd = F.bx & 7, perx = F.G >> 3;
          if ((F.G & 7) == 0) { for (int k = (perx == 32) ? (((F.bx >> 3) + 24) & 31) : (F.bx >> 3); ; k += perx) { const int chk = xcd + 8 * (k >> 2); if (chk >= nch) break; cmlp_unit(F, p, l, chk, k & 3); } }
          else for (int u = F.bx; u < 4 * nch; u += F.G) cmlp_unit(F, p, l, u >> 2, u & 3); }
        }
        GRID_BAR(); LAUNDER();
        if (DIGEST_AFTER == 4) { digest_phase(F, p, 4); return; }
        p5_readout(F, p, l);
        GRID_BAR(); LAUNDER();
        if (DIGEST_AFTER == 5) { digest_phase(F, p, 5); return; }
        { pg8::Gemm g{WSP(bf16_t, WS_OA), WSP(bf16_t, WS_WBR) + (size_t)l * 3 * 1024 * 512, 512, 512, 512, OABC_STRIDE, (size_t)1024 * 512};
          pg8::MergeOrder S; S.init(((l == 3) ? NLAT : MT) / 256, 4, F.G, F.bx);
          pg8::EpiMerge E{WSP(bf16_t, WS_PROJ), WSP(bf16_t, WS_TMP), WSP(bf16_t, WS_YM)};
          GEMM_CALL(F.lds, F.tid, g, S, E); LAUNDER(); if (GEMM_REPEAT) { GEMM_CALL(F.lds, F.tid, g, S, E); LAUNDER(); } }
        GRID_BAR(); LAUNDER();
        if (DIGEST_AFTER == 6) { digest_phase(F, p, 6); return; }
        { pg8::Gemm g{WSP(bf16_t, WS_YM), WSP(bf16_t, WS_WOUT) + (size_t)l * 1024 * 1024, 1024, 1024, 1024, 0, 0};
          pg8::StaticOrder S; S.init(((l == 3) ? NLAT : MT) / 256, 4, F.G, F.bx);
          pg8::EpiBf16Out E{WSP(bf16_t, WS_OL), 1024};
          GEMM_CALL(F.lds, F.tid, g, S, E); LAUNDER(); if (GEMM_REPEAT) { GEMM_CALL(F.lds, F.tid, g, S, E); LAUNDER(); } }
        GRID_BAR(); LAUNDER();
        if (DIGEST_AFTER == 7) { digest_phase(F, p, 7); return; }
        p8_postmix(F, p, l);
        GRID_BAR(); LAUNDER();
        const int mrows = (l == 3) ? NLAT : MT;
        if ((l & 1) == 0) {
            LAUNDER();
            { pg8::Gemm g{WSP(bf16_t, WS_H), WSP(bf16_t, WS_WGU) + (size_t)li * 2 * FD * 1024, 1024, 1024, 1024, 0, 0};
              pg8::StaticOrder S; S.init(mrows / 256, 2 * FD / 256, F.G, F.bx);
              pg8::EpiSwiglu E{WSP(bf16_t, WS_HID), FD};
              GEMM_CALL(F.lds, F.tid, g, S, E); LAUNDER(); if (GEMM_REPEAT) { GEMM_CALL(F.lds, F.tid, g, S, E); LAUNDER(); } }
            GRID_BAR(); LAUNDER();
            { pg8::Gemm g{WSP(bf16_t, WS_HID), WSP(bf16_t, WS_WDN) + (size_t)li * 1024 * FD, FD, FD, FD, 0, 0};
              pg8::StaticOrder S; S.init(mrows / 256, 4, F.G, F.bx);
              pg8::EpiBf16Out E{WSP(bf16_t, WS_YP), 1024};
              GEMM_CALL(F.lds, F.tid, g, S, E); LAUNDER(); if (GEMM_REPEAT) { GEMM_CALL(F.lds, F.tid, g, S, E); LAUNDER(); } }
            GRID_BAR(); LAUNDER();
        } else {
            LAUNDER();
            p9_gather(F, p, l);
            GRID_BAR(); LAUNDER();
            { pg8::Gemm g{WSP(bf16_t, WS_HPERM), WSP(bf16_t, WS_MGU) + (size_t)li * 8 * 2 * FE * 1024, 1024, 1024, 1024, 0, (size_t)2 * FE * 1024};
              pg8::GroupOrder S; int ts[9]; moe_tile_starts(F, li, ts); { int* tp = WSP(int, WS_CTL) + 65536 + F.bx * 16;
#pragma unroll
                for (int j = 0; j < 9; ++j) tp[j] = ts[j];
                S.tsp = tp; } S.init(ts[8], 2 * FE / 256, F.G, F.bx);
              pg8::EpiSwiglu E{WSP(bf16_t, WS_HID), FE};
              GEMM_CALL(F.lds, F.tid, g, S, E); LAUNDER(); if (GEMM_REPEAT) { GEMM_CALL(F.lds, F.tid, g, S, E); LAUNDER(); } }
            GRID_BAR(); LAUNDER();
            { pg8::Gemm g{WSP(bf16_t, WS_HID), WSP(bf16_t, WS_MDN) + (size_t)li * 8 * 1024 * FE, FE, FE, FE, 0, (size_t)1024 * FE};
              pg8::GroupOrder S; int ts[9]; moe_tile_starts(F, li, ts); { int* tp = WSP(int, WS_CTL) + 65536 + F.bx * 16;
#pragma unroll
                for (int j = 0; j < 9; ++j) tp[j] = ts[j];
                S.tsp = tp; } S.init(ts[8], 4, F.G, F.bx);
              pg8::EpiBf16Out E{WSP(bf16_t, WS_YP), 1024};
              GEMM_CALL(F.lds, F.tid, g, S, E); LAUNDER(); if (GEMM_REPEAT) { GEMM_CALL(F.lds, F.tid, g, S, E); LAUNDER(); } }
            GRID_BAR(); LAUNDER();
        }
        p12_postffn(F, p, l);
        GRID_BAR(); LAUNDER();
        if (stop == 2 * l + 2) return;
    }
}

extern "C" void kernel_launch(void* const* d_in, const int* in_sizes, int n_in, void* d_out, int out_size, void* d_ws, size_t ws_size, hipStream_t stream) {
    static int grid = 0;
    if (grid == 0) {
        if (n_in != 30 || out_size != NLAT * D || ws_size < WS_END) { fprintf(stderr, "kernel_launch: unexpected shapes (n_in %d out %d ws %zu, need ws >= %zu); nothing launched\n", n_in, out_size, ws_size, (size_t)WS_END); grid = -1; return; }
        int dev = 0, cus = 0, per_cu = 0;
        if (hipGetDevice(&dev) != hipSuccess || hipDeviceGetAttribute(&cus, hipDeviceAttributeMultiprocessorCount, dev) != hipSuccess) { grid = -1; return; }
        if (hipFuncSetAttribute((const void*)mk_fwd, hipFuncAttributeMaxDynamicSharedMemorySize, LDS_BYTES) != hipSuccess) { fprintf(stderr, "kernel_launch: hipFuncSetAttribute failed\n"); grid = -1; return; }
        if (hipOccupancyMaxActiveBlocksPerMultiprocessor(&per_cu, (const void*)mk_fwd, 512, LDS_BYTES) != hipSuccess || per_cu < 1)
            fprintf(stderr, "kernel_launch: occupancy query reports %d blocks per CU\n", per_cu);
        (void)hipGetLastError();
        grid = cus;
    }
    if (grid < 0) return;
    (void)hipMemsetAsync((char*)d_ws + WS_CTL, 0, CTL_BYTES, stream);
    Params p{};
    for (int i = 0; i < 30; ++i) p.in[i] = (const float*)d_in[i];
    p.out = (float*)d_out; p.ws = (unsigned char*)d_ws; p.stop_after = STOP_AFTER; p.pad = 0;
    hipLaunchKernelGGL(mk_fwd, dim3(grid), dim3(512), LDS_BYTES, stream, p);
}
```
